# Optimizing an MI355X kernel written in HIP

```python
import math
import jax
import jax.numpy as jnp
from jax import lax
import numpy as np

D_MODEL = 1024
BATCH = 4
SEQ = 4096
DEPTH = 2

CTX_LEN = 256
GRID_W = 64
NORM_EPS = 1e-6

HY_WIDTH = 1024
HY_SHORT = 3
HY_EMB = 33
HY_BANDS = (HY_EMB - 1) // 2
HY_HIDDEN = 64
HY_TARGET = 1e-2
HY_SHORT_DECAY_PCT = 0.3
HY_LONG_DECAY_PCT = 1.5

ATT_HEADS = 8
ATT_KV_HEADS = 2
HEAD_DIM = 128
ATT_WIDTH = ATT_HEADS * HEAD_DIM
Q_BLOCK = 128
ROPE_THETA = 10000.0

EVEN_MIX = HY_WIDTH + ATT_WIDTH
EVEN_SPLITS = (3 * HY_WIDTH, HY_WIDTH, ATT_WIDTH, ATT_KV_HEADS * HEAD_DIM, ATT_KV_HEADS * HEAD_DIM, ATT_WIDTH)
EVEN_IN = sum(EVEN_SPLITS)

ML_HEADS = 8
ML_QK = 128
ML_V = 256
ML_WIDTH = ML_HEADS * ML_V
ML_CHUNK = 64
ML_SHORT = 3
ODD_SPLITS = (ML_HEADS * ML_QK, ML_HEADS * ML_QK, ML_WIDTH, ML_WIDTH, ML_WIDTH, 4 * ML_HEADS)
ODD_IN = sum(ODD_SPLITS)

N_EVEN = (DEPTH + 1) // 2
N_ODD = DEPTH // 2

kernel_name = 'hybrid_hyena_gqa_mlstm_prefix_dit'


def _split(a, sizes):
    out, start = [], 0
    for s in sizes:
        out.append(a[..., start:start + s])
        start += s
    return out


def rms_norm(x, g):
    xf = x.astype(jnp.float32)
    y = xf * lax.rsqrt(jnp.mean(xf * xf, axis=-1, keepdims=True) + NORM_EPS)
    return (y * g.astype(jnp.float32)).astype(x.dtype)


def dw_conv(u, w, b):
    ch = u.shape[-1]
    k = w.shape[0]
    y = lax.conv_general_dilated(u, w[:, None, :].astype(u.dtype), window_strides=(1,),
                                 padding=[(k // 2, k // 2)], dimension_numbers=('NWC', 'WIO', 'NWC'),
                                 feature_group_count=ch)
    return y + b.astype(u.dtype)


def adaln(cond, w_mod, b_mod):
    m = jax.nn.silu(cond) @ w_mod + b_mod
    return _split(m, (D_MODEL, D_MODEL, D_MODEL))


def axial_rope(x, rows, cols):
    f32 = jnp.float32
    half = x.shape[-1] // 2
    nf = half // 2
    inv = ROPE_THETA ** (-jnp.arange(nf, dtype=f32) / nf)

    def rot(xa, pos):
        ang = pos.astype(f32)[:, None] * inv
        cos = jnp.cos(ang)[None, :, None, :]
        sin = jnp.sin(ang)[None, :, None, :]
        x1 = xa[..., :nf].astype(f32)
        x2 = xa[..., nf:].astype(f32)
        return jnp.concatenate([x1 * cos - x2 * sin, x1 * sin + x2 * cos], axis=-1)

    out = jnp.concatenate([rot(x[..., :half], rows), rot(x[..., half:], cols)], axis=-1)
    return out.astype(x.dtype)


def hyena_filter(n, w1, b1, freq, w2, b2, w3):
    f32 = jnp.float32
    t = jnp.linspace(0.0, 1.0, n, dtype=f32)[:, None]
    bands = jnp.linspace(1e-4, HY_BANDS - 1, HY_BANDS, dtype=f32)
    ang = (2.0 * math.pi / n) * jnp.arange(n, dtype=f32)[:, None] * bands
    z = jnp.concatenate([t, jnp.cos(ang), -jnp.sin(ang)], axis=-1)
    fr = freq.astype(f32)
    hdn = jnp.sin(fr * (z @ w1.astype(f32) + b1.astype(f32)))
    hdn = jnp.sin(fr * (hdn @ w2.astype(f32) + b2.astype(f32)))
    h = (hdn @ w3.astype(f32)).reshape(n, 2, HY_WIDTH)
    max_decay = math.log(HY_TARGET) / HY_SHORT_DECAY_PCT
    min_decay = math.log(HY_TARGET) / HY_LONG_DECAY_PCT
    deltas = jnp.linspace(min_decay, max_decay, HY_WIDTH, dtype=f32)
    h = h * jnp.exp(-t * jnp.abs(deltas))[:, None, :]
    two_sided = jnp.concatenate([h[:, 0], jnp.zeros((1, HY_WIDTH), f32), h[:0:-1, 1]], axis=0)
    return two_sided / jnp.sum(jnp.abs(two_sided), axis=0, keepdims=True)


def bidir_long_conv(u, filt):
    n = u.shape[1]
    uf = jnp.fft.rfft(u.astype(jnp.float32), n=2 * n, axis=1)
    ff = jnp.fft.rfft(filt, axis=0)
    return jnp.fft.irfft(uf * ff[None], n=2 * n, axis=1)[:, :n].astype(u.dtype)


def hyena_mixer(xv, conv_w, conv_b, f_w1, f_b1, f_freq, f_w2, f_b2, f_w3, hy_bias):
    n = xv.shape[1]
    x0, x1, v = _split(dw_conv(xv, conv_w, conv_b), (HY_WIDTH, HY_WIDTH, HY_WIDTH))
    filt = hyena_filter(n, f_w1, f_b1, f_freq, f_w2, f_b2, f_w3)
    g = v * x1
    return x0 * (bidir_long_conv(g, filt) + g * hy_bias.astype(g.dtype))


def block_attention(q, k, v):
    B, n, H, Dh = q.shape
    kvh = k.shape[2]
    grp = H // kvh
    nb = n // Q_BLOCK
    qb = jnp.moveaxis(q.reshape(B, nb, Q_BLOCK, kvh, grp, Dh), 1, 0)
    scale = Dh ** -0.5

    def attend(qblk):
        s = jnp.einsum('bqkgd,btkd->bkgqt', qblk, k, preferred_element_type=jnp.float32) * scale
        p = jax.nn.softmax(s, axis=-1).astype(v.dtype)
        return jnp.einsum('bkgqt,btkd->bqkgd', p, v)

    out = lax.map(attend, qb)
    return jnp.moveaxis(out, 0, 1).reshape(B, n, H * Dh)


def even_mixer(h_lat, h_ctx, rows, cols, need_ctx, w_in, conv_w, conv_b, f_w1, f_b1, f_freq,
               f_w2, f_b2, f_w3, hy_bias, q_norm, k_norm, w_out):
    def project(h):
        B, n = h.shape[:2]
        xv, g_hy, q, k, v, g_att = _split(h @ w_in, EVEN_SPLITS)
        q = rms_norm(q.reshape(B, n, ATT_HEADS, HEAD_DIM), q_norm)
        k = rms_norm(k.reshape(B, n, ATT_KV_HEADS, HEAD_DIM), k_norm)
        v = v.reshape(B, n, ATT_KV_HEADS, HEAD_DIM)
        return xv, g_hy, q, k, v, g_att

    def hyena(xv):
        return hyena_mixer(xv, conv_w, conv_b, f_w1, f_b1, f_freq, f_w2, f_b2, f_w3, hy_bias)

    def combine(hy, att, g_hy, g_att):
        return jnp.concatenate([hy * jax.nn.silu(g_hy), att * jax.nn.silu(g_att)], axis=-1) @ w_out

    xv_l, gh_l, q_l, k_l, v_l, ga_l = project(h_lat)
    xv_c, gh_c, q_c, k_c, v_c, ga_c = project(h_ctx)
    q_l = axial_rope(q_l, rows, cols)
    k_l = axial_rope(k_l, rows, cols)
    att_l = block_attention(q_l, jnp.concatenate([k_l, k_c], axis=1), jnp.concatenate([v_l, v_c], axis=1))
    y_lat = combine(hyena(xv_l), att_l, gh_l, ga_l)
    y_ctx = None
    if need_ctx:
        y_ctx = combine(hyena(xv_c), block_attention(q_c, k_c, v_c), gh_c, ga_c)
    return y_lat, y_ctx


def mlstm_chunkwise(q, k, v, i_pre, f_pre, state):
    f32 = jnp.float32
    B, H, n, _ = q.shape
    nc = n // ML_CHUNK

    def chunks(a):
        a = a.astype(f32)
        return jnp.moveaxis(a.reshape(B, H, nc, ML_CHUNK, *a.shape[3:]), 2, 0)

    lower = jnp.tril(jnp.ones((ML_CHUNK, ML_CHUNK), dtype=bool))

    def step(carry, inp):
        C, nvec, m = carry
        qc, kc, vc, ic, lfc = inp
        b = jnp.cumsum(lfc, axis=-1)
        d = jnp.where(lower, b[..., :, None] - b[..., None, :] + ic[..., None, :], -jnp.inf)
        inter = b + m[..., None]
        m_row = jnp.maximum(inter, jnp.max(d, axis=-1))
        s = jnp.einsum('bhtd,bhsd->bhts', qc, kc) * jnp.exp(d - m_row[..., None])
        w_prev = jnp.exp(inter - m_row)
        num = jnp.einsum('bhts,bhsv->bhtv', s, vc) + w_prev[..., None] * jnp.einsum('bhvd,bhtd->bhtv', C, qc)
        den = jnp.sum(s, axis=-1) + w_prev * jnp.einsum('bhd,bhtd->bht', nvec, qc)
        h = num / jnp.maximum(jnp.abs(den), jnp.exp(-m_row))[..., None]
        b_end = b[..., -1]
        g = b_end[..., None] - b + ic
        m_new = jnp.maximum(b_end + m, jnp.max(g, axis=-1))
        a = jnp.exp(g - m_new[..., None])
        a_prev = jnp.exp(b_end + m - m_new)
        C = a_prev[..., None, None] * C + jnp.einsum('bhsv,bhsd->bhvd', vc * a[..., None], kc)
        nvec = a_prev[..., None] * nvec + jnp.einsum('bhs,bhsd->bhd', a, kc)
        return (C, nvec, m_new), h

    xs = (chunks(q), chunks(k), chunks(v), chunks(i_pre), chunks(jax.nn.log_sigmoid(f_pre.astype(f32))))
    state, hs = lax.scan(step, state, xs)
    return state, jnp.moveaxis(hs, 0, 2).reshape(B, H, n, v.shape[-1])


def odd_mixer(h_lat, h_ctx, need_ctx, w_in, conv_w, conv_b, gate_b, head_norm, w_out):
    f32 = jnp.float32

    def project(h):
        B, n = h.shape[:2]
        q, k, v, o, z, gates = _split(h @ w_in, ODD_SPLITS)
        qk = jax.nn.silu(dw_conv(jnp.concatenate([q, k], axis=-1), conv_w, conv_b))
        q, k = _split(qk, (ML_HEADS * ML_QK, ML_HEADS * ML_QK))
        q = q.reshape(B, n, ML_HEADS, ML_QK).transpose(0, 2, 1, 3)
        k = k.reshape(B, n, ML_HEADS, ML_QK).transpose(0, 2, 1, 3) * (ML_QK ** -0.5)
        v = v.reshape(B, n, ML_HEADS, ML_V).transpose(0, 2, 1, 3)
        gates = (gates + gate_b).astype(f32).reshape(B, n, 4, ML_HEADS).transpose(2, 0, 3, 1)
        return q, k, v, o, z, gates

    def flip(a):
        return jnp.flip(a, axis=2)

    ql, kl, vl, ol, zl, gl = project(h_lat)
    qc, kc, vc, oc, zc, gc = project(h_ctx)
    B = h_lat.shape[0]
    zero = (jnp.zeros((B, ML_HEADS, ML_V, ML_QK), f32), jnp.zeros((B, ML_HEADS, ML_QK), f32),
            jnp.zeros((B, ML_HEADS), f32))
    st_f, hc_f = mlstm_chunkwise(qc, kc, vc, gc[0], gc[1], zero)
    _, hl_f = mlstm_chunkwise(ql, kl, vl, gl[0], gl[1], st_f)
    st_b, hc_b = mlstm_chunkwise(flip(qc), flip(kc), flip(vc), flip(gc[2]), flip(gc[3]), zero)
    _, hl_b = mlstm_chunkwise(flip(ql), flip(kl), flip(vl), flip(gl[2]), flip(gl[3]), st_b)

    def finish(h_f, h_b, o, z):
        Bn, _, n, _ = h_f.shape
        h = (h_f + h_b).transpose(0, 2, 1, 3).reshape(Bn, n, ML_WIDTH).astype(o.dtype) * jax.nn.sigmoid(o)
        h = rms_norm(h.reshape(Bn, n, ML_HEADS, ML_V), head_norm.reshape(ML_HEADS, ML_V)).reshape(Bn, n, ML_WIDTH)
        return (h * jax.nn.silu(z)) @ w_out

    y_lat = finish(hl_f, flip(hl_b), ol, zl)
    y_ctx = finish(hc_f, flip(hc_b), oc, zc) if need_ctx else None
    return y_lat, y_ctx


def setup_inputs(seed: int = 0) -> dict:
    key = jax.random.key(seed)
    keys = jax.random.split(key, 32)
    f32 = jnp.float32

    def nrm(i, shape, scale):
        return jax.random.normal(keys[i], shape, f32) * scale

    D = D_MODEL
    forget_init = jnp.linspace(3.0, 6.0, ML_HEADS, dtype=f32)
    o_gate_b = jnp.concatenate([
        nrm(24, (N_ODD, ML_HEADS), 0.1),
        forget_init + nrm(25, (N_ODD, ML_HEADS), 0.1),
        nrm(26, (N_ODD, ML_HEADS), 0.1),
        forget_init + nrm(27, (N_ODD, ML_HEADS), 0.1)], axis=-1)
    return {
        'x': nrm(0, (BATCH, SEQ, D), 1.0),
        'c': nrm(1, (BATCH, D), 1.0),
        'ctx': nrm(2, (BATCH, CTX_LEN, D), 1.0),
        'c_ctx': nrm(3, (D,), 1.0),
        'w_mod': nrm(4, (DEPTH, D, 3 * D), D ** -0.5),
        'b_mod': nrm(5, (DEPTH, 3 * D), 0.02),
        'g_pre': 1.0 + nrm(6, (DEPTH, D), 0.02),
        'g_post': 1.0 + nrm(7, (DEPTH, D), 0.02),
        'e_w_in': nrm(8, (N_EVEN, D, EVEN_IN), D ** -0.5),
        'e_conv_w': nrm(9, (N_EVEN, HY_SHORT, 3 * HY_WIDTH), HY_SHORT ** -0.5),
        'e_conv_b': nrm(10, (N_EVEN, 3 * HY_WIDTH), 0.02),
        'e_filt_w1': nrm(11, (N_EVEN, HY_EMB, HY_HIDDEN), HY_EMB ** -0.5),
        'e_filt_b1': nrm(12, (N_EVEN, HY_HIDDEN), 0.1),
        'e_filt_freq': 1.0 + nrm(13, (N_EVEN, HY_HIDDEN), 0.02),
        'e_filt_w2': nrm(14, (N_EVEN, HY_HIDDEN, HY_HIDDEN), HY_HIDDEN ** -0.5),
        'e_filt_b2': nrm(15, (N_EVEN, HY_HIDDEN), 0.1),
        'e_filt_w3': nrm(16, (N_EVEN, HY_HIDDEN, 2 * HY_WIDTH), HY_HIDDEN ** -0.5),
        'e_hy_bias': nrm(17, (N_EVEN, HY_WIDTH), 0.1),
        'e_q_norm': 1.0 + nrm(18, (N_EVEN, HEAD_DIM), 0.02),
        'e_k_norm': 1.0 + nrm(19, (N_EVEN, HEAD_DIM), 0.02),
        'e_w_out': nrm(20, (N_EVEN, EVEN_MIX, D), EVEN_MIX ** -0.5),
        'o_w_in': nrm(21, (N_ODD, D, ODD_IN), D ** -0.5),
        'o_conv_w': nrm(22, (N_ODD, ML_SHORT, 2 * ML_HEADS * ML_QK), ML_SHORT ** -0.5),
        'o_conv_b': nrm(23, (N_ODD, 2 * ML_HEADS * ML_QK), 0.02),
        'o_gate_b': o_gate_b,
        'o_head_norm': 1.0 + nrm(28, (N_ODD, ML_WIDTH), 0.02),
        'o_w_out': nrm(29, (N_ODD, ML_WIDTH, D), ML_WIDTH ** -0.5),
    }


def reference(x, c, ctx, c_ctx, w_mod, b_mod, g_pre, g_post, e_w_in, e_conv_w, e_conv_b, e_filt_w1,
              e_filt_b1, e_filt_freq, e_filt_w2, e_filt_b2, e_filt_w3, e_hy_bias, e_q_norm, e_k_norm,
              e_w_out, o_w_in, o_conv_w, o_conv_b, o_gate_b, o_head_norm, o_w_out):
    n_lat = x.shape[1]
    ROWS = n_lat // GRID_W
    rows = jnp.repeat(jnp.arange(ROWS, dtype=jnp.int32), GRID_W)
    cols = jnp.tile(jnp.arange(GRID_W, dtype=jnp.int32), ROWS)
    x_lat, x_ctx = x, ctx
    for layer in range(DEPTH):
        need_ctx = layer < DEPTH - 1
        sh_l, sc_l, ga_l = adaln(c, w_mod[layer], b_mod[layer])
        sh_c, sc_c, ga_c = adaln(c_ctx, w_mod[layer], b_mod[layer])
        h_lat = rms_norm(x_lat, g_pre[layer]) * (1 + sc_l[:, None]) + sh_l[:, None]
        h_ctx = rms_norm(x_ctx, g_pre[layer]) * (1 + sc_c) + sh_c
        j = layer // 2
        if layer % 2 == 0:
            y_lat, y_ctx = even_mixer(h_lat, h_ctx, rows, cols, need_ctx, e_w_in[j], e_conv_w[j], e_conv_b[j],
                                      e_filt_w1[j], e_filt_b1[j], e_filt_freq[j], e_filt_w2[j], e_filt_b2[j],
                                      e_filt_w3[j], e_hy_bias[j], e_q_norm[j], e_k_norm[j], e_w_out[j])
        else:
            y_lat, y_ctx = odd_mixer(h_lat, h_ctx, need_ctx, o_w_in[j], o_conv_w[j], o_conv_b[j], o_gate_b[j],
                                     o_head_norm[j], o_w_out[j])
        x_lat = x_lat + ga_l[:, None] * rms_norm(y_lat, g_post[layer])
        if need_ctx:
            x_ctx = x_ctx + ga_c * rms_norm(y_ctx, g_post[layer])
    return x_lat
```

```cpp
#include <hip/hip_runtime.h>
#include <hip/hip_cooperative_groups.h>
#include <hip/hip_bf16.h>
#include <cstdio>
#include <cstdint>
#include <cmath>
namespace cg = cooperative_groups;
namespace pg8 {
#define PG8_LAS __attribute__((address_space(3)))
typedef unsigned short bf16_t;
typedef short bf16x8 __attribute__((ext_vector_type(8)));
typedef float f32x4 __attribute__((ext_vector_type(4)));
typedef unsigned u32x4 __attribute__((ext_vector_type(4)));
constexpr int BM = 256, BK = 64, HALF = 128, HTB = HALF * BK * 2  , STAGE_BYTES = 8 * HTB, NXCD = 8, WGM = 8;

__host__ __device__ __forceinline__ int lds_byte(int r, int c) { const int st = (r >> 4) * 2 + (c >> 5), rr = r & 15, cc = c & 31, ob = rr * 64 + cc * 2; return st * 1024 + (ob ^ (((ob >> 9) & 1) << 5)); }
__host__ __device__ __forceinline__ void stage_rc(int b, int& R, int& C) { const int st = b / 1024, sb = b % 1024, swz = sb ^ (((sb >> 9) & 1) << 5); R = (st >> 1) * 16 + swz / 64; C = (st & 1) * 32 + (swz % 64) / 2; }
__host__ __device__ __forceinline__ int perm32(int rho) { const int n = rho >> 4, i = rho & 15; return 8 * (i >> 2) + 4 * n + (i & 3); }

struct Unit { int pm, pn; };
struct Gemm { const bf16_t* A; const bf16_t* Bt; int M, N, K; const bf16_t* A2; int split_pm; };

struct StaticOrder {
    int nM, nN, nwg, G, c;
    __host__ __device__ void init(int M, int N, int G_, int c_) { nM = M / BM; nN = N / BM; nwg = nM * nN; G = G_; c = c_; }
    __host__ __device__ bool next(int i, Unit& u) const {
        const long L = (long)i * G + c; if (L >= nwg) return false;
        int wgid = (int)L; { const int q = nwg / NXCD, r = nwg % NXCD, xcd = wgid % NXCD, off = wgid / NXCD; wgid = (xcd < r ? xcd * (q + 1) : r * (q + 1) + (xcd - r) * q) + off; }
        const int nig = WGM * nN, gid = wgid / nig, fm = gid * WGM, gsz = (nM - fm) < WGM ? (nM - fm) : WGM;
        u.pm = fm + ((wgid % nig) % gsz); u.pn = (wgid % nig) / gsz; return true;
    }
    __device__ __forceinline__ void a_ready(const Unit&) const {}
    __device__ __forceinline__ void done(const Unit&) const {}
};

__device__ __forceinline__ unsigned cvt_pk_bf16(float lo, float hi) { unsigned r; asm volatile("v_cvt_pk_bf16_f32 %0, %1, %2" : "=v"(r) : "v"(lo), "v"(hi)); return r; }
typedef float f32x2 __attribute__((ext_vector_type(2)));
__device__ __forceinline__ f32x2 gelu_pk(f32x2 v) {
    const f32x2 av = __builtin_elementwise_abs(v), d = av * 0.2316418882f + 1.0f;
    f32x2 t; t.x = __builtin_amdgcn_rcpf(d.x); t.y = __builtin_amdgcn_rcpf(d.y);
    f32x2 q = t * 0.5307027145f + (-0.7265760135f); q = q * t + 0.7107068705f; q = q * t + (-0.142248368f); q = q * t + 0.127414796f; q = q * t;
    const f32x2 s = (v * v) * (-0.72134752044f);
    f32x2 e; e.x = __builtin_amdgcn_exp2f(s.x); e.y = __builtin_amdgcn_exp2f(s.y);
    const f32x2 m = v * (q * e), r = v - m;
    f32x2 o; o.x = v.x < 0.f ? m.x : r.x; o.y = v.y < 0.f ? m.y : r.y; return o;
}

template <int ACT  > struct EpiBf16 {
    static constexpr bool PERM = true, AFTER_DRAIN = false; static_assert(ACT == 0 || ACT == 1, "EpiBf16: ACT is 0 (none) or 1 (gelu_pk)");
    bf16_t* O; int ldc; const float* bias; int split_cols; size_t split_stride; float scale0;
    __device__ __forceinline__ void operator()(const f32x4 (&acc)[2][2][4][2], const Unit& u, int wr, int wc, int fr, int fq) const {
        const int row0 = u.pm * BM + wr * 64 + fr; int colt = u.pn * BM; bf16_t* base = O;
        float sc = 1.f; if (split_cols) { const int t = colt / split_cols; base += (size_t)t * split_stride; colt -= t * split_cols; if (t == 0) sc = scale0; }
        const int col0 = colt + wc * 32 + 8 * fq, bcol0 = u.pn * BM + wc * 32 + 8 * fq;
        f32x4 bv[2][2];
#pragma unroll
        for (int bj = 0; bj < 2; ++bj)
#pragma unroll
            for (int n = 0; n < 2; ++n) bv[bj][n] = bias ? *(const f32x4*)(bias + bcol0 + bj * HALF + 4 * n) : (f32x4){0.f, 0.f, 0.f, 0.f};
#pragma unroll
        for (int ai = 0; ai < 2; ++ai)
#pragma unroll
            for (int m = 0; m < 4; ++m) { bf16_t* rowp = base + (size_t)(row0 + ai * HALF + m * 16) * ldc + col0;
#pragma unroll
                for (int bj = 0; bj < 2; ++bj) { f32x4 v0 = acc[ai][bj][m][0] + bv[bj][0], v1 = acc[ai][bj][m][1] + bv[bj][1];
                    if (ACT == 1) { f32x2 a = gelu_pk((f32x2){v0[0], v0[1]}), b = gelu_pk((f32x2){v0[2], v0[3]}), c = gelu_pk((f32x2){v1[0], v1[1]}), d = gelu_pk((f32x2){v1[2], v1[3]});
                        v0 = (f32x4){a.x, a.y, b.x, b.y}; v1 = (f32x4){c.x, c.y, d.x, d.y}; }
                    v0 = v0 * sc; v1 = v1 * sc; u32x4 w; w.x = cvt_pk_bf16(v0[0], v0[1]); w.y = cvt_pk_bf16(v0[2], v0[3]); w.z = cvt_pk_bf16(v1[0], v1[1]); w.w = cvt_pk_bf16(v1[2], v1[3]);
                    *(u32x4*)(rowp + bj * HALF) = w; } }
    }
};
struct EpiF32 {
    static constexpr bool PERM = false, AFTER_DRAIN = false;
    float* C; int ldc; const float* bias;
    __device__ __forceinline__ void operator()(const f32x4 (&acc)[2][2][4][2], const Unit& u, int wr, int wc, int fr, int fq) const {
        const int row0 = u.pm * BM + wr * 64 + fr, col0 = u.pn * BM + wc * 32 + 4 * fq;
        f32x4 bv[2][2];
#pragma unroll
        for (int bj = 0; bj < 2; ++bj)
#pragma unroll
            for (int n = 0; n < 2; ++n) bv[bj][n] = bias ? *(const f32x4*)(bias + col0 + bj * HALF + n * 16) : (f32x4){0.f, 0.f, 0.f, 0.f};
#pragma unroll
        for (int ai = 0; ai < 2; ++ai)
#pragma unroll
            for (int m = 0; m < 4; ++m) { float* rowp = C + (size_t)(row0 + ai * HALF + m * 16) * ldc + col0;
#pragma unroll
                for (int bj = 0; bj < 2; ++bj)
#pragma unroll
                    for (int n = 0; n < 2; ++n) *(f32x4*)(rowp + bj * HALF + n * 16) = acc[ai][bj][m][n] + bv[bj][n]; }
    }
};
template <class Epi, class Sched, bool ALIGN_EPI = false, bool SP2 = false>
__device__ __forceinline__ void gemm_phase(PG8_LAS unsigned char* lds, const Gemm g, const Sched& S, const Epi& E) {
    const int tid = threadIdx.x, wid = __builtin_amdgcn_readfirstlane(tid >> 6), lane = tid & 63, wr = wid >> 2, wc = wid & 3, fr = lane & 15, fq = lane >> 4;
    const int K = g.K, nt = K / BK;
    unsigned voffA[2], voffB[2];
#pragma unroll
    for (int i = 0; i < 2; ++i) { int R, C; stage_rc(tid * 16 + i * 8192, R, C); const int Rb = Epi::PERM ? ((R & ~31) + perm32(R & 31)) : R;
        voffA[i] = (unsigned)(R * K + C) * 2u; voffB[i] = (unsigned)(Rb * K + C) * 2u; }
    const size_t kstep = (size_t)(BK * 2);
    const size_t hstep = (size_t)HALF * K * 2;
    const size_t tstep = 2 * hstep;
    const unsigned ldsw = (unsigned)wid * 1024u;
    const int aoff = lds_byte(wr * 64 + fr, fq * 8), boff = lds_byte(wc * 32 + fr, fq * 8);
#define PG8_ABASE(pm_) (((pm_) < g.split_pm) ? ((const char*)g.A + (size_t)(pm_) * tstep) : ((const char*)g.A2 + (size_t)((pm_) - g.split_pm) * tstep))
#define PG8_SA(b, h) (((b) * 2 + (h)) * HTB)
#define PG8_SB(b, h) ((4 + (b) * 2 + (h)) * HTB)
#define PG8_STAGE(bufoff, gbase, voff) do { _Pragma("unroll") for (int _i = 0; _i < 2; ++_i) \
        __builtin_amdgcn_global_load_lds((const unsigned*)((const char*)(gbase) + (voff)[_i]), (PG8_LAS unsigned*)(lds + (bufoff) + ldsw + _i * 8192), 16, 0, 0); } while (0)
#define PG8_LDA(dst, b, h) do { _Pragma("unroll") for (int m = 0; m < 4; ++m) _Pragma("unroll") for (int k = 0; k < 2; ++k) dst[m][k] = *(const PG8_LAS bf16x8*)(lds + PG8_SA(b, h) + aoff + m * 2048 + k * 1024); } while (0)
#define PG8_LDB(dst, b, h) do { _Pragma("unroll") for (int n = 0; n < 2; ++n) _Pragma("unroll") for (int k = 0; k < 2; ++k) dst[n][k] = *(const PG8_LAS bf16x8*)(lds + PG8_SB(b, h) + boff + n * 2048 + k * 1024); } while (0)
#define PG8_MMA(ai, bj, At, Bt) do { __builtin_amdgcn_s_setprio(1); _Pragma("unroll") for (int m = 0; m < 4; ++m) _Pragma("unroll") for (int n = 0; n < 2; ++n) _Pragma("unroll") for (int k = 0; k < 2; ++k) \
        acc[ai][bj][m][n] = __builtin_amdgcn_mfma_f32_16x16x32_bf16(Bt[n][k], At[m][k], acc[ai][bj][m][n], 0, 0, 0); __builtin_amdgcn_s_setprio(0); } while (0)
#define PG8_WAIT_V(n) asm volatile("s_waitcnt vmcnt(" #n ")" ::: "memory")
#define PG8_WAIT_L(n) asm volatile("s_waitcnt lgkmcnt(" #n ")" ::: "memory")
#define PG8_BAR __builtin_amdgcn_s_barrier()
#define PG8_SCHED __builtin_amdgcn_sched_barrier(0)
    Unit cur, nxt; int ui = 0;
    if (!S.next(0, cur)) return;
    f32x4 acc[2][2][4][2];
#pragma unroll
    for (int a = 0; a < 2; ++a)
#pragma unroll
        for (int b = 0; b < 2; ++b)
#pragma unroll
            for (int m = 0; m < 4; ++m)
#pragma unroll
                for (int n = 0; n < 2; ++n) acc[a][b][m][n] = (f32x4){0.f, 0.f, 0.f, 0.f};
    bf16x8 At[4][2], B0[2][2], B1[2][2];
    const char* cA = PG8_ABASE(cur.pm); const char* cB = (const char*)g.Bt + (size_t)cur.pn * tstep;
    S.a_ready(cur);
    if constexpr (SP2) {
        PG8_STAGE(PG8_SB(0, 0), cB, voffB); PG8_STAGE(PG8_SB(0, 1), cB + hstep, voffB); PG8_STAGE(PG8_SA(0, 0), cA, voffA); PG8_STAGE(PG8_SA(0, 1), cA + hstep, voffA);
        if (wr == 1) PG8_BAR;
        PG8_WAIT_V(2); PG8_BAR;
        PG8_STAGE(PG8_SB(1, 0), cB + kstep, voffB); PG8_STAGE(PG8_SA(1, 0), cA + kstep, voffA); PG8_STAGE(PG8_SB(1, 1), cB + hstep + kstep, voffB);
        PG8_WAIT_V(6); PG8_BAR;
    } else {
        PG8_STAGE(PG8_SB(0, 0), cB, voffB); PG8_STAGE(PG8_SA(0, 0), cA, voffA); PG8_STAGE(PG8_SB(0, 1), cB + hstep, voffB); PG8_STAGE(PG8_SA(0, 1), cA + hstep, voffA);
        if (wr == 1) PG8_BAR;
        PG8_WAIT_V(4); PG8_BAR;
        PG8_STAGE(PG8_SB(1, 0), cB + kstep, voffB); PG8_STAGE(PG8_SA(1, 0), cA + kstep, voffA); PG8_STAGE(PG8_SB(1, 1), cB + hstep + kstep, voffB);
        PG8_WAIT_V(6); PG8_BAR;
    }
    for (;;) {
        const bool has_next = S.next(ui + 1, nxt);
        const char* nA = has_next ? PG8_ABASE(nxt.pm) : cA; const char* nB = has_next ? (const char*)g.Bt + (size_t)nxt.pn * tstep : cB;
        for (int t = 0; t < nt; t += 2) {
            const bool last = (t == nt - 2);
            const char* a1 = cA + (size_t)(t + 1) * kstep;
            const char* a2 = last ? nA : cA + (size_t)(t + 2) * kstep; const char* b2 = last ? nB : cB + (size_t)(t + 2) * kstep;
            const char* a3 = a2 + kstep; const char* b3 = b2 + kstep;
            if (last && has_next) S.a_ready(nxt);
            if constexpr (SP2) {
            PG8_LDB(B0, 0, 0); PG8_LDB(B1, 0, 1); PG8_SCHED; PG8_LDA(At, 0, 0); PG8_STAGE(PG8_SA(1, 1), a1 + hstep, voffA);
            PG8_WAIT_V(8); PG8_WAIT_L(0); PG8_BAR; PG8_MMA(0, 0, At, B0); PG8_MMA(0, 1, At, B1); PG8_BAR; PG8_SCHED;
            PG8_LDA(At, 0, 1); PG8_STAGE(PG8_SB(0, 0), b2, voffB); PG8_STAGE(PG8_SB(0, 1), b2 + hstep, voffB); PG8_STAGE(PG8_SA(0, 0), a2, voffA);
            PG8_WAIT_V(8); PG8_WAIT_L(0); PG8_BAR; PG8_MMA(1, 0, At, B0); PG8_MMA(1, 1, At, B1); PG8_BAR; PG8_SCHED;
            PG8_LDB(B0, 1, 0); PG8_LDB(B1, 1, 1); PG8_SCHED; PG8_LDA(At, 1, 0); PG8_STAGE(PG8_SA(0, 1), a2 + hstep, voffA);
            PG8_WAIT_V(8); PG8_WAIT_L(0); PG8_BAR; PG8_MMA(0, 0, At, B0); PG8_MMA(0, 1, At, B1); PG8_BAR; PG8_SCHED;
            PG8_LDA(At, 1, 1); PG8_STAGE(PG8_SB(1, 0), b3, voffB); PG8_STAGE(PG8_SB(1, 1), b3 + hstep, voffB); PG8_STAGE(PG8_SA(1, 0), a3, voffA);
            PG8_WAIT_V(8); PG8_WAIT_L(0); PG8_BAR; PG8_MMA(1, 0, At, B0); PG8_MMA(1, 1, At, B1); PG8_BAR; PG8_SCHED;
            } else {
            PG8_LDB(B0, 0, 0); PG8_SCHED; PG8_LDA(At, 0, 0); PG8_STAGE(PG8_SA(1, 1), a1 + hstep, voffA);
            PG8_WAIT_L(8); PG8_BAR; PG8_WAIT_L(0); PG8_MMA(0, 0, At, B0); PG8_BAR; PG8_SCHED;
            PG8_LDB(B1, 0, 1); PG8_STAGE(PG8_SB(0, 0), b2, voffB);
            PG8_BAR; PG8_WAIT_L(0); PG8_MMA(0, 1, At, B1); PG8_BAR;
            PG8_LDA(At, 0, 1); PG8_STAGE(PG8_SA(0, 0), a2, voffA);
            PG8_BAR; PG8_WAIT_L(0); PG8_MMA(1, 0, At, B0); PG8_BAR; PG8_SCHED;
            PG8_STAGE(PG8_SB(0, 1), b2 + hstep, voffB);
            PG8_WAIT_V(6); PG8_BAR; PG8_MMA(1, 1, At, B1); PG8_BAR;
            PG8_LDB(B0, 1, 0); PG8_SCHED; PG8_LDA(At, 1, 0); PG8_STAGE(PG8_SA(0, 1), a2 + hstep, voffA);
            PG8_WAIT_L(8); PG8_BAR; PG8_WAIT_L(0); PG8_MMA(0, 0, At, B0); PG8_BAR; PG8_SCHED;
            PG8_LDB(B1, 1, 1); PG8_STAGE(PG8_SB(1, 0), b3, voffB);
            PG8_BAR; PG8_WAIT_L(0); PG8_MMA(0, 1, At, B1); PG8_BAR;
            PG8_LDA(At, 1, 1); PG8_STAGE(PG8_SA(1, 0), a3, voffA);
            PG8_BAR; PG8_WAIT_L(0); PG8_MMA(1, 0, At, B0); PG8_BAR; PG8_SCHED;
            PG8_STAGE(PG8_SB(1, 1), b3 + hstep, voffB);
            PG8_WAIT_V(6); PG8_BAR; PG8_MMA(1, 1, At, B1); PG8_BAR;
            }
        }
        if constexpr (ALIGN_EPI) { if (wr == 0) PG8_BAR; }
        if constexpr (!Epi::AFTER_DRAIN) { E(acc, cur, wr, wc, fr, fq); S.done(cur); }
        if (!has_next) break;
#pragma unroll
        for (int a = 0; a < 2; ++a)
#pragma unroll
            for (int b = 0; b < 2; ++b)
#pragma unroll
                for (int m = 0; m < 4; ++m)
#pragma unroll
                    for (int n = 0; n < 2; ++n) acc[a][b][m][n] = (f32x4){0.f, 0.f, 0.f, 0.f};
        cur = nxt; cA = nA; cB = nB; ++ui;
        if constexpr (ALIGN_EPI) { if (wr == 1) PG8_BAR; }
    }
    PG8_WAIT_V(0);
    if constexpr (!ALIGN_EPI) { if (wr == 0) PG8_BAR; }
    PG8_BAR;
    if constexpr (Epi::AFTER_DRAIN) { E.fused(acc, cur, wr, wc, fr, fq, lds, wid, lane); S.done(cur); }
#undef PG8_SA
#undef PG8_ABASE
#undef PG8_SB
#undef PG8_STAGE
#undef PG8_LDA
#undef PG8_LDB
#undef PG8_MMA
#undef PG8_WAIT_V
#undef PG8_WAIT_L
#undef PG8_BAR
#undef PG8_SCHED
}
}
namespace pg8 {
__device__ __forceinline__ unsigned short f2bf_rne(float f) { unsigned u = __builtin_bit_cast(unsigned, f); return (unsigned short)((u + 0x7fffu + ((u >> 16) & 1u)) >> 16); }
struct EpiL0 {
    static constexpr bool PERM = true, AFTER_DRAIN = false;
    bf16_t* xvt_lat; bf16_t* xvt_ctx; bf16_t* qkvg;
    __device__ __forceinline__ void operator()(const f32x4 (&acc)[2][2][4][2], const Unit& u, int wr, int wc, int fr, int fq) const {
        if (u.pn >= 16) {
            const int row0 = u.pm * BM + wr * 64 + fr; const int col0 = (u.pn - 16) * BM + wc * 32 + 8 * fq;
#pragma unroll
            for (int ai = 0; ai < 2; ++ai)
#pragma unroll
                for (int m = 0; m < 4; ++m) { bf16_t* rowp = qkvg + (size_t)(row0 + ai * HALF + m * 16) * 2560 + col0;
#pragma unroll
                    for (int bj = 0; bj < 2; ++bj) { const f32x4 v0 = acc[ai][bj][m][0], v1 = acc[ai][bj][m][1];
                        u32x4 w; w.x = cvt_pk_bf16(v0[0], v0[1]); w.y = cvt_pk_bf16(v0[2], v0[3]); w.z = cvt_pk_bf16(v1[0], v1[1]); w.w = cvt_pk_bf16(v1[2], v1[3]);
                        *(u32x4*)(rowp + bj * HALF) = w; } }
        } else {
            bf16_t* dst; int nt, t0;
            if (u.pm < 64) { const int b = u.pm >> 4; nt = 4096; t0 = (u.pm & 15) * 256; dst = xvt_lat + (size_t)b * 4096 * 4096; }
            else { const int b = u.pm - 64; nt = 256; t0 = 0; dst = xvt_ctx + (size_t)b * 4096 * 256; }
            const int ch0 = u.pn * BM + wc * 32 + 8 * fq; const int tl0 = t0 + wr * 64 + fr;
#pragma unroll
            for (int bj = 0; bj < 2; ++bj)
#pragma unroll
                for (int n = 0; n < 2; ++n)
#pragma unroll
                    for (int j = 0; j < 4; ++j) { bf16_t* cp = dst + (size_t)(ch0 + bj * HALF + 4 * n + j) * nt + tl0;
#pragma unroll
                        for (int ai = 0; ai < 2; ++ai)
#pragma unroll
                            for (int m = 0; m < 4; ++m) cp[ai * HALF + m * 16] = f2bf_rne(acc[ai][bj][m][n][j]); }
        }
    }
};
struct EpiL1a {
    static constexpr bool PERM = true, AFTER_DRAIN = false;
    bf16_t* y; float* gates; const float* gate_b;
    __device__ __forceinline__ void operator()(const f32x4 (&acc)[2][2][4][2], const Unit& u, int wr, int wc, int fr, int fq) const {
        const int row0 = u.pm * BM + wr * 64 + fr;
        if (u.pn < 16) {
            const int col0 = u.pn * BM + wc * 32 + 8 * fq;
#pragma unroll
            for (int ai = 0; ai < 2; ++ai)
#pragma unroll
                for (int m = 0; m < 4; ++m) { bf16_t* rowp = y + (size_t)(row0 + ai * HALF + m * 16) * 4096 + col0;
#pragma unroll
                    for (int bj = 0; bj < 2; ++bj) { const f32x4 v0 = acc[ai][bj][m][0], v1 = acc[ai][bj][m][1];
                        u32x4 w; w.x = cvt_pk_bf16(v0[0], v0[1]); w.y = cvt_pk_bf16(v0[2], v0[3]); w.z = cvt_pk_bf16(v1[0], v1[1]); w.w = cvt_pk_bf16(v1[2], v1[3]);
                        *(u32x4*)(rowp + bj * HALF) = w; } }
        } else if (wc == 0) {
            const int c0 = 8 * fq;
            const f32x4 b0 = *(const f32x4*)(gate_b + c0), b1 = *(const f32x4*)(gate_b + c0 + 4);
#pragma unroll
            for (int ai = 0; ai < 2; ++ai)
#pragma unroll
                for (int m = 0; m < 4; ++m) { float* rowp = gates + (size_t)(row0 + ai * HALF + m * 16) * 32 + c0;
                    *(f32x4*)(rowp) = acc[ai][0][m][0] + b0; *(f32x4*)(rowp + 4) = acc[ai][0][m][1] + b1; }
        }
    }
};
}
namespace attn {
using bf16 = unsigned short;
constexpr int D = 128, NW = 8, QBLK = 32, KVBLK = 64;
constexpr float SCALE = 0.088388347648318440f;
constexpr float THR = 8.f;
constexpr int SDEPTH = 2;
constexpr int LDQ = 2560, LDK = 2560, LDO = 2048, VOFF = 256, GOFF = 1536;
constexpr size_t SHM_V = KVBLK * D * 2, SHM_K = KVBLK * D * 2, SHM_ATTN = 2 * SHM_V + 2 * SHM_K + NW * 64 * 4;
using bf16x8 = __attribute__((ext_vector_type(8))) short;
using s16x4  = __attribute__((ext_vector_type(4))) short;
using f32x16 = __attribute__((ext_vector_type(16))) float;
using u32x4  = __attribute__((ext_vector_type(4))) unsigned;
#define KSWZ(row, colB) ((row) * 256 + ((colB) ^ (((row) & 7) << 4)))
#define SBAR() __builtin_amdgcn_sched_barrier(0)
__device__ __forceinline__ int crow(int r, int hi) { return (r & 3) + 8 * (r >> 2) + 4 * hi; }
__device__ __forceinline__ unsigned cvtpk(float lo, float hi) { unsigned r; asm volatile("v_cvt_pk_bf16_f32 %0, %1, %2" : "=v"(r) : "v"(lo), "v"(hi)); return r; }
__device__ __forceinline__ bf16x8 ld8(const bf16* p) { return *reinterpret_cast<const bf16x8*>(p); }
__device__ __forceinline__ void partialSM(f32x16& p0, f32x16& p1, float& m_reg, float& mn, float& alpha) {
  constexpr float C = SCALE * 1.4426950408889634f;
  float pmax = p0[0]; for (int r = 1; r < 16; ++r) pmax = fmaxf(pmax, p0[r]); for (int r = 0; r < 16; ++r) pmax = fmaxf(pmax, p1[r]);
  { auto rr = __builtin_amdgcn_permlane32_swap(__float_as_uint(pmax), __float_as_uint(pmax), false, false);
    pmax = fmaxf(__uint_as_float(rr[0]), __uint_as_float(rr[1])); }
  if (__builtin_expect(__all(pmax - m_reg <= THR / SCALE), 1)) { mn = m_reg; alpha = 1.f; }
  else { mn = fmaxf(m_reg, pmax); alpha = __builtin_amdgcn_exp2f((m_reg - mn) * C); m_reg = mn; }
  float mnC = -mn * C;
  for (int r = 0; r < 16; ++r) p0[r] = fmaf(p0[r], C, mnC); for (int r = 0; r < 16; ++r) p1[r] = fmaf(p1[r], C, mnC);
  for (int r = 0; r < 16; ++r) p0[r] = __builtin_amdgcn_exp2f(p0[r]);
}
__device__ __forceinline__ void finishSM(f32x16& p0, f32x16& p1, float alpha, float& l_reg, bf16x8& pa0, bf16x8& pa1, bf16x8& pa2, bf16x8& pa3) {
  for (int r = 0; r < 16; ++r) p1[r] = __builtin_amdgcn_exp2f(p1[r]);
  float ps = 0; for (int r = 0; r < 16; ++r) ps += p0[r]; for (int r = 0; r < 16; ++r) ps += p1[r];
  { auto rr = __builtin_amdgcn_permlane32_swap(__float_as_uint(ps), __float_as_uint(ps), false, false);
    ps = __uint_as_float(rr[0]) + __uint_as_float(rr[1]); }
  l_reg = l_reg * alpha + ps;
#define PK4(P, BASE, OUT) do { unsigned a0 = cvtpk(P[BASE + 0], P[BASE + 1]), a1 = cvtpk(P[BASE + 2], P[BASE + 3]);   \
    unsigned b0 = cvtpk(P[BASE + 4], P[BASE + 5]), b1 = cvtpk(P[BASE + 6], P[BASE + 7]);                              \
    auto r0 = __builtin_amdgcn_permlane32_swap(a0, b0, false, false); auto r1 = __builtin_amdgcn_permlane32_swap(a1, b1, false, false); \
    u32x4 w = {r0[0], r1[0], r0[1], r1[1]}; OUT = *reinterpret_cast<bf16x8*>(&w); } while (0)
  PK4(p0, 0, pa0); PK4(p0, 8, pa1); PK4(p1, 0, pa2); PK4(p1, 8, pa3);
#undef PK4
}
__device__ __forceinline__ void qkt(f32x16& p0, f32x16& p1, const bf16* Ks, const bf16x8* qr, int r32, int hi) {
  p0 = f32x16{}; p1 = f32x16{};
  for (int d0 = 0; d0 < 8; ++d0) { int cb = (d0 * 16 + hi * 8) * 2;
    bf16x8 b0 = *reinterpret_cast<const bf16x8*>((const char*)Ks + KSWZ(r32, cb));
    bf16x8 b1 = *reinterpret_cast<const bf16x8*>((const char*)Ks + KSWZ(32 + r32, cb));
    p0 = __builtin_amdgcn_mfma_f32_32x32x16_bf16(b0, qr[d0], p0, 0, 0, 0);
    p1 = __builtin_amdgcn_mfma_f32_32x32x16_bf16(b1, qr[d0], p1, 0, 0, 0); }
}
__device__ __forceinline__ int v_st(int k, int c) { const int kk = (k & ~0xC) | ((k & 4) << 1) | ((k & 8) >> 1); return ((kk >> 3) * 4 + (c >> 5)) * 512 + ((kk & 7) * 32 + (c & 31)) * 2; }
__device__ __forceinline__ int v_rd_base(int lane) { return ((lane & 3) << 3) | (((lane >> 2) & 3) << 6) | (((lane >> 4) & 1) << 5) | (((lane >> 5) & 1) << 8); }
constexpr int v_rd_off(int d0, int ks, int half) { return d0 * 512 + ks * 4096 + half * 2048; }
template <int OFF> __device__ __forceinline__ s16x4 tr_read(int vb) {
  s16x4 r; asm volatile("ds_read_b64_tr_b16 %0, %1 offset:%2" : "=&v"(r) : "v"(vb), "i"(OFF) : "memory"); return r;
}
template <int D0> __device__ __forceinline__ void pv_one(f32x16& od, int vb, bf16x8 pa0, bf16x8 pa1, bf16x8 pa2, bf16x8 pa3) {
  const s16x4 l0 = tr_read<v_rd_off(D0, 0, 0)>(vb), h0 = tr_read<v_rd_off(D0, 0, 1)>(vb), l1 = tr_read<v_rd_off(D0, 1, 0)>(vb), h1 = tr_read<v_rd_off(D0, 1, 1)>(vb);
  const s16x4 l2 = tr_read<v_rd_off(D0, 2, 0)>(vb), h2 = tr_read<v_rd_off(D0, 2, 1)>(vb), l3 = tr_read<v_rd_off(D0, 3, 0)>(vb), h3 = tr_read<v_rd_off(D0, 3, 1)>(vb);
  asm volatile("s_waitcnt lgkmcnt(0)" ::: "memory"); SBAR();
#define PK(L, H) (bf16x8){L[0], L[1], L[2], L[3], H[0], H[1], H[2], H[3]}
  od = __builtin_amdgcn_mfma_f32_32x32x16_bf16(pa0, PK(l0, h0), od, 0, 0, 0);
  od = __builtin_amdgcn_mfma_f32_32x32x16_bf16(pa1, PK(l1, h1), od, 0, 0, 0);
  od = __builtin_amdgcn_mfma_f32_32x32x16_bf16(pa2, PK(l2, h2), od, 0, 0, 0);
  od = __builtin_amdgcn_mfma_f32_32x32x16_bf16(pa3, PK(l3, h3), od, 0, 0, 0);
#undef PK
}
__device__ __forceinline__ void pv_d0(f32x16* o, int vb, bf16x8 pa0, bf16x8 pa1, bf16x8 pa2, bf16x8 pa3) {
  pv_one<0>(o[0], vb, pa0, pa1, pa2, pa3); pv_one<1>(o[1], vb, pa0, pa1, pa2, pa3); pv_one<2>(o[2], vb, pa0, pa1, pa2, pa3); pv_one<3>(o[3], vb, pa0, pa1, pa2, pa3);
}
__device__ __forceinline__ void attn_dense_body(const bf16* __restrict__ Qb, __amdgpu_buffer_rsrc_t kvrs, unsigned kb0, unsigned kb1, int seg0, const bf16* __restrict__ Gb,
                                                bf16* __restrict__ Ob, int seq, char* lds) {
  int tid_ = threadIdx.x; asm volatile("" : "+v"(tid_));
  const int tid = tid_, wid = tid >> 6, lane = tid & 63, r32 = lane & 31, hi = lane >> 5;
  bf16* V_lds = (bf16*)lds; bf16* K_lds = (bf16*)(lds + 2 * SHM_V);
  float* ws = (float*)(lds + 2 * SHM_V + 2 * SHM_K) + wid * 64; float* li_l = ws; float* al_l = ws + 32;
  float m_reg = -1e30f, l_reg = 0; f32x16 o[4] = {}; bf16x8 qr[8];
  const bf16* Qw = Qb + (long)(wid * QBLK + r32) * LDQ + hi * 8;
#pragma unroll
  for (int d0 = 0; d0 < 8; ++d0) qr[d0] = ld8(Qw + d0 * 16);
  const int sr = tid >> 4, sc = (tid & 15) * 8, vst0 = v_st(sr, sc), vst1 = v_st(32 + sr, sc);
  const int vb0 = (int)(uintptr_t)V_lds + v_rd_base(lane);
  struct { bf16x8 vs0, vs1, ks0, ks1; } sr_[SDEPTH];
  const unsigned vo0 = (unsigned)(sr * LDK + sc) * 2u, vo1 = (unsigned)((32 + sr) * LDK + sc) * 2u;
#define BLD(vo, so) __builtin_bit_cast(bf16x8, __builtin_amdgcn_raw_buffer_load_b128(kvrs, (int)(vo), (int)(so), 0))
#define SLOAD(i, k0) do { const unsigned so_ = ((k0) < seg0) ? kb0 + (unsigned)(k0) * (LDK * 2) : kb1 + (unsigned)((k0) - seg0) * (LDK * 2); \
    sr_[i].vs0 = BLD(vo0 + VOFF * 2, so_); sr_[i].vs1 = BLD(vo1 + VOFF * 2, so_); \
    sr_[i].ks0 = BLD(vo0, so_); sr_[i].ks1 = BLD(vo1, so_); } while (0)
#define SWRITE(b, i) do { *(bf16x8*)((char*)V_lds + (b) * SHM_V + vst0) = sr_[i].vs0;          \
    *(bf16x8*)((char*)V_lds + (b) * SHM_V + vst1) = sr_[i].vs1; int kc = sc * 2;               \
    *(bf16x8*)((char*)K_lds + (b) * SHM_K + KSWZ(sr, kc)) = sr_[i].ks0;                       \
    *(bf16x8*)((char*)K_lds + (b) * SHM_K + KSWZ(32 + sr, kc)) = sr_[i].ks1; } while (0)
#define SWAIT() do { asm volatile("s_waitcnt vmcnt(4)" ::: "memory"); } while (0)
#define RESC(a) do { if (__any((a) < 1.f)) { if (hi == 0) al_l[r32] = (a); asm volatile("s_waitcnt lgkmcnt(0)" ::: "memory"); \
    for (int d = 0; d < 4; ++d) for (int r = 0; r < 16; ++r) o[d][r] *= al_l[crow(r, hi)]; } } while (0)
  f32x16 pA0, pA1, pB0, pB1; float mnA, mnB, alA, alB; bf16x8 pa0, pa1, pa2, pa3; const int NT = seq / KVBLK;
  constexpr int SE = 0, SO = SDEPTH - 1;
  SLOAD(SE, 0); asm volatile("s_waitcnt vmcnt(0)" ::: "memory"); SWRITE(0, SE); __syncthreads();
  qkt(pA0, pA1, K_lds, qr, r32, hi); partialSM(pA0, pA1, m_reg, mnA, alA);
  SLOAD(SO, KVBLK); if (2 < NT) SLOAD(SE, 2 * KVBLK);
  SWAIT(); SWRITE(1, SO); __syncthreads();
  for (int j = 1; j + 1 < NT; j += 2) {
    SBAR(); qkt(pB0, pB1, (bf16*)((char*)K_lds + SHM_K), qr, r32, hi);
    finishSM(pA0, pA1, alA, l_reg, pa0, pa1, pa2, pa3); SBAR();
    SLOAD(SO, (j + SDEPTH) * KVBLK); SBAR();
    pv_d0(o, vb0, pa0, pa1, pa2, pa3); partialSM(pB0, pB1, m_reg, mnB, alB);
    __syncthreads(); SWAIT(); SWRITE(0, SE);
    RESC(alB); __syncthreads();
    SBAR(); qkt(pA0, pA1, K_lds, qr, r32, hi);
    finishSM(pB0, pB1, alB, l_reg, pa0, pa1, pa2, pa3); SBAR();
    if (j + 3 < NT) SLOAD(SE, (j + 1 + SDEPTH) * KVBLK); SBAR();
    pv_d0(o, vb0 + (int)SHM_V, pa0, pa1, pa2, pa3); partialSM(pA0, pA1, m_reg, mnA, alA);
    __syncthreads(); SWAIT(); SWRITE(1, SO);
    RESC(alA); __syncthreads();
  }
  SBAR(); qkt(pB0, pB1, (bf16*)((char*)K_lds + SHM_K), qr, r32, hi);
  finishSM(pA0, pA1, alA, l_reg, pa0, pa1, pa2, pa3); SBAR();
  pv_d0(o, vb0, pa0, pa1, pa2, pa3); partialSM(pB0, pB1, m_reg, mnB, alB);
  __syncthreads(); RESC(alB);
  finishSM(pB0, pB1, alB, l_reg, pa0, pa1, pa2, pa3); SBAR();
  pv_d0(o, vb0 + (int)SHM_V, pa0, pa1, pa2, pa3);
  if (hi == 0) li_l[r32] = l_reg; asm volatile("s_waitcnt lgkmcnt(0)" ::: "memory");
  float rli[16];
#pragma unroll
  for (int r = 0; r < 16; ++r) rli[r] = __builtin_amdgcn_rcpf(li_l[crow(r, hi)]);
  bf16* Ow = Ob + (long)(wid * QBLK) * LDO; const bf16* Gw = Gb + (long)(wid * QBLK) * LDQ;
  asm volatile("" ::: "memory"); SBAR();
#pragma unroll
  for (int r = 0; r < 16; ++r) { int orow = crow(r, hi); asm volatile("" ::: "memory");
    for (int d0 = 0; d0 < 4; ++d0) { const float gt = __uint_as_float((unsigned)Gw[(long)orow * LDQ + d0 * 32 + r32] << 16);
      const float val = o[d0][r] * rli[r] * (gt / (1.f + __expf(-gt)));
      Ow[(long)orow * LDO + d0 * 32 + r32] = pg8::f2bf_rne(val); } }
  __syncthreads();
#undef SLOAD
#undef BLD
#undef SWRITE
#undef SWAIT
#undef RESC
}
#undef KSWZ
#undef SBAR
}
#define LAS __attribute__((address_space(3)))
typedef unsigned short bf16_t;
typedef float f32x4 __attribute__((ext_vector_type(4)));
typedef float f32x2 __attribute__((ext_vector_type(2)));
typedef short bf16x8 __attribute__((ext_vector_type(8)));
typedef unsigned u32x2 __attribute__((ext_vector_type(2)));
constexpr int DM = 1024, NB = 4, SEQ = 4096, CTXL = 256, MLAT = NB * SEQ, MCTX = NB * CTXL, MTOT = MLAT + MCTX;
constexpr float EPS = 1e-6f;
constexpr size_t MiB = 1u << 20;
constexpr size_t WS_CTL = 0, CTL_ZERO_BYTES = 256 * 1024, WS_MODS = 65536, WS_HDN = 512 * 1024, WS_GATES = 2 * MiB;
constexpr size_t WS_W0IN = 5 * MiB, WS_W0OUT = 18 * MiB, WS_QKVG = 22 * MiB, WS_XVTL = 107 * MiB, WS_XVTC = 235 * MiB, WS_A2C = 243 * MiB, WS_Y0 = 100 * MiB;
constexpr size_t WS_W1OUT = 5 * MiB, WS_W1B = 9 * MiB, WS_H1 = 17 * MiB, WS_Y1A = 51 * MiB, WS_H = 192 * MiB, WS_W1A = 192 * MiB, WS_OZ = 51 * MiB, WS_Y1 = 51 * MiB;
constexpr size_t WS_END = 256 * MiB;
constexpr int LDS_BYTES = 147456;
constexpr int NPHASE = 13;

__device__ __forceinline__ float bf2f(unsigned short b) { return __uint_as_float((unsigned)b << 16); }
__device__ __forceinline__ unsigned short f2bf(float f) { return pg8::f2bf_rne(f); }
__device__ __forceinline__ unsigned pk2(float lo, float hi) { return (unsigned)f2bf(lo) | ((unsigned)f2bf(hi) << 16); }
__device__ __forceinline__ float silu_f(float x) { return x / (1.f + __expf(-x)); }
__device__ __forceinline__ float sigm_f(float x) { return 1.f / (1.f + __expf(-x)); }
__device__ __forceinline__ float wave_sum(float v) {
#pragma unroll
    for (int o = 1; o < 64; o <<= 1) v += __shfl_xor(v, o);
    return v;
}
#define LDS_WAIT() asm volatile("s_waitcnt lgkmcnt(0)" ::: "memory")

__device__ __forceinline__ void transpose_item(const float* __restrict__ W, int ldw, int K, int col0, bf16_t* __restrict__ WT, int row0, LAS float* scr, int kb, int lane) {
    const int k0 = 64 * kb;
#pragma unroll 8
    for (int i = 0; i < 32; ++i) { const int kk = 2 * i + (lane >> 5); scr[kk * 33 + (lane & 31)] = W[(size_t)(k0 + kk) * ldw + col0 + (lane & 31)]; }
    LDS_WAIT(); asm volatile("" ::: "memory");
    const int c = lane & 7;
#pragma unroll
    for (int j = 0; j < 4; ++j) { const int n = (lane >> 3) + 8 * j; const LAS float* s = scr + (8 * c) * 33 + n;
        pg8::u32x4 o; o.x = pk2(s[0 * 33], s[1 * 33]); o.y = pk2(s[2 * 33], s[3 * 33]); o.z = pk2(s[4 * 33], s[5 * 33]); o.w = pk2(s[6 * 33], s[7 * 33]);
        *(pg8::u32x4*)(WT + (size_t)(row0 + n) * K + k0 + 8 * c) = o; }
    LDS_WAIT(); asm volatile("" ::: "memory");
}

__device__ __forceinline__ void load_row(const float* __restrict__ p, int lane, f32x4 (&v)[4]) {
#pragma unroll
    for (int j = 0; j < 4; ++j) v[j] = ((const f32x4*)p)[lane + 64 * j];
}
__device__ __forceinline__ float row_rstd(const f32x4 (&v)[4]) {
    float s = 0.f;
#pragma unroll
    for (int j = 0; j < 4; ++j) s += (v[j].x * v[j].x + v[j].y * v[j].y) + (v[j].z * v[j].z + v[j].w * v[j].w);
    return rsqrtf(wave_sum(s) * (1.f / DM) + EPS);
}
__device__ __forceinline__ void modulate_store(const f32x4 (&v)[4], float rstd, const float* __restrict__ g, const float* __restrict__ mods, bf16_t* __restrict__ orow, int lane) {
#pragma unroll
    for (int j = 0; j < 4; ++j) { const int q = lane + 64 * j; const f32x4 gg = ((const f32x4*)g)[q], sh = ((const f32x4*)mods)[q], sc = ((const f32x4*)(mods + DM))[q];
        const f32x4 h = v[j] * rstd * gg * (sc + 1.f) + sh;
        u32x2 w; w.x = pk2(h.x, h.y); w.y = pk2(h.z, h.w); ((u32x2*)orow)[q] = w; }
}

__device__ __forceinline__ void fft_dif(LAS f32x2* buf, int N, int tid) {
    for (int half = N >> 1; half >= 1; half >>= 1) {
        for (int i = tid; i < (N >> 1); i += 512) { const int j = i & (half - 1), p = 2 * i - j, q = p + half;
            const float f = (float)j / (float)(2 * half); const float c = __builtin_amdgcn_cosf(f), s = __builtin_amdgcn_sinf(f);
            const f32x2 u = buf[p], v = buf[q]; buf[p] = u + v; const f32x2 d = u - v; buf[q] = (f32x2){d.x * c + d.y * s, d.y * c - d.x * s}; }
        __syncthreads();
    }
}
__device__ __forceinline__ void ifft_dit(LAS f32x2* buf, int N, int tid) {
    for (int half = 1; half < N; half <<= 1) {
        for (int i = tid; i < (N >> 1); i += 512) { const int j = i & (half - 1), p = 2 * i - j, q = p + half;
            const float f = (float)j / (float)(2 * half); const float c = __builtin_amdgcn_cosf(f), s = __builtin_amdgcn_sinf(f);
            const f32x2 u = buf[p], v0 = buf[q]; const f32x2 v = (f32x2){v0.x * c - v0.y * s, v0.x * s + v0.y * c}; buf[p] = u + v; buf[q] = u - v; }
        __syncthreads();
    }
}
__device__ __forceinline__ float conv3(const bf16_t* __restrict__ u, int s, int n, float w0, float w1, float w2, float bias) {
    float a = bias + w1 * bf2f(u[s]);
    if (s > 0) a += w0 * bf2f(u[s - 1]);
    if (s < n - 1) a += w2 * bf2f(u[s + 1]);
    return a;
}
__device__ __forceinline__ void hyena_item(LAS unsigned char* L, int n, int c, const bf16_t* __restrict__ xvt, const float* __restrict__ hdn, const float* __restrict__ w3,
                                           const float* __restrict__ cw, const float* __restrict__ cb, const float* __restrict__ hyb, bf16_t* __restrict__ a2, int tid) {
    const int N = 2 * n, lane = tid & 63, wid = tid >> 6;
    LAS f32x2* Fb = (LAS f32x2*)L; LAS f32x2* Zb = (LAS f32x2*)(L + 65536); LAS float* w3s = (LAS float*)(L + 131072); LAS float* red = w3s + 128;
    if (tid < 128) w3s[tid] = w3[(tid & 63) * 2048 + (tid >> 6) * 1024 + c];
    __syncthreads();
    const float absdelta = 3.0701134573253945f + (float)c * (12.280453829301578f / 1023.f);
    float l1 = 0.f;
    for (int t = tid; t < n; t += 512) {
        const f32x4* hr = (const f32x4*)(hdn + (size_t)t * 64); float d0 = 0.f, d1 = 0.f;
#pragma unroll
        for (int j4 = 0; j4 < 16; ++j4) { const f32x4 hv = hr[j4];
            d0 += hv.x * w3s[4 * j4] + hv.y * w3s[4 * j4 + 1] + hv.z * w3s[4 * j4 + 2] + hv.w * w3s[4 * j4 + 3];
            d1 += hv.x * w3s[64 + 4 * j4] + hv.y * w3s[64 + 4 * j4 + 1] + hv.z * w3s[64 + 4 * j4 + 2] + hv.w * w3s[64 + 4 * j4 + 3]; }
        const float dec = expf(-((float)t / (float)(n - 1)) * absdelta); const float f0 = d0 * dec, f1 = d1 * dec;
        Fb[t] = (f32x2){f0, 0.f}; l1 += fabsf(f0);
        if (t >= 1) { Fb[N - t] = (f32x2){f1, 0.f}; l1 += fabsf(f1); }
    }
    if (tid == 0) Fb[n] = (f32x2){0.f, 0.f};
    l1 = wave_sum(l1); if (lane == 0) red[wid] = l1;
    __syncthreads();
    float tot = 0.f;
#pragma unroll
    for (int w = 0; w < 8; ++w) tot += red[w];
    const float scale = 1.f / (tot * (float)N);
    fft_dif(Fb, N, tid);
    const float w00 = cw[c], w01 = cw[3072 + c], w02 = cw[6144 + c], b0 = cb[c];
    const float w10 = cw[1024 + c], w11 = cw[3072 + 1024 + c], w12 = cw[6144 + 1024 + c], b1 = cb[1024 + c];
    const float w20 = cw[2048 + c], w21 = cw[3072 + 2048 + c], w22 = cw[6144 + 2048 + c], b2 = cb[2048 + c];
    const float hb = hyb[c];
    for (int pair = 0; pair < 2; ++pair) {
        const bf16_t* r0 = xvt + ((size_t)(2 * pair) * 4096) * n; const bf16_t* r1 = xvt + ((size_t)(2 * pair + 1) * 4096) * n;
        for (int s = tid; s < n; s += 512) {
            const float g0 = conv3(r0 + (size_t)(2048 + c) * n, s, n, w20, w21, w22, b2) * conv3(r0 + (size_t)(1024 + c) * n, s, n, w10, w11, w12, b1);
            const float g1 = conv3(r1 + (size_t)(2048 + c) * n, s, n, w20, w21, w22, b2) * conv3(r1 + (size_t)(1024 + c) * n, s, n, w10, w11, w12, b1);
            Zb[s] = (f32x2){g0, g1}; Zb[n + s] = (f32x2){0.f, 0.f}; }
        __syncthreads();
        fft_dif(Zb, N, tid);
        for (int k = tid; k < N; k += 512) { const f32x2 z = Zb[k], f = Fb[k]; Zb[k] = (f32x2){(z.x * f.x - z.y * f.y) * scale, (z.x * f.y + z.y * f.x) * scale}; }
        __syncthreads();
        ifft_dit(Zb, N, tid);
        for (int t = tid; t < n; t += 512) { const f32x2 y = Zb[t];
#pragma unroll
            for (int e = 0; e < 2; ++e) { const bf16_t* rb = e ? r1 : r0; const int b = 2 * pair + e;
                const float g = conv3(rb + (size_t)(2048 + c) * n, t, n, w20, w21, w22, b2) * conv3(rb + (size_t)(1024 + c) * n, t, n, w10, w11, w12, b1);
                const float x0 = conv3(rb + (size_t)c * n, t, n, w00, w01, w02, b0);
                const float gh = bf2f(rb[(size_t)(3072 + c) * n + t]);
                const float o = x0 * ((e ? y.y : y.x) + g * hb) * silu_f(gh);
                a2[((size_t)b * n + t) * 2048 + c] = f2bf(o); } }
        __syncthreads();
    }
}
__device__ __forceinline__ void mlstm_phase(LAS unsigned char* L, const bf16_t* __restrict__ Y1A, const float* __restrict__ GATES, const float* __restrict__ cw, const float* __restrict__ cb,
                                            bf16_t* __restrict__ H, int bid, int G) {
    const int tid = threadIdx.x, lane = tid & 63, wid = __builtin_amdgcn_readfirstlane(tid >> 6), fr = lane & 15, fq = lane >> 4;
    constexpr int QS = 272, KTS = 144, CS = 272;
    constexpr int OFF_Q = 0, OFF_K = 17408, OFF_KT = 34816, OFF_VT = 53248, OFF_S = 60160, OFF_C = 69376, OFF_G = 82432;
    LAS float* gl = (LAS float*)(L + OFF_G);
    LAS unsigned short* q_s = (LAS unsigned short*)(L + OFF_Q); LAS unsigned short* k_s = (LAS unsigned short*)(L + OFF_K); LAS unsigned short* kt_s = (LAS unsigned short*)(L + OFF_KT);
    LAS unsigned short* vt_s = (LAS unsigned short*)(L + OFF_VT); LAS unsigned short* S_s = (LAS unsigned short*)(L + OFF_S); LAS unsigned short* C_s = (LAS unsigned short*)(L + OFF_C);
    for (int item = bid; item < 256; item += G) {
        const int b = item >> 6, h = (item >> 3) & 7, sl = item & 7;
        for (int dir = 0; dir < 2; ++dir) {
            f32x4 Cacc[3];
#pragma unroll
            for (int m = 0; m < 3; ++m) Cacc[m] = (f32x4){0.f, 0.f, 0.f, 0.f};
            for (int i = tid; i < 48 * 68; i += 512) ((LAS unsigned*)(L + OFF_C))[i] = 0u;
            for (int i = tid; i < 16 * 72; i += 512) { const int r = i / 72; vt_s[(32 + r) * 72 + (i % 72)] = (r == 0) ? (unsigned short)0x3F80 : (unsigned short)0; }
            __syncthreads();
            for (int step = 0; step < 68; ++step) {
                int n, rowbase, t0;
                if (step < 4) { const int ci = dir == 0 ? step : 3 - step; n = CTXL; rowbase = MLAT + b * CTXL; t0 = ci * 64; }
                else { const int ci = dir == 0 ? step - 4 : 67 - step; n = SEQ; rowbase = b * SEQ; t0 = ci * 64; }
#pragma unroll 4
                for (int i = 0; i < 32; ++i) {
                    const int e = tid + 512 * i, r = e >> 8, cc = e & 255;
                    const int tt = dir == 0 ? t0 + r : t0 + 63 - r;
                    const int col = (cc < 128) ? (h * 128 + cc) : (1024 + h * 128 + (cc - 128));
                    const bf16_t* p = Y1A + (size_t)(rowbase + tt) * 4096 + col;
                    float a = cb[col] + cw[2048 + col] * bf2f(p[0]);
                    if (tt > 0) a += cw[col] * bf2f(p[-4096]);
                    if (tt < n - 1) a += cw[4096 + col] * bf2f(p[4096]);
                    a = silu_f(a);
                    if (cc < 128) q_s[r * 136 + cc] = f2bf(a); else k_s[r * 136 + (cc - 128)] = f2bf(a * 0.08838834764831845f);
                }
                { const int r = tid >> 3, v4 = (tid & 7) * 4; const int tt = dir == 0 ? t0 + r : t0 + 63 - r;
                  const u32x2 w = *(const u32x2*)(Y1A + (size_t)(rowbase + tt) * 4096 + 2048 + h * 256 + sl * 32 + v4);
                  vt_s[(v4 + 0) * 72 + r] = (unsigned short)(w.x & 0xffffu); vt_s[(v4 + 1) * 72 + r] = (unsigned short)(w.x >> 16);
                  vt_s[(v4 + 2) * 72 + r] = (unsigned short)(w.y & 0xffffu); vt_s[(v4 + 3) * 72 + r] = (unsigned short)(w.y >> 16); }
                if (tid < 64) { const int tt = dir == 0 ? t0 + tid : t0 + 63 - tid; const float* gp = GATES + (size_t)(rowbase + tt) * 32 + dir * 16 + h;
                  const float ip = gp[0], fp = gp[8]; const float lf = fminf(fp, 0.f) - log1pf(expf(-fabsf(fp)));
                  gl[tid] = lf; gl[64 + tid] = ip; }
                __syncthreads();
                if (tid < 64) { float bs = 0.f, bt = 0.f;
                  for (int r2 = 0; r2 < 64; ++r2) { const float v = gl[r2]; bt += v; if (r2 <= tid) bs += v; }
                  const float ip = gl[64 + tid];
                  asm volatile("s_waitcnt lgkmcnt(0)" ::: "memory");
                  gl[tid] = bs; gl[64 + tid] = bs - ip; gl[128 + tid] = expf(bs); gl[192 + tid] = expf(bt - bs + ip); }
                __syncthreads();
#pragma unroll 4
                for (int i = 0; i < 16; ++i) { const int e = tid + 512 * i, s = e & 63, d = e >> 6; kt_s[d * 72 + s] = f2bf(gl[192 + s] * bf2f(k_s[s * 136 + d])); }
                { const int mt = wid >> 1;
#pragma unroll
                  for (int q2 = 0; q2 < 2; ++q2) { const int nt = (wid & 1) * 2 + q2; f32x4 acc = (f32x4){0.f, 0.f, 0.f, 0.f};
                    if (nt <= mt) {
#pragma unroll
                      for (int kk = 0; kk < 4; ++kk) { const bf16x8 af = *(const LAS bf16x8*)(L + OFF_Q + (mt * 16 + fr) * QS + (kk * 32 + fq * 8) * 2);
                        const bf16x8 bfr = *(const LAS bf16x8*)(L + OFF_K + (nt * 16 + fr) * QS + (kk * 32 + fq * 8) * 2);
                        acc = __builtin_amdgcn_mfma_f32_16x16x32_bf16(af, bfr, acc, 0, 0, 0); } }
#pragma unroll
                    for (int j = 0; j < 4; ++j) { const int t = mt * 16 + fq * 4 + j, s = nt * 16 + fr;
                      const float w = (s <= t) ? acc[j] * expf(gl[t] - gl[64 + s]) : 0.f; S_s[t * 72 + s] = f2bf(w); } } }
                __syncthreads();
                if (step >= 4 && wid < 4) { const int mt = wid; f32x4 o3[3];
#pragma unroll
                  for (int nt = 0; nt < 3; ++nt) { f32x4 acc = (f32x4){0.f, 0.f, 0.f, 0.f};
#pragma unroll
                    for (int kk = 0; kk < 4; ++kk) { const bf16x8 af = *(const LAS bf16x8*)(L + OFF_Q + (mt * 16 + fr) * QS + (kk * 32 + fq * 8) * 2);
                      const bf16x8 bfr = *(const LAS bf16x8*)(L + OFF_C + (nt * 16 + fr) * CS + (kk * 32 + fq * 8) * 2);
                      acc = __builtin_amdgcn_mfma_f32_16x16x32_bf16(af, bfr, acc, 0, 0, 0); }
#pragma unroll
                    for (int j = 0; j < 4; ++j) acc[j] *= gl[128 + mt * 16 + fq * 4 + j];
#pragma unroll
                    for (int kk = 0; kk < 2; ++kk) { const bf16x8 af = *(const LAS bf16x8*)(L + OFF_S + (mt * 16 + fr) * KTS + (kk * 32 + fq * 8) * 2);
                      const bf16x8 bfr = *(const LAS bf16x8*)(L + OFF_VT + (nt * 16 + fr) * KTS + (kk * 32 + fq * 8) * 2);
                      acc = __builtin_amdgcn_mfma_f32_16x16x32_bf16(af, bfr, acc, 0, 0, 0); }
                    o3[nt] = acc; }
#pragma unroll
                  for (int j = 0; j < 4; ++j) { const float den = __shfl(o3[2][j], lane & 48); const float inv = 1.f / fmaxf(fabsf(den), 1.f);
                    const int t = mt * 16 + fq * 4 + j; const int tt = dir == 0 ? t0 + t : t0 + 63 - t;
                    bf16_t* hp = H + (size_t)(b * SEQ + tt) * 2048 + h * 256 + sl * 32 + fr;
                    float v0 = o3[0][j] * inv, v1 = o3[1][j] * inv;
                    if (dir == 1) { v0 += bf2f(hp[0]); v1 += bf2f(hp[16]); }
                    hp[0] = f2bf(v0); hp[16] = f2bf(v1); } }
                { const float ap = gl[128 + 63];
#pragma unroll
                  for (int mt = 0; mt < 3; ++mt) { Cacc[mt] = Cacc[mt] * ap;
#pragma unroll
                    for (int kk = 0; kk < 2; ++kk) { const bf16x8 af = *(const LAS bf16x8*)(L + OFF_VT + (mt * 16 + fr) * KTS + (kk * 32 + fq * 8) * 2);
                      const bf16x8 bfr = *(const LAS bf16x8*)(L + OFF_KT + (wid * 16 + fr) * KTS + (kk * 32 + fq * 8) * 2);
                      Cacc[mt] = __builtin_amdgcn_mfma_f32_16x16x32_bf16(af, bfr, Cacc[mt], 0, 0, 0); } } }
                __syncthreads();
#pragma unroll
                for (int mt = 0; mt < 3; ++mt)
#pragma unroll
                    for (int j = 0; j < 4; ++j) C_s[(mt * 16 + fq * 4 + j) * 136 + wid * 16 + fr] = f2bf(Cacc[mt][j]);
                __syncthreads();
            }
            __threadfence(); __syncthreads();
        }
    }
}
struct Args { const float* in[27]; float* out; unsigned char* ws; int ph_lo, ph_hi; };
enum { I_X = 0, I_C, I_CTX, I_CCTX, I_WMOD, I_BMOD, I_GPRE, I_GPOST, I_EWIN, I_ECW, I_ECB, I_FW1, I_FB1, I_FFREQ, I_FW2, I_FB2, I_FW3, I_HYB, I_QN, I_KN, I_EWOUT,
       I_OWIN, I_OCW, I_OCB, I_OGB, I_OHN, I_OWOUT };

__global__ void __launch_bounds__(512, 2) fwd_kernel(Args a) {
    extern __shared__ __attribute__((aligned(16))) unsigned char lds_raw[];
    LAS unsigned char* lds = (LAS unsigned char*)lds_raw;
    cg::grid_group grid = cg::this_grid();
    const int tid = threadIdx.x, lane = tid & 63, wid = __builtin_amdgcn_readfirstlane(tid >> 6);
    const int G = gridDim.x, bid = blockIdx.x, gw = bid * 8 + wid, NGW = G * 8;
    unsigned char* ws = a.ws;
    float* MODS = (float*)(ws + WS_MODS); float* HDN = (float*)(ws + WS_HDN); float* GATES = (float*)(ws + WS_GATES);
    bf16_t* W0IN = (bf16_t*)(ws + WS_W0IN); bf16_t* W0OUT = (bf16_t*)(ws + WS_W0OUT); bf16_t* QKVG = (bf16_t*)(ws + WS_QKVG);
    bf16_t* XVTL = (bf16_t*)(ws + WS_XVTL); bf16_t* XVTC = (bf16_t*)(ws + WS_XVTC); bf16_t* A2C = (bf16_t*)(ws + WS_A2C); float* Y0 = (float*)(ws + WS_Y0);
    bf16_t* W1OUT = (bf16_t*)(ws + WS_W1OUT); bf16_t* W1B = (bf16_t*)(ws + WS_W1B); bf16_t* H1 = (bf16_t*)(ws + WS_H1); bf16_t* Y1A = (bf16_t*)(ws + WS_Y1A);
    bf16_t* HB = (bf16_t*)(ws + WS_H); bf16_t* W1A = (bf16_t*)(ws + WS_W1A); bf16_t* OZ = (bf16_t*)(ws + WS_OZ); float* Y1 = (float*)(ws + WS_Y1);
    bf16_t* H0 = (bf16_t*)a.out;
    bf16_t* A2L = (bf16_t*)a.out; float* X1 = a.out;
    const int lo = a.ph_lo, hi = a.ph_hi;
#ifndef PHMASK
#define PHMASK 0xFFFF
#endif
#define IN(k) ((((PHMASK) >> (k)) & 1) && lo <= (k) && (k) < hi)
#define SEAM(k) do { if (IN(k) && IN((k) + 1)) grid.sync(); } while (0)

    if (IN(0)) {
        LAS float* scr = (LAS float*)(lds + wid * 16384);
        for (int it = gw; it < 3328 + 1024; it += NGW) {
            if (it < 3328) { const int kb = it / 208, cb_ = it % 208; transpose_item(a.in[I_EWIN], 6656, 1024, cb_ * 32, W0IN, cb_ * 32, scr, kb, lane); }
            else { const int r = it - 3328, kb = r / 32, cb_ = r % 32; transpose_item(a.in[I_EWOUT], 1024, 2048, cb_ * 32, W0OUT, cb_ * 32, scr, kb, lane); }
        }
        for (int it = bid; it < 192; it += G) {
            const int l = it / 96, r = it % 96, cc = r / 16, kc = r % 16, col = cc * 512 + tid;
            const float* wm = a.in[I_WMOD] + ((size_t)l * 1024 + kc * 64) * 3072 + col; const float* cv = a.in[I_C] + kc * 64; const float* ccx = a.in[I_CCTX] + kc * 64;
            float acc[5] = {0.f, 0.f, 0.f, 0.f, 0.f};
            for (int k = 0; k < 64; ++k) { const float w = wm[(size_t)k * 3072];
#pragma unroll
                for (int j = 0; j < 4; ++j) acc[j] += silu_f(cv[j * 1024 + k]) * w;
                acc[4] += silu_f(ccx[k]) * w; }
            const float bm = (kc == 0) ? a.in[I_BMOD][l * 3072 + col] : 0.f;
#pragma unroll
            for (int j = 0; j < 5; ++j) atomicAdd(&MODS[(l * 5 + j) * 3072 + col], acc[j] + bm);
        }
        for (int r = gw; r < 4352; r += NGW) {
            const int n = r < 4096 ? 4096 : 256, t = r < 4096 ? r : r - 4096;
            const float* w1 = a.in[I_FW1]; const float fr_ = a.in[I_FFREQ][lane];
            float acc = ((float)t / (float)(n - 1)) * w1[lane];
            const float w0 = (float)(2.0 * 3.14159265358979323846 / (double)n) * (float)t;
#pragma unroll 4
            for (int i = 0; i < 16; ++i) { const float band = 1e-4f + (float)i * ((15.f - 1e-4f) / 15.f); const float ang = w0 * band;
                acc += cosf(ang) * w1[(1 + i) * 64 + lane] - sinf(ang) * w1[(17 + i) * 64 + lane]; }
            const float h1 = sinf(fr_ * (acc + a.in[I_FB1][lane]));
            float acc2 = 0.f; const float* w2 = a.in[I_FW2];
            for (int i = 0; i < 64; ++i) acc2 += __shfl(h1, i) * w2[i * 64 + lane];
            HDN[(size_t)r * 64 + lane] = sinf(fr_ * (acc2 + a.in[I_FB2][lane]));
        }
    }
    SEAM(0);
    if (IN(1)) {
        for (int m = gw; m < MTOT; m += NGW) {
            const float* xr = m < MLAT ? a.in[I_X] + (size_t)m * DM : a.in[I_CTX] + (size_t)(m - MLAT) * DM; const int j = m < MLAT ? (m >> 12) : 4;
            f32x4 v[4]; load_row(xr, lane, v); const float rstd = row_rstd(v);
            modulate_store(v, rstd, a.in[I_GPRE], MODS + (size_t)j * 3072, H0 + (size_t)m * DM, lane);
        }
    }
    SEAM(1);
    if (IN(2)) {
        pg8::Gemm g{H0, W0IN, MTOT, 6656, 1024, H0, 1 << 30}; pg8::StaticOrder S; S.init(MTOT, 6656, G, bid); pg8::EpiL0 E{XVTL, XVTC, QKVG};
        pg8::gemm_phase<pg8::EpiL0, pg8::StaticOrder, true, true>(lds, g, S, E);
    }
    SEAM(2);
    if (IN(3)) {
        const int i = lane & 31, hs = lane >> 5;
        const float inv = exp2f(-(float)i * (13.287712379549449f / 32.f));
        for (int m = gw; m < MTOT; m += NGW) {
            bf16_t* row = QKVG + (size_t)m * 2560; const bool lat = m < MLAT; const int t = m & 4095; const float pos = (float)(hs ? (t & 63) : (t >> 6));
            float cs_ = 1.f, sn_ = 0.f; if (lat) { const float ang = pos * inv; cs_ = cosf(ang); sn_ = sinf(ang); }
            for (int hd = 0; hd < 10; ++hd) {
                const int base = hd * 128 + hs * 64 + i; const float* gv = (hd < 8 ? a.in[I_QN] : a.in[I_KN]) + hs * 64 + i;
                const float x0 = bf2f(row[base]), x1 = bf2f(row[base + 32]);
                const float r = rsqrtf(wave_sum(x0 * x0 + x1 * x1) * (1.f / 128.f) + EPS);
                const float y0 = x0 * r * gv[0], y1 = x1 * r * gv[32];
                row[base] = f2bf(y0 * cs_ - y1 * sn_); row[base + 32] = f2bf(y0 * sn_ + y1 * cs_);
            }
        }
    }
    SEAM(3);
    if (IN(4)) {
        for (int u = bid; u < 544; u += G) {
            const bf16_t *Qb, *Gb; bf16_t* Ob; int seg0, seq; unsigned kb0, kb1;
            if (u < 512) { const int b = u >> 7, h = (u >> 4) & 7, qb = u & 15; const size_t q0 = (size_t)b * SEQ + qb * 256;
                Qb = QKVG + q0 * 2560 + h * 128; kb0 = (unsigned)(((size_t)b * SEQ * 2560 + 1024 + (h >> 2) * 128) * 2); kb1 = (unsigned)(((size_t)(MLAT + b * CTXL) * 2560 + 1024 + (h >> 2) * 128) * 2);
                seg0 = SEQ; seq = SEQ + CTXL; Gb = QKVG + q0 * 2560 + 1536 + h * 128; Ob = A2L + q0 * 2048 + 1024 + h * 128; }
            else { const int v = u - 512, b = v >> 3, h = v & 7; const size_t q0 = (size_t)MLAT + b * CTXL;
                Qb = QKVG + q0 * 2560 + h * 128; kb0 = (unsigned)((q0 * 2560 + 1024 + (h >> 2) * 128) * 2); kb1 = kb0; seg0 = CTXL; seq = CTXL;
                Gb = QKVG + q0 * 2560 + 1536 + h * 128; Ob = A2C + (size_t)b * CTXL * 2048 + 1024 + h * 128; }
            const __amdgpu_buffer_rsrc_t kvrs = __builtin_amdgcn_make_buffer_rsrc((void*)QKVG, (short)0, (int)(MTOT * 2560 * 2), 0x00020000);
            attn::attn_dense_body(Qb, kvrs, kb0, kb1, seg0, Gb, Ob, seq, (char*)lds_raw);
        }
        __syncthreads();
#ifndef NO_HYENA
        for (int it = bid; it < 2048; it += G) {
            if (it < 1024) hyena_item(lds, SEQ, it, XVTL, HDN, a.in[I_FW3], a.in[I_ECW], a.in[I_ECB], a.in[I_HYB], A2L, tid);
            else hyena_item(lds, CTXL, it - 1024, XVTC, HDN + 4096 * 64, a.in[I_FW3], a.in[I_ECW], a.in[I_ECB], a.in[I_HYB], A2C, tid);
        }
#endif
    }
    SEAM(4);
    if (IN(5)) {
        pg8::Gemm g{A2L, W0OUT, MTOT, 1024, 2048, A2C, 64}; pg8::StaticOrder S; S.init(MTOT, 1024, G, bid); pg8::EpiF32 E{Y0, 1024, nullptr};
        pg8::gemm_phase<pg8::EpiF32, pg8::StaticOrder, true, true>(lds, g, S, E);
    }
    SEAM(5);
    if (IN(6)) {
        for (int m = gw; m < MTOT; m += NGW) {
            const float* xr = m < MLAT ? a.in[I_X] + (size_t)m * DM : a.in[I_CTX] + (size_t)(m - MLAT) * DM; const int j = m < MLAT ? (m >> 12) : 4;
            f32x4 y[4], x[4]; load_row(Y0 + (size_t)m * DM, lane, y); load_row(xr, lane, x); const float ry = row_rstd(y);
            const float* ga = MODS + (size_t)j * 3072 + 2048;
#pragma unroll
            for (int q = 0; q < 4; ++q) { const int idx = lane + 64 * q; x[q] = x[q] + ((const f32x4*)ga)[idx] * (y[q] * ry * ((const f32x4*)a.in[I_GPOST])[idx]);
                if (m < MLAT) ((f32x4*)(X1 + (size_t)m * DM))[idx] = x[q]; }
            const float rx = row_rstd(x);
            modulate_store(x, rx, a.in[I_GPRE] + DM, MODS + (size_t)(5 + j) * 3072, H1 + (size_t)m * DM, lane);
        }
        LAS float* scr = (LAS float*)(lds + wid * 16384);
        for (int it = gw; it < 2048 + 16 + 2048 + 1024; it += NGW) {
            if (it < 2048) { const int kb = it / 128, cb_ = it % 128; transpose_item(a.in[I_OWIN], 8224, 1024, cb_ * 32, W1A, cb_ * 32, scr, kb, lane); }
            else if (it < 2064) { const int kb = it - 2048; transpose_item(a.in[I_OWIN], 8224, 1024, 8192, W1A, 4096, scr, kb, lane); }
            else if (it < 4112) { const int r = it - 2064, kb = r / 128, cb_ = r % 128; transpose_item(a.in[I_OWIN], 8224, 1024, 4096 + cb_ * 32, W1B, cb_ * 32, scr, kb, lane); }
            else { const int r = it - 4112, kb = r / 32, cb_ = r % 32; transpose_item(a.in[I_OWOUT], 1024, 2048, cb_ * 32, W1OUT, cb_ * 32, scr, kb, lane); }
        }
    }
    SEAM(6);
    if (IN(7)) {
        pg8::Gemm g{H1, W1A, MTOT, 4352, 1024, H1, 1 << 30}; pg8::StaticOrder S; S.init(MTOT, 4352, G, bid); pg8::EpiL1a E{Y1A, GATES, a.in[I_OGB]};
        pg8::gemm_phase<pg8::EpiL1a, pg8::StaticOrder, true, true>(lds, g, S, E);
    }
    SEAM(7);
    if (IN(8)) mlstm_phase(lds, Y1A, GATES, a.in[I_OCW], a.in[I_OCB], HB, bid, G);
    SEAM(8);
    if (IN(9)) {
        pg8::Gemm g{H1, W1B, MLAT, 4096, 1024, H1, 1 << 30}; pg8::StaticOrder S; S.init(MLAT, 4096, G, bid); pg8::EpiBf16<0> E{OZ, 4096, nullptr, 0, 0, 1.f};
        pg8::gemm_phase<pg8::EpiBf16<0>, pg8::StaticOrder, true, true>(lds, g, S, E);
    }
    SEAM(9);
    if (IN(10)) {
        for (int m = gw; m < MLAT; m += NGW) {
            bf16_t* hrow = HB + (size_t)m * 2048; const bf16_t* oz = OZ + (size_t)m * 4096;
#pragma unroll 2
            for (int hh = 0; hh < 8; ++hh) { const int col = hh * 256 + lane * 4;
                const u32x2 hv = *(const u32x2*)(hrow + col), ov = *(const u32x2*)(oz + col), zv = *(const u32x2*)(oz + 2048 + col);
                float t[4] = { bf2f((unsigned short)(hv.x & 0xffffu)) * sigm_f(bf2f((unsigned short)(ov.x & 0xffffu))), bf2f((unsigned short)(hv.x >> 16)) * sigm_f(bf2f((unsigned short)(ov.x >> 16))),
                               bf2f((unsigned short)(hv.y & 0xffffu)) * sigm_f(bf2f((unsigned short)(ov.y & 0xffffu))), bf2f((unsigned short)(hv.y >> 16)) * sigm_f(bf2f((unsigned short)(ov.y >> 16))) };
                const float r = rsqrtf(wave_sum(t[0] * t[0] + t[1] * t[1] + t[2] * t[2] + t[3] * t[3]) * (1.f / 256.f) + EPS);
                const f32x4 hn = *(const f32x4*)(a.in[I_OHN] + col);
                const float z0 = bf2f((unsigned short)(zv.x & 0xffffu)), z1 = bf2f((unsigned short)(zv.x >> 16)), z2 = bf2f((unsigned short)(zv.y & 0xffffu)), z3 = bf2f((unsigned short)(zv.y >> 16));
                u32x2 w; w.x = pk2(t[0] * r * hn.x * silu_f(z0), t[1] * r * hn.y * silu_f(z1)); w.y = pk2(t[2] * r * hn.z * silu_f(z2), t[3] * r * hn.w * silu_f(z3));
                *(u32x2*)(hrow + col) = w; }
        }
    }
    SEAM(10);
    if (IN(11)) {
        pg8::Gemm g{HB, W1OUT, MLAT, 1024, 2048, HB, 1 << 30}; pg8::StaticOrder S; S.init(MLAT, 1024, G, bid); pg8::EpiF32 E{Y1, 1024, nullptr};
        pg8::gemm_phase<pg8::EpiF32, pg8::StaticOrder, true, true>(lds, g, S, E);
    }
    SEAM(11);
    if (IN(12)) {
        for (int m = gw; m < MLAT; m += NGW) {
            f32x4 y[4], x[4]; load_row(Y1 + (size_t)m * DM, lane, y); load_row(X1 + (size_t)m * DM, lane, x); const float ry = row_rstd(y);
            const float* ga = MODS + (size_t)(5 + (m >> 12)) * 3072 + 2048;
#pragma unroll
            for (int q = 0; q < 4; ++q) { const int idx = lane + 64 * q;
                ((f32x4*)(a.out + (size_t)m * DM))[idx] = x[q] + ((const f32x4*)ga)[idx] * (y[q] * ry * ((const f32x4*)(a.in[I_GPOST] + DM))[idx]); }
        }
    }
#undef IN
#undef SEAM
}

#ifndef MK_MULTI
#define MK_MULTI 0
#endif
extern "C" void kernel_launch(void* const* d_in, const int* in_sizes, int n_in, void* d_out, int out_size, void* d_ws, size_t ws_size, hipStream_t stream) {
    static int grid = 0;
    if (grid == 0) {
        if (n_in != 27 || out_size != MLAT * DM || ws_size < WS_END) { fprintf(stderr, "kernel_launch: unexpected shapes (n_in %d out %d ws %zu)\n", n_in, out_size, ws_size); grid = -1; return; }
        int dev = 0, cus = 0, per_cu = 0;
        if (hipGetDevice(&dev) != hipSuccess || hipDeviceGetAttribute(&cus, hipDeviceAttributeMultiprocessorCount, dev) != hipSuccess) { grid = -1; return; }
        if (hipFuncSetAttribute((const void*)fwd_kernel, hipFuncAttributeMaxDynamicSharedMemorySize, LDS_BYTES) != hipSuccess) { fprintf(stderr, "kernel_launch: hipFuncSetAttribute failed\n"); grid = -1; return; }
        if (hipOccupancyMaxActiveBlocksPerMultiprocessor(&per_cu, (const void*)fwd_kernel, 512, LDS_BYTES) != hipSuccess || per_cu < 1) { fprintf(stderr, "kernel_launch: occupancy query failed (%d)\n", per_cu); (void)hipGetLastError(); per_cu = 1; }
        grid = cus * (per_cu > 1 ? 1 : per_cu);
    }
    if (grid < 0) return;
    (void)hipMemsetAsync((char*)d_ws + WS_CTL, 0, CTL_ZERO_BYTES, stream);
    Args a{};
    for (int i = 0; i < 27; ++i) a.in[i] = (const float*)d_in[i];
    a.out = (float*)d_out; a.ws = (unsigned char*)d_ws;
#if MK_MULTI
    for (int p = 0; p < NPHASE; ++p) { a.ph_lo = p; a.ph_hi = p + 1; hipLaunchKernelGGL(fwd_kernel, dim3(grid), dim3(512), LDS_BYTES, stream, a); }
#else
    a.ph_lo = 0; a.ph_hi = NPHASE;
    void* args[] = {&a};
    hipError_t e = hipLaunchCooperativeKernel((const void*)fwd_kernel, dim3(grid), dim3(512), args, LDS_BYTES, stream);
    if (e != hipSuccess) fprintf(stderr, "kernel_launch: cooperative launch failed: %s (grid %d)\n", hipGetErrorString(e), grid);
#endif
}
```

```cpp
#include <hip/hip_runtime.h>
#include <hip/hip_cooperative_groups.h>
#include <hip/hip_bf16.h>
#include <cstdio>
#include <cstdint>
#include <cmath>
namespace cg = cooperative_groups;
namespace pg8 {
#define PG8_LAS __attribute__((address_space(3)))
typedef unsigned short bf16_t;
typedef short bf16x8 __attribute__((ext_vector_type(8)));
typedef float f32x4 __attribute__((ext_vector_type(4)));
typedef unsigned u32x4 __attribute__((ext_vector_type(4)));
constexpr int BM = 256, BK = 64, HALF = 128, HTB = HALF * BK * 2  , STAGE_BYTES = 8 * HTB, NXCD = 8, WGM = 8;

__host__ __device__ __forceinline__ int lds_byte(int r, int c) { const int st = (r >> 4) * 2 + (c >> 5), rr = r & 15, cc = c & 31, ob = rr * 64 + cc * 2; return st * 1024 + (ob ^ (((ob >> 9) & 1) << 5)); }
__host__ __device__ __forceinline__ void stage_rc(int b, int& R, int& C) { const int st = b / 1024, sb = b % 1024, swz = sb ^ (((sb >> 9) & 1) << 5); R = (st >> 1) * 16 + swz / 64; C = (st & 1) * 32 + (swz % 64) / 2; }
__host__ __device__ __forceinline__ int perm32(int rho) { const int n = rho >> 4, i = rho & 15; return 8 * (i >> 2) + 4 * n + (i & 3); }

struct Unit { int pm, pn, kc; };
struct Gemm { const bf16_t* A; const bf16_t* Bt; int M, N, K; const bf16_t* A2; int split_pm; int ld; int kcb; };

struct StaticOrder {
    int nM, nN, nwg, G, c;
    __host__ __device__ void init(int M, int N, int G_, int c_) { nM = M / BM; nN = N / BM; nwg = nM * nN; G = G_; c = c_; }
    __host__ __device__ bool next(int i, Unit& u) const {
        const long L = (long)i * G + c; if (L >= nwg) return false;
        int wgid = (int)L; { const int q = nwg / NXCD, r = nwg % NXCD, xcd = wgid % NXCD, off = wgid / NXCD; wgid = (xcd < r ? xcd * (q + 1) : r * (q + 1) + (xcd - r) * q) + off; }
        const int nig = WGM * nN, gid = wgid / nig, fm = gid * WGM, gsz = (nM - fm) < WGM ? (nM - fm) : WGM;
        u.pm = fm + ((wgid % nig) % gsz); u.pn = (wgid % nig) / gsz; u.kc = 0; return true;
    }
    __device__ __forceinline__ void a_ready(const Unit&) const {}
    __device__ __forceinline__ void done(const Unit&) const {}
};

__device__ __forceinline__ unsigned cvt_pk_bf16(float lo, float hi) { unsigned r; asm volatile("v_cvt_pk_bf16_f32 %0, %1, %2" : "=v"(r) : "v"(lo), "v"(hi)); return r; }
typedef float f32x2 __attribute__((ext_vector_type(2)));
__device__ __forceinline__ f32x2 gelu_pk(f32x2 v) {
    const f32x2 av = __builtin_elementwise_abs(v), d = av * 0.2316418882f + 1.0f;
    f32x2 t; t.x = __builtin_amdgcn_rcpf(d.x); t.y = __builtin_amdgcn_rcpf(d.y);
    f32x2 q = t * 0.5307027145f + (-0.7265760135f); q = q * t + 0.7107068705f; q = q * t + (-0.142248368f); q = q * t + 0.127414796f; q = q * t;
    const f32x2 s = (v * v) * (-0.72134752044f);
    f32x2 e; e.x = __builtin_amdgcn_exp2f(s.x); e.y = __builtin_amdgcn_exp2f(s.y);
    const f32x2 m = v * (q * e), r = v - m;
    f32x2 o; o.x = v.x < 0.f ? m.x : r.x; o.y = v.y < 0.f ? m.y : r.y; return o;
}

template <int ACT  > struct EpiBf16 {
    static constexpr bool PERM = true, AFTER_DRAIN = false; static_assert(ACT == 0 || ACT == 1, "EpiBf16: ACT is 0 (none) or 1 (gelu_pk)");
    bf16_t* O; int ldc; const float* bias; int split_cols; size_t split_stride; float scale0;
    __device__ __forceinline__ void operator()(const f32x4 (&acc)[2][2][4][2], const Unit& u, int wr, int wc, int fr, int fq) const {
        const int row0 = u.pm * BM + wr * 64 + fr; int colt = u.pn * BM; bf16_t* base = O;
        float sc = 1.f; if (split_cols) { const int t = colt / split_cols; base += (size_t)t * split_stride; colt -= t * split_cols; if (t == 0) sc = scale0; }
        const int col0 = colt + wc * 32 + 8 * fq, bcol0 = u.pn * BM + wc * 32 + 8 * fq;
        f32x4 bv[2][2];
#pragma unroll
        for (int bj = 0; bj < 2; ++bj)
#pragma unroll
            for (int n = 0; n < 2; ++n) bv[bj][n] = bias ? *(const f32x4*)(bias + bcol0 + bj * HALF + 4 * n) : (f32x4){0.f, 0.f, 0.f, 0.f};
#pragma unroll
        for (int ai = 0; ai < 2; ++ai)
#pragma unroll
            for (int m = 0; m < 4; ++m) { bf16_t* rowp = base + (size_t)(row0 + ai * HALF + m * 16) * ldc + col0;
#pragma unroll
                for (int bj = 0; bj < 2; ++bj) { f32x4 v0 = acc[ai][bj][m][0] + bv[bj][0], v1 = acc[ai][bj][m][1] + bv[bj][1];
                    if (ACT == 1) { f32x2 a = gelu_pk((f32x2){v0[0], v0[1]}), b = gelu_pk((f32x2){v0[2], v0[3]}), c = gelu_pk((f32x2){v1[0], v1[1]}), d = gelu_pk((f32x2){v1[2], v1[3]});
                        v0 = (f32x4){a.x, a.y, b.x, b.y}; v1 = (f32x4){c.x, c.y, d.x, d.y}; }
                    v0 = v0 * sc; v1 = v1 * sc; u32x4 w; w.x = cvt_pk_bf16(v0[0], v0[1]); w.y = cvt_pk_bf16(v0[2], v0[3]); w.z = cvt_pk_bf16(v1[0], v1[1]); w.w = cvt_pk_bf16(v1[2], v1[3]);
                    *(u32x4*)(rowp + bj * HALF) = w; } }
    }
};
struct EpiF32 {
    static constexpr bool PERM = false, AFTER_DRAIN = false;
    float* C; int ldc; const float* bias;
    __device__ __forceinline__ void operator()(const f32x4 (&acc)[2][2][4][2], const Unit& u, int wr, int wc, int fr, int fq) const {
        const int row0 = u.pm * BM + wr * 64 + fr, col0 = u.pn * BM + wc * 32 + 4 * fq;
        f32x4 bv[2][2];
#pragma unroll
        for (int bj = 0; bj < 2; ++bj)
#pragma unroll
            for (int n = 0; n < 2; ++n) bv[bj][n] = bias ? *(const f32x4*)(bias + col0 + bj * HALF + n * 16) : (f32x4){0.f, 0.f, 0.f, 0.f};
#pragma unroll
        for (int ai = 0; ai < 2; ++ai)
#pragma unroll
            for (int m = 0; m < 4; ++m) { float* rowp = C + (size_t)(row0 + ai * HALF + m * 16) * ldc + col0;
#pragma unroll
                for (int bj = 0; bj < 2; ++bj)
#pragma unroll
                    for (int n = 0; n < 2; ++n) *(f32x4*)(rowp + bj * HALF + n * 16) = acc[ai][bj][m][n] + bv[bj][n]; }
    }
};
template <class Epi, class Sched, bool ALIGN_EPI = false, bool SP2 = false>
__device__ __forceinline__ void gemm_phase(PG8_LAS unsigned char* lds, const Gemm g, const Sched& S, const Epi& E) {
    int tid_ = threadIdx.x; asm volatile("" : "+v"(tid_));
    const int tid = tid_, wid = __builtin_amdgcn_readfirstlane(tid >> 6), lane = tid & 63, wr = wid >> 2, wc = wid & 3, fr = lane & 15, fq = lane >> 4;
    const int K = g.K, nt = K / BK;
    unsigned voffA[2], voffB[2];
#pragma unroll
    for (int i = 0; i < 2; ++i) { int R, C; stage_rc(tid * 16 + i * 8192, R, C); const int Rb = Epi::PERM ? ((R & ~31) + perm32(R & 31)) : R;
        voffA[i] = (unsigned)(R * g.ld + C) * 2u; voffB[i] = (unsigned)(Rb * g.ld + C) * 2u; }
    const size_t kstep = (size_t)(BK * 2);
    const size_t hstep = (size_t)HALF * g.ld * 2;
    const size_t tstep = 2 * hstep;
    const unsigned ldsw = (unsigned)wid * 1024u;
    const int aoff = lds_byte(wr * 64 + fr, fq * 8), boff = lds_byte(wc * 32 + fr, fq * 8);
#define PG8_ABASE(pm_) (((pm_) < g.split_pm) ? ((const char*)g.A + (size_t)(pm_) * tstep) : ((const char*)g.A2 + (size_t)((pm_) - g.split_pm) * tstep))
#define PG8_SA(b, h) (((b) * 2 + (h)) * HTB)
#define PG8_SB(b, h) ((4 + (b) * 2 + (h)) * HTB)
#define PG8_STAGE(bufoff, gbase, voff) do { _Pragma("unroll") for (int _i = 0; _i < 2; ++_i) \
        __builtin_amdgcn_global_load_lds((const unsigned*)((const char*)(gbase) + (voff)[_i]), (PG8_LAS unsigned*)(lds + (bufoff) + ldsw + _i * 8192), 16, 0, 0); } while (0)
#define PG8_LDA(dst, b, h) do { _Pragma("unroll") for (int m = 0; m < 4; ++m) _Pragma("unroll") for (int k = 0; k < 2; ++k) dst[m][k] = *(const PG8_LAS bf16x8*)(lds + PG8_SA(b, h) + aoff + m * 2048 + k * 1024); } while (0)
#define PG8_LDB(dst, b, h) do { _Pragma("unroll") for (int n = 0; n < 2; ++n) _Pragma("unroll") for (int k = 0; k < 2; ++k) dst[n][k] = *(const PG8_LAS bf16x8*)(lds + PG8_SB(b, h) + boff + n * 2048 + k * 1024); } while (0)
#define PG8_MMA(ai, bj, At, Bt) do { __builtin_amdgcn_s_setprio(1); _Pragma("unroll") for (int m = 0; m < 4; ++m) _Pragma("unroll") for (int n = 0; n < 2; ++n) _Pragma("unroll") for (int k = 0; k < 2; ++k) \
        acc[ai][bj][m][n] = __builtin_amdgcn_mfma_f32_16x16x32_bf16(Bt[n][k], At[m][k], acc[ai][bj][m][n], 0, 0, 0); __builtin_amdgcn_s_setprio(0); } while (0)
#define PG8_WAIT_V(n) asm volatile("s_waitcnt vmcnt(" #n ")" ::: "memory")
#define PG8_WAIT_L(n) asm volatile("s_waitcnt lgkmcnt(" #n ")" ::: "memory")
#define PG8_BAR __builtin_amdgcn_s_barrier()
#define PG8_SCHED __builtin_amdgcn_sched_barrier(0)
    Unit cur, nxt; int ui = 0;
    if (!S.next(0, cur)) return;
    f32x4 acc[2][2][4][2];
#pragma unroll
    for (int a = 0; a < 2; ++a)
#pragma unroll
        for (int b = 0; b < 2; ++b)
#pragma unroll
            for (int m = 0; m < 4; ++m)
#pragma unroll
                for (int n = 0; n < 2; ++n) acc[a][b][m][n] = (f32x4){0.f, 0.f, 0.f, 0.f};
    bf16x8 At[4][2], B0[2][2], B1[2][2];
    const char* cA = PG8_ABASE(cur.pm) + (size_t)cur.kc * g.kcb; const char* cB = (const char*)g.Bt + (size_t)cur.pn * tstep + (size_t)cur.kc * g.kcb;
    S.a_ready(cur);
    if constexpr (SP2) {
        PG8_STAGE(PG8_SB(0, 0), cB, voffB); PG8_STAGE(PG8_SB(0, 1), cB + hstep, voffB); PG8_STAGE(PG8_SA(0, 0), cA, voffA); PG8_STAGE(PG8_SA(0, 1), cA + hstep, voffA);
        if (wr == 1) PG8_BAR;
        PG8_WAIT_V(2); PG8_BAR;
        PG8_STAGE(PG8_SB(1, 0), cB + kstep, voffB); PG8_STAGE(PG8_SA(1, 0), cA + kstep, voffA); PG8_STAGE(PG8_SB(1, 1), cB + hstep + kstep, voffB);
        PG8_WAIT_V(6); PG8_BAR;
    } else {
        PG8_STAGE(PG8_SB(0, 0), cB, voffB); PG8_STAGE(PG8_SA(0, 0), cA, voffA); PG8_STAGE(PG8_SB(0, 1), cB + hstep, voffB); PG8_STAGE(PG8_SA(0, 1), cA + hstep, voffA);
        if (wr == 1) PG8_BAR;
        PG8_WAIT_V(4); PG8_BAR;
        PG8_STAGE(PG8_SB(1, 0), cB + kstep, voffB); PG8_STAGE(PG8_SA(1, 0), cA + kstep, voffA); PG8_STAGE(PG8_SB(1, 1), cB + hstep + kstep, voffB);
        PG8_WAIT_V(6); PG8_BAR;
    }
    for (;;) {
        const bool has_next = S.next(ui + 1, nxt);
        const char* nA = has_next ? PG8_ABASE(nxt.pm) + (size_t)nxt.kc * g.kcb : cA; const char* nB = has_next ? (const char*)g.Bt + (size_t)nxt.pn * tstep + (size_t)nxt.kc * g.kcb : cB;
        for (int t = 0; t < nt; t += 2) {
            const bool last = (t == nt - 2);
            const char* a1 = cA + (size_t)(t + 1) * kstep;
            const char* a2 = last ? nA : cA + (size_t)(t + 2) * kstep; const char* b2 = last ? nB : cB + (size_t)(t + 2) * kstep;
            const char* a3 = a2 + kstep; const char* b3 = b2 + kstep;
            if (last && has_next) S.a_ready(nxt);
            if constexpr (SP2) {
            PG8_LDB(B0, 0, 0); PG8_LDB(B1, 0, 1); PG8_SCHED; PG8_LDA(At, 0, 0); PG8_STAGE(PG8_SA(1, 1), a1 + hstep, voffA);
            PG8_WAIT_V(8); PG8_WAIT_L(0); PG8_BAR; PG8_MMA(0, 0, At, B0); PG8_MMA(0, 1, At, B1); PG8_BAR; PG8_SCHED;
            PG8_LDA(At, 0, 1); PG8_STAGE(PG8_SB(0, 0), b2, voffB); PG8_STAGE(PG8_SB(0, 1), b2 + hstep, voffB); PG8_STAGE(PG8_SA(0, 0), a2, voffA);
            PG8_WAIT_V(8); PG8_WAIT_L(0); PG8_BAR; PG8_MMA(1, 0, At, B0); PG8_MMA(1, 1, At, B1); PG8_BAR; PG8_SCHED;
            PG8_LDB(B0, 1, 0); PG8_LDB(B1, 1, 1); PG8_SCHED; PG8_LDA(At, 1, 0); PG8_STAGE(PG8_SA(0, 1), a2 + hstep, voffA);
            PG8_WAIT_V(8); PG8_WAIT_L(0); PG8_BAR; PG8_MMA(0, 0, At, B0); PG8_MMA(0, 1, At, B1); PG8_BAR; PG8_SCHED;
            PG8_LDA(At, 1, 1); PG8_STAGE(PG8_SB(1, 0), b3, voffB); PG8_STAGE(PG8_SB(1, 1), b3 + hstep, voffB); PG8_STAGE(PG8_SA(1, 0), a3, voffA);
            PG8_WAIT_V(8); PG8_WAIT_L(0); PG8_BAR; PG8_MMA(1, 0, At, B0); PG8_MMA(1, 1, At, B1); PG8_BAR; PG8_SCHED;
            } else {
            PG8_LDB(B0, 0, 0); PG8_SCHED; PG8_LDA(At, 0, 0); PG8_STAGE(PG8_SA(1, 1), a1 + hstep, voffA);
            PG8_WAIT_L(8); PG8_BAR; PG8_WAIT_L(0); PG8_MMA(0, 0, At, B0); PG8_BAR; PG8_SCHED;
            PG8_LDB(B1, 0, 1); PG8_STAGE(PG8_SB(0, 0), b2, voffB);
            PG8_BAR; PG8_WAIT_L(0); PG8_MMA(0, 1, At, B1); PG8_BAR;
            PG8_LDA(At, 0, 1); PG8_STAGE(PG8_SA(0, 0), a2, voffA);
            PG8_BAR; PG8_WAIT_L(0); PG8_MMA(1, 0, At, B0); PG8_BAR; PG8_SCHED;
            PG8_STAGE(PG8_SB(0, 1), b2 + hstep, voffB);
            PG8_WAIT_V(6); PG8_BAR; PG8_MMA(1, 1, At, B1); PG8_BAR;
            PG8_LDB(B0, 1, 0); PG8_SCHED; PG8_LDA(At, 1, 0); PG8_STAGE(PG8_SA(0, 1), a2 + hstep, voffA);
            PG8_WAIT_L(8); PG8_BAR; PG8_WAIT_L(0); PG8_MMA(0, 0, At, B0); PG8_BAR; PG8_SCHED;
            PG8_LDB(B1, 1, 1); PG8_STAGE(PG8_SB(1, 0), b3, voffB);
            PG8_BAR; PG8_WAIT_L(0); PG8_MMA(0, 1, At, B1); PG8_BAR;
            PG8_LDA(At, 1, 1); PG8_STAGE(PG8_SA(1, 0), a3, voffA);
            PG8_BAR; PG8_WAIT_L(0); PG8_MMA(1, 0, At, B0); PG8_BAR; PG8_SCHED;
            PG8_STAGE(PG8_SB(1, 1), b3 + hstep, voffB);
            PG8_WAIT_V(6); PG8_BAR; PG8_MMA(1, 1, At, B1); PG8_BAR;
            }
        }
        if constexpr (ALIGN_EPI) { if (wr == 0) PG8_BAR; }
        if constexpr (!Epi::AFTER_DRAIN) { E(acc, cur, wr, wc, fr, fq); S.done(cur); }
        if (!has_next) break;
#pragma unroll
        for (int a = 0; a < 2; ++a)
#pragma unroll
            for (int b = 0; b < 2; ++b)
#pragma unroll
                for (int m = 0; m < 4; ++m)
#pragma unroll
                    for (int n = 0; n < 2; ++n) acc[a][b][m][n] = (f32x4){0.f, 0.f, 0.f, 0.f};
        cur = nxt; cA = nA; cB = nB; ++ui;
        if constexpr (ALIGN_EPI) { if (wr == 1) PG8_BAR; }
    }
    PG8_WAIT_V(0);
    if constexpr (!ALIGN_EPI) { if (wr == 0) PG8_BAR; }
    PG8_BAR;
    if constexpr (Epi::AFTER_DRAIN) { E.fused(acc, cur, wr, wc, fr, fq, lds, wid, lane); S.done(cur); }
#undef PG8_SA
#undef PG8_ABASE
#undef PG8_SB
#undef PG8_STAGE
#undef PG8_LDA
#undef PG8_LDB
#undef PG8_MMA
#undef PG8_WAIT_V
#undef PG8_WAIT_L
#undef PG8_BAR
#undef PG8_SCHED
}
}
namespace pg8 {
typedef float f32x2_t __attribute__((ext_vector_type(2))); typedef __bf16 bf16x2_t __attribute__((ext_vector_type(2)));
__device__ __forceinline__ unsigned cvtpk_hw(float lo, float hi) { f32x2_t v = {lo, hi}; bf16x2_t b = __builtin_convertvector(v, bf16x2_t); return __builtin_bit_cast(unsigned, b); }
__device__ __forceinline__ unsigned short f2bf_rne(float f) { return (unsigned short)(cvtpk_hw(f, 0.f) & 0xffffu); }
struct EpiL0 {
    static constexpr bool PERM = true, AFTER_DRAIN = false;
    bf16_t* xvt_lat; bf16_t* xvt_ctx; bf16_t* qkvg; const float* qn; const float* kn; PG8_LAS float* xch;
    __device__ __forceinline__ void operator()(f32x4 (&acc)[2][2][4][2], const Unit& u, int wr, int wc, int fr, int fq) const {
        if (u.pn >= 16 && u.pn <= 20) {
            const float* gw = u.pn < 20 ? qn : kn; const bool lat = u.pm < 64;
#pragma unroll
            for (int ai = 0; ai < 2; ++ai)
#pragma unroll
                for (int m = 0; m < 4; ++m)
#pragma unroll
                    for (int bj = 0; bj < 2; ++bj) { const f32x4 v0 = acc[ai][bj][m][0], v1 = acc[ai][bj][m][1];
                        float ss = (v0[0] * v0[0] + v0[1] * v0[1]) + (v0[2] * v0[2] + v0[3] * v0[3]) + (v1[0] * v1[0] + v1[1] * v1[1]) + (v1[2] * v1[2] + v1[3] * v1[3]);
                        ss += __shfl_xor(ss, 16); ss += __shfl_xor(ss, 32);
                        if (fq == 0) xch[((ai * HALF + wr * 64 + m * 16 + fr) * 2 + bj) * 4 + wc] = ss; }
            asm volatile("s_waitcnt lgkmcnt(0)" ::: "memory"); __builtin_amdgcn_s_barrier(); asm volatile("" ::: "memory");
            const int kb = 16 * wc + 4 * fq;
            const int ob = wc < 2 ? kb : kb + 32;
            float iv[4];
#pragma unroll
            for (int q = 0; q < 4; ++q) { iv[q] = __builtin_amdgcn_exp2f(-(float)((kb + q) & 31) * (13.287712379549449f / 32.f)) * 0.15915494309189535f; }
            const int row0 = u.pm * BM + wr * 64 + fr; const int col0 = (u.pn - 16) * BM + wc * 32 + 8 * fq;
#pragma unroll
            for (int ai = 0; ai < 2; ++ai)
#pragma unroll
                for (int m = 0; m < 4; ++m) { const int rl = ai * HALF + wr * 64 + m * 16 + fr; const int t = (u.pm * BM + rl) & 4095; const float pos = (float)(wc < 2 ? (t >> 6) : (t & 63));
                    float cs[4], sn[4];
#pragma unroll
                    for (int q = 0; q < 4; ++q) { const float a = pos * iv[q]; cs[q] = lat ? __builtin_amdgcn_cosf(a) : 1.f; sn[q] = lat ? __builtin_amdgcn_sinf(a) : 0.f; }
                    bf16_t* rowp = qkvg + (size_t)(row0 + ai * HALF + m * 16) * 2560 + col0;
                    asm volatile("" ::: "memory");
                    const f32x4 gA = *(const f32x4*)(gw + ob), gB = *(const f32x4*)(gw + ob + 32); const float g1[4] = {gA[0], gA[1], gA[2], gA[3]}, g2[4] = {gB[0], gB[1], gB[2], gB[3]};
#pragma unroll
                    for (int bj = 0; bj < 2; ++bj) { const f32x4 p = *(const PG8_LAS f32x4*)(xch + (rl * 2 + bj) * 4); const float r = __builtin_amdgcn_rsqf(((p[0] + p[1]) + (p[2] + p[3])) * (1.f / 128.f) + 1e-6f);
                        const f32x4 v0 = acc[ai][bj][m][0], v1 = acc[ai][bj][m][1];
                        const float a0 = v0[0] * r * g1[0], b0 = v0[1] * r * g2[0], a1 = v0[2] * r * g1[1], b1 = v0[3] * r * g2[1];
                        const float a2 = v1[0] * r * g1[2], b2 = v1[1] * r * g2[2], a3 = v1[2] * r * g1[3], b3 = v1[3] * r * g2[3];
                        u32x4 w; w.x = cvt_pk_bf16(a0 * cs[0] - b0 * sn[0], a0 * sn[0] + b0 * cs[0]); w.y = cvt_pk_bf16(a1 * cs[1] - b1 * sn[1], a1 * sn[1] + b1 * cs[1]);
                        w.z = cvt_pk_bf16(a2 * cs[2] - b2 * sn[2], a2 * sn[2] + b2 * cs[2]); w.w = cvt_pk_bf16(a3 * cs[3] - b3 * sn[3], a3 * sn[3] + b3 * cs[3]);
                        *(u32x4*)(rowp + bj * HALF) = w; } }
        } else if (u.pn >= 16) {
            const int row0 = u.pm * BM + wr * 64 + fr; const int col0 = (u.pn - 16) * BM + wc * 32 + 8 * fq;
#pragma unroll
            for (int ai = 0; ai < 2; ++ai)
#pragma unroll
                for (int m = 0; m < 4; ++m) { bf16_t* rowp = qkvg + (size_t)(row0 + ai * HALF + m * 16) * 2560 + col0;
#pragma unroll
                    for (int bj = 0; bj < 2; ++bj) { const f32x4 v0 = acc[ai][bj][m][0], v1 = acc[ai][bj][m][1];
                        u32x4 w; w.x = cvt_pk_bf16(v0[0], v0[1]); w.y = cvt_pk_bf16(v0[2], v0[3]); w.z = cvt_pk_bf16(v1[0], v1[1]); w.w = cvt_pk_bf16(v1[2], v1[3]);
                        *(u32x4*)(rowp + bj * HALF) = w; } }
        } else {
            bf16_t* dst; int nt, t0;
            if (u.pm < 64) { const int b = u.pm >> 4; nt = 4096; t0 = (u.pm & 15) * 256; dst = xvt_lat + (size_t)b * 4096 * 4096; }
            else { const int b = u.pm - 64; nt = 256; t0 = 0; dst = xvt_ctx + (size_t)b * 4096 * 256; }
            const int ch0 = u.pn * BM + wc * 32 + 8 * fq; const int tl0 = t0 + wr * 64 + fr;
#pragma unroll
            for (int bj = 0; bj < 2; ++bj)
#pragma unroll
                for (int n = 0; n < 2; ++n)
#pragma unroll
                    for (int j = 0; j < 4; ++j) { bf16_t* cp = dst + (size_t)(ch0 + bj * HALF + 4 * n + j) * nt + tl0;
#pragma unroll
                        for (int ai = 0; ai < 2; ++ai)
#pragma unroll
                            for (int m = 0; m < 4; ++m) cp[ai * HALF + m * 16] = f2bf_rne(acc[ai][bj][m][n][j]); }
        }
    }
};
struct EpiL1a {
    static constexpr bool PERM = true, AFTER_DRAIN = false;
    bf16_t* y; float* gates; const float* gate_b;
    __device__ __forceinline__ void operator()(const f32x4 (&acc)[2][2][4][2], const Unit& u, int wr, int wc, int fr, int fq) const {
        const int row0 = u.pm * BM + wr * 64 + fr;
        if (u.pn < 16) {
            const int col0 = u.pn * BM + wc * 32 + 8 * fq;
#pragma unroll
            for (int ai = 0; ai < 2; ++ai)
#pragma unroll
                for (int m = 0; m < 4; ++m) { bf16_t* rowp = y + (size_t)(row0 + ai * HALF + m * 16) * 4096 + col0;
#pragma unroll
                    for (int bj = 0; bj < 2; ++bj) { const f32x4 v0 = acc[ai][bj][m][0], v1 = acc[ai][bj][m][1];
                        u32x4 w; w.x = cvt_pk_bf16(v0[0], v0[1]); w.y = cvt_pk_bf16(v0[2], v0[3]); w.z = cvt_pk_bf16(v1[0], v1[1]); w.w = cvt_pk_bf16(v1[2], v1[3]);
                        *(u32x4*)(rowp + bj * HALF) = w; } }
        } else if (wc == 0) {
            const int c0 = 8 * fq;
            const f32x4 b0 = *(const f32x4*)(gate_b + c0), b1 = *(const f32x4*)(gate_b + c0 + 4);
#pragma unroll
            for (int ai = 0; ai < 2; ++ai)
#pragma unroll
                for (int m = 0; m < 4; ++m) { float* rowp = gates + (size_t)(row0 + ai * HALF + m * 16) * 32 + c0;
                    *(f32x4*)(rowp) = acc[ai][0][m][0] + b0; *(f32x4*)(rowp + 4) = acc[ai][0][m][1] + b1; }
        }
    }
};
struct EpiF32Slab {
    static constexpr bool PERM = false, AFTER_DRAIN = false;
    float* C; int ldc; size_t slab;
    __device__ __forceinline__ void operator()(const f32x4 (&acc)[2][2][4][2], const Unit& u, int wr, int wc, int fr, int fq) const {
        const int row0 = u.pm * BM + wr * 64 + fr, col0 = u.pn * BM + wc * 32 + 4 * fq; float* Cs = C + (size_t)u.kc * slab;
#pragma unroll
        for (int ai = 0; ai < 2; ++ai)
#pragma unroll
            for (int m = 0; m < 4; ++m) { float* rowp = Cs + (size_t)(row0 + ai * HALF + m * 16) * ldc + col0;
#pragma unroll
                for (int bj = 0; bj < 2; ++bj)
#pragma unroll
                    for (int n = 0; n < 2; ++n) *(f32x4*)(rowp + bj * HALF + n * 16) = acc[ai][bj][m][n]; }
    }
};
struct SplitKOrder {
    int G, c;
    __device__ bool next(int i, Unit& u) const { const int L = i * G + c; if (L >= 128) return false; u.kc = L & 7; u.pm = (L >> 3) >> 2; u.pn = (L >> 3) & 3; return true; }
    __device__ __forceinline__ void a_ready(const Unit&) const {}
    __device__ __forceinline__ void done(const Unit&) const {}
};
}

namespace pg8 {
struct EpiOZ {
    static constexpr bool PERM = true, AFTER_DRAIN = false;
    bf16_t* hb; const float* hn; PG8_LAS float* xch;
    __device__ __forceinline__ static float bflo(unsigned w) { return __builtin_bit_cast(float, w << 16); }
    __device__ __forceinline__ static float bfhi(unsigned w) { return __builtin_bit_cast(float, w & 0xffff0000u); }
    __device__ __forceinline__ void operator()(f32x4 (&acc)[2][2][4][2], const Unit& u, int wr, int wc, int fr, int fq) const {
        const int row0 = u.pm * BM + wr * 64 + fr;
        if (u.pn < 8) {
            const int col0 = u.pn * BM + wc * 32 + 8 * fq;
#pragma unroll
            for (int ai = 0; ai < 2; ++ai)
#pragma unroll
                for (int m = 0; m < 4; ++m) { const bf16_t* rowp = hb + (size_t)(row0 + ai * HALF + m * 16) * 2048 + col0; float ss = 0.f;
#pragma unroll
                    for (int bj = 0; bj < 2; ++bj) { const u32x4 hv = *(const u32x4*)(rowp + bj * HALF); f32x4& v0 = acc[ai][bj][m][0]; f32x4& v1 = acc[ai][bj][m][1];
                        v0[0] = bflo(hv.x) * __builtin_amdgcn_rcpf(1.f + __expf(-v0[0])); v0[1] = bfhi(hv.x) * __builtin_amdgcn_rcpf(1.f + __expf(-v0[1])); v0[2] = bflo(hv.y) * __builtin_amdgcn_rcpf(1.f + __expf(-v0[2])); v0[3] = bfhi(hv.y) * __builtin_amdgcn_rcpf(1.f + __expf(-v0[3]));
                        v1[0] = bflo(hv.z) * __builtin_amdgcn_rcpf(1.f + __expf(-v1[0])); v1[1] = bfhi(hv.z) * __builtin_amdgcn_rcpf(1.f + __expf(-v1[1])); v1[2] = bflo(hv.w) * __builtin_amdgcn_rcpf(1.f + __expf(-v1[2])); v1[3] = bfhi(hv.w) * __builtin_amdgcn_rcpf(1.f + __expf(-v1[3]));
                        ss += (v0[0] * v0[0] + v0[1] * v0[1]) + (v0[2] * v0[2] + v0[3] * v0[3]) + (v1[0] * v1[0] + v1[1] * v1[1]) + (v1[2] * v1[2] + v1[3] * v1[3]); }
                    ss += __shfl_xor(ss, 16); ss += __shfl_xor(ss, 32);
                    if (fq == 0) xch[(ai * HALF + wr * 64 + m * 16 + fr) * 4 + wc] = ss; }
            asm volatile("s_waitcnt lgkmcnt(0)" ::: "memory"); __builtin_amdgcn_s_barrier(); asm volatile("" ::: "memory");
#pragma unroll
            for (int bj = 0; bj < 2; ++bj) { const f32x4 g0 = *(const f32x4*)(hn + col0 + bj * HALF), g1 = *(const f32x4*)(hn + col0 + bj * HALF + 4);
#pragma unroll
                for (int ai = 0; ai < 2; ++ai)
#pragma unroll
                    for (int m = 0; m < 4; ++m) { const int rl = ai * HALF + wr * 64 + m * 16 + fr; const f32x4 p = *(const PG8_LAS f32x4*)(xch + rl * 4);
                        const float r = __builtin_amdgcn_rsqf(((p[0] + p[1]) + (p[2] + p[3])) * (1.f / 256.f) + 1e-6f);
                        bf16_t* rowp = hb + (size_t)(row0 + ai * HALF + m * 16) * 2048 + col0;
                        const f32x4 v0 = acc[ai][bj][m][0] * r * g0, v1 = acc[ai][bj][m][1] * r * g1;
                        u32x4 w; w.x = cvt_pk_bf16(v0[0], v0[1]); w.y = cvt_pk_bf16(v0[2], v0[3]); w.z = cvt_pk_bf16(v1[0], v1[1]); w.w = cvt_pk_bf16(v1[2], v1[3]);
                        *(u32x4*)(rowp + bj * HALF) = w; } }
        } else {
            const int col0 = (u.pn - 8) * BM + wc * 32 + 8 * fq;
#pragma unroll
            for (int ai = 0; ai < 2; ++ai)
#pragma unroll
                for (int m = 0; m < 4; ++m) { bf16_t* rowp = hb + (size_t)(row0 + ai * HALF + m * 16) * 2048 + col0;
                    const u32x4 hq[2] = {*(const u32x4*)rowp, *(const u32x4*)(rowp + HALF)};
#pragma unroll
                    for (int bj = 0; bj < 2; ++bj) { const u32x4 hv = hq[bj]; const f32x4 a0 = acc[ai][bj][m][0], a1 = acc[ai][bj][m][1];
                        u32x4 w; w.x = cvt_pk_bf16(bflo(hv.x) * a0[0] * __builtin_amdgcn_rcpf(1.f + __expf(-a0[0])), bfhi(hv.x) * a0[1] * __builtin_amdgcn_rcpf(1.f + __expf(-a0[1])));
                        w.y = cvt_pk_bf16(bflo(hv.y) * a0[2] * __builtin_amdgcn_rcpf(1.f + __expf(-a0[2])), bfhi(hv.y) * a0[3] * __builtin_amdgcn_rcpf(1.f + __expf(-a0[3])));
                        w.z = cvt_pk_bf16(bflo(hv.z) * a1[0] * __builtin_amdgcn_rcpf(1.f + __expf(-a1[0])), bfhi(hv.z) * a1[1] * __builtin_amdgcn_rcpf(1.f + __expf(-a1[1])));
                        w.w = cvt_pk_bf16(bflo(hv.w) * a1[2] * __builtin_amdgcn_rcpf(1.f + __expf(-a1[2])), bfhi(hv.w) * a1[3] * __builtin_amdgcn_rcpf(1.f + __expf(-a1[3])));
                        *(u32x4*)(rowp + bj * HALF) = w; } }
        }
    }
};
struct PairOrder {
    int G, c;
    __device__ bool next(int i, Unit& u) const { const int r = i >> 1; if (r >= 512 / G) return false; const int x = c & 7, y = c >> 3, head = y & 7; u.pm = r * (G >> 3) + x * (G >> 6) + (y >> 3); u.pn = (i & 1) ? 8 + head : head; u.kc = 0; return true; }
    __device__ __forceinline__ void a_ready(const Unit&) const {}
    __device__ __forceinline__ void done(const Unit&) const {}
};
}
namespace attn {
using bf16 = unsigned short;
constexpr int D = 128, NW = 8, QBLK = 32, KVBLK = 64;
constexpr float SCALE = 0.088388347648318440f;
constexpr float THR = 8.f;
constexpr int SDEPTH = 2;
constexpr int LDQ = 2560, LDK = 2560, LDO = 2048, VOFF = 256, GOFF = 1536;
constexpr size_t SHM_V = KVBLK * D * 2, SHM_K = KVBLK * D * 2, SHM_ATTN = 2 * SHM_V + 2 * SHM_K + NW * 64 * 4;
using bf16x8 = __attribute__((ext_vector_type(8))) short;
using s16x4  = __attribute__((ext_vector_type(4))) short;
using f32x16 = __attribute__((ext_vector_type(16))) float;
using u32x4  = __attribute__((ext_vector_type(4))) unsigned;
#define KSWZ(row, colB) ((row) * 256 + ((colB) ^ (((row) & 7) << 4)))
#define SBAR() __builtin_amdgcn_sched_barrier(0)
__device__ __forceinline__ int crow(int r, int hi) { return (r & 3) + 8 * (r >> 2) + 4 * hi; }
__device__ __forceinline__ unsigned cvtpk(float lo, float hi) { unsigned r; asm volatile("v_cvt_pk_bf16_f32 %0, %1, %2" : "=v"(r) : "v"(lo), "v"(hi)); return r; }
__device__ __forceinline__ bf16x8 ld8(const bf16* p) { return *reinterpret_cast<const bf16x8*>(p); }
__device__ __forceinline__ void partialSM(f32x16& p0, f32x16& p1, float& m_reg, float& mn, float& alpha) {
  constexpr float C = SCALE * 1.4426950408889634f;
  float pmax = p0[0]; for (int r = 1; r < 16; ++r) pmax = fmaxf(pmax, p0[r]); for (int r = 0; r < 16; ++r) pmax = fmaxf(pmax, p1[r]);
  { auto rr = __builtin_amdgcn_permlane32_swap(__float_as_uint(pmax), __float_as_uint(pmax), false, false);
    pmax = fmaxf(__uint_as_float(rr[0]), __uint_as_float(rr[1])); }
  if (__builtin_expect(__all(pmax - m_reg <= THR / SCALE), 1)) { mn = m_reg; alpha = 1.f; }
  else { mn = fmaxf(m_reg, pmax); alpha = __builtin_amdgcn_exp2f((m_reg - mn) * C); m_reg = mn; }
  float mnC = -mn * C;
  for (int r = 0; r < 16; ++r) p0[r] = fmaf(p0[r], C, mnC); for (int r = 0; r < 16; ++r) p1[r] = fmaf(p1[r], C, mnC);
  for (int r = 0; r < 16; ++r) p0[r] = __builtin_amdgcn_exp2f(p0[r]);
}
__device__ __forceinline__ void finishSM(f32x16& p0, f32x16& p1, float alpha, float& l_reg, bf16x8& pa0, bf16x8& pa1, bf16x8& pa2, bf16x8& pa3) {
  for (int r = 0; r < 16; ++r) p1[r] = __builtin_amdgcn_exp2f(p1[r]);
  float ps = 0; for (int r = 0; r < 16; ++r) ps += p0[r]; for (int r = 0; r < 16; ++r) ps += p1[r];
  { auto rr = __builtin_amdgcn_permlane32_swap(__float_as_uint(ps), __float_as_uint(ps), false, false);
    ps = __uint_as_float(rr[0]) + __uint_as_float(rr[1]); }
  l_reg = l_reg * alpha + ps;
#define PK4(P, BASE, OUT) do { unsigned a0 = cvtpk(P[BASE + 0], P[BASE + 1]), a1 = cvtpk(P[BASE + 2], P[BASE + 3]);   \
    unsigned b0 = cvtpk(P[BASE + 4], P[BASE + 5]), b1 = cvtpk(P[BASE + 6], P[BASE + 7]);                              \
    auto r0 = __builtin_amdgcn_permlane32_swap(a0, b0, false, false); auto r1 = __builtin_amdgcn_permlane32_swap(a1, b1, false, false); \
    u32x4 w = {r0[0], r1[0], r0[1], r1[1]}; OUT = *reinterpret_cast<bf16x8*>(&w); } while (0)
  PK4(p0, 0, pa0); PK4(p0, 8, pa1); PK4(p1, 0, pa2); PK4(p1, 8, pa3);
#undef PK4
}
__device__ __forceinline__ void qkt(f32x16& p0, f32x16& p1, const bf16* Ks, const bf16x8* qr, int r32, int hi) {
  p0 = f32x16{}; p1 = f32x16{};
  for (int d0 = 0; d0 < 8; ++d0) { int cb = (d0 * 16 + hi * 8) * 2;
    bf16x8 b0 = *reinterpret_cast<const bf16x8*>((const char*)Ks + KSWZ(r32, cb));
    bf16x8 b1 = *reinterpret_cast<const bf16x8*>((const char*)Ks + KSWZ(32 + r32, cb));
    p0 = __builtin_amdgcn_mfma_f32_32x32x16_bf16(b0, qr[d0], p0, 0, 0, 0);
    p1 = __builtin_amdgcn_mfma_f32_32x32x16_bf16(b1, qr[d0], p1, 0, 0, 0); }
}
__device__ __forceinline__ int v_st(int k, int c) { const int kk = (k & ~0xC) | ((k & 4) << 1) | ((k & 8) >> 1); return ((kk >> 3) * 4 + (c >> 5)) * 512 + ((kk & 7) * 32 + (c & 31)) * 2; }
__device__ __forceinline__ int v_rd_base(int lane) { return ((lane & 3) << 3) | (((lane >> 2) & 3) << 6) | (((lane >> 4) & 1) << 5) | (((lane >> 5) & 1) << 8); }
constexpr int v_rd_off(int d0, int ks, int half) { return d0 * 512 + ks * 4096 + half * 2048; }
template <int OFF> __device__ __forceinline__ s16x4 tr_read(int vb) {
  s16x4 r; asm volatile("ds_read_b64_tr_b16 %0, %1 offset:%2" : "=&v"(r) : "v"(vb), "i"(OFF) : "memory"); return r;
}
template <int D0> __device__ __forceinline__ void pv_one(f32x16& od, int vb, bf16x8 pa0, bf16x8 pa1, bf16x8 pa2, bf16x8 pa3) {
  const s16x4 l0 = tr_read<v_rd_off(D0, 0, 0)>(vb), h0 = tr_read<v_rd_off(D0, 0, 1)>(vb), l1 = tr_read<v_rd_off(D0, 1, 0)>(vb), h1 = tr_read<v_rd_off(D0, 1, 1)>(vb);
  const s16x4 l2 = tr_read<v_rd_off(D0, 2, 0)>(vb), h2 = tr_read<v_rd_off(D0, 2, 1)>(vb), l3 = tr_read<v_rd_off(D0, 3, 0)>(vb), h3 = tr_read<v_rd_off(D0, 3, 1)>(vb);
  asm volatile("s_waitcnt lgkmcnt(0)" ::: "memory"); SBAR();
#define PK(L, H) (bf16x8){L[0], L[1], L[2], L[3], H[0], H[1], H[2], H[3]}
  od = __builtin_amdgcn_mfma_f32_32x32x16_bf16(pa0, PK(l0, h0), od, 0, 0, 0);
  od = __builtin_amdgcn_mfma_f32_32x32x16_bf16(pa1, PK(l1, h1), od, 0, 0, 0);
  od = __builtin_amdgcn_mfma_f32_32x32x16_bf16(pa2, PK(l2, h2), od, 0, 0, 0);
  od = __builtin_amdgcn_mfma_f32_32x32x16_bf16(pa3, PK(l3, h3), od, 0, 0, 0);
#undef PK
}
__device__ __forceinline__ void pv_d0(f32x16* o, int vb, bf16x8 pa0, bf16x8 pa1, bf16x8 pa2, bf16x8 pa3) {
  pv_one<0>(o[0], vb, pa0, pa1, pa2, pa3); pv_one<1>(o[1], vb, pa0, pa1, pa2, pa3); pv_one<2>(o[2], vb, pa0, pa1, pa2, pa3); pv_one<3>(o[3], vb, pa0, pa1, pa2, pa3);
}
__device__ __forceinline__ void attn_dense_body(const bf16* __restrict__ Qb, __amdgpu_buffer_rsrc_t kvrs, unsigned kb0, unsigned kb1, int seg0, const bf16* __restrict__ Gb,
                                                bf16* __restrict__ Ob, int seq, char* lds, int wrows = QBLK) {
  int tid_ = threadIdx.x; asm volatile("" : "+v"(tid_));
  const int tid = tid_, wid = tid >> 6, lane = tid & 63, r32 = lane & 31, hi = lane >> 5;
  bf16* V_lds = (bf16*)lds; bf16* K_lds = (bf16*)(lds + 2 * SHM_V);
  float* ws = (float*)(lds + 2 * SHM_V + 2 * SHM_K) + wid * 64; float* li_l = ws; float* al_l = ws + 32;
  float m_reg = -1e30f, l_reg = 0; f32x16 o[4] = {}; bf16x8 qr[8];
  const bf16* Qw = Qb + (long)(wid * wrows + r32) * LDQ + hi * 8;
#pragma unroll
  for (int d0 = 0; d0 < 8; ++d0) qr[d0] = ld8(Qw + d0 * 16);
  const int sr = tid >> 4, sc = (tid & 15) * 8, vst0 = v_st(sr, sc), vst1 = v_st(32 + sr, sc);
  const int vb0 = (int)(uintptr_t)V_lds + v_rd_base(lane);
  struct { bf16x8 vs0, vs1, ks0, ks1; } sr_[SDEPTH];
  const unsigned vo0 = (unsigned)(sr * LDK + sc) * 2u, vo1 = (unsigned)((32 + sr) * LDK + sc) * 2u;
#define BLD(vo, so) __builtin_bit_cast(bf16x8, __builtin_amdgcn_raw_buffer_load_b128(kvrs, (int)(vo), (int)(so), 0))
#define SLOAD(i, k0) do { const unsigned so_ = ((k0) < seg0) ? kb0 + (unsigned)(k0) * (LDK * 2) : kb1 + (unsigned)((k0) - seg0) * (LDK * 2); \
    sr_[i].vs0 = BLD(vo0 + VOFF * 2, so_); sr_[i].vs1 = BLD(vo1 + VOFF * 2, so_); \
    sr_[i].ks0 = BLD(vo0, so_); sr_[i].ks1 = BLD(vo1, so_); } while (0)
#define SWRITE(b, i) do { *(bf16x8*)((char*)V_lds + (b) * SHM_V + vst0) = sr_[i].vs0;          \
    *(bf16x8*)((char*)V_lds + (b) * SHM_V + vst1) = sr_[i].vs1; int kc = sc * 2;               \
    *(bf16x8*)((char*)K_lds + (b) * SHM_K + KSWZ(sr, kc)) = sr_[i].ks0;                       \
    *(bf16x8*)((char*)K_lds + (b) * SHM_K + KSWZ(32 + sr, kc)) = sr_[i].ks1; } while (0)
#define SWAIT() do { if constexpr (SDEPTH == 2) asm volatile("s_waitcnt vmcnt(4)" ::: "memory"); else asm volatile("s_waitcnt vmcnt(0)" ::: "memory"); } while (0)
#define RESC(a) do { if (__any((a) < 1.f)) { if (hi == 0) al_l[r32] = (a); asm volatile("s_waitcnt lgkmcnt(0)" ::: "memory"); \
    for (int d = 0; d < 4; ++d) for (int r = 0; r < 16; ++r) o[d][r] *= al_l[crow(r, hi)]; } } while (0)
  f32x16 pA0, pA1, pB0, pB1; float mnA, mnB, alA, alB; bf16x8 pa0, pa1, pa2, pa3; const int NT = seq / KVBLK;
  constexpr int SE = 0, SO = SDEPTH - 1;
  SLOAD(SE, 0); asm volatile("s_waitcnt vmcnt(0)" ::: "memory"); SWRITE(0, SE); __syncthreads();
  qkt(pA0, pA1, K_lds, qr, r32, hi); partialSM(pA0, pA1, m_reg, mnA, alA);
  SLOAD(SO, KVBLK); if constexpr (SDEPTH == 2) { if (2 < NT) SLOAD(SE, 2 * KVBLK); }
  SWAIT(); SWRITE(1, SO); __syncthreads();
  for (int j = 1; j + 1 < NT; j += 2) {
    SBAR(); qkt(pB0, pB1, (bf16*)((char*)K_lds + SHM_K), qr, r32, hi);
    finishSM(pA0, pA1, alA, l_reg, pa0, pa1, pa2, pa3); SBAR();
    SLOAD(SO, (j + SDEPTH) * KVBLK); SBAR();
    pv_d0(o, vb0, pa0, pa1, pa2, pa3); partialSM(pB0, pB1, m_reg, mnB, alB);
    __syncthreads(); SWAIT(); SWRITE(0, SE);
    RESC(alB); __syncthreads();
    SBAR(); qkt(pA0, pA1, K_lds, qr, r32, hi);
    finishSM(pB0, pB1, alB, l_reg, pa0, pa1, pa2, pa3); SBAR();
    if (SDEPTH == 1 || j + 3 < NT) SLOAD(SE, (j + 1 + SDEPTH) * KVBLK); SBAR();
    pv_d0(o, vb0 + (int)SHM_V, pa0, pa1, pa2, pa3); partialSM(pA0, pA1, m_reg, mnA, alA);
    __syncthreads(); SWAIT(); SWRITE(1, SO);
    RESC(alA); __syncthreads();
  }
  SBAR(); qkt(pB0, pB1, (bf16*)((char*)K_lds + SHM_K), qr, r32, hi);
  finishSM(pA0, pA1, alA, l_reg, pa0, pa1, pa2, pa3); SBAR();
  pv_d0(o, vb0, pa0, pa1, pa2, pa3); partialSM(pB0, pB1, m_reg, mnB, alB);
  __syncthreads(); RESC(alB);
  finishSM(pB0, pB1, alB, l_reg, pa0, pa1, pa2, pa3); SBAR();
  pv_d0(o, vb0 + (int)SHM_V, pa0, pa1, pa2, pa3);
  if (hi == 0) li_l[r32] = l_reg; asm volatile("s_waitcnt lgkmcnt(0)" ::: "memory");
  float rli[16];
#pragma unroll
  for (int r = 0; r < 16; ++r) rli[r] = __builtin_amdgcn_rcpf(li_l[crow(r, hi)]);
  bf16* Ow = Ob + (long)(wid * wrows) * LDO; const bf16* Gw = Gb + (long)(wid * wrows) * LDQ;
  asm volatile("" ::: "memory"); SBAR();
  { const bool odd = (r32 & 1) != 0; const int cb2 = r32 & ~1;
#define NSWAP(x_) __builtin_amdgcn_update_dpp(0, (int)(x_), 0xB1, 0xF, 0xF, true)
#pragma unroll
    for (int rh = 0; rh < 2; ++rh) {
      unsigned gw_[4][4];
#pragma unroll
      for (int p = 0; p < 4; ++p) { const int myrow = crow(rh * 8 + 2 * p + (odd ? 1 : 0), hi);
#pragma unroll
        for (int d0 = 0; d0 < 4; ++d0) gw_[p][d0] = *(const unsigned*)(Gw + (long)myrow * LDQ + d0 * 32 + cb2); }
      asm volatile("" ::: "memory");
#pragma unroll
      for (int p = 0; p < 4; ++p) { const int r0 = rh * 8 + 2 * p, r1 = r0 + 1; const int myrow = crow(odd ? r1 : r0, hi);
#pragma unroll
        for (int d0 = 0; d0 < 4; ++d0) { const unsigned own = gw_[p][d0], nbr = (unsigned)NSWAP(own);
          const unsigned wA = odd ? nbr : own, wB = odd ? own : nbr;
          const float gA = __uint_as_float(odd ? (wA & 0xffff0000u) : (wA << 16)), gB = __uint_as_float(odd ? (wB & 0xffff0000u) : (wB << 16));
          const float oA = o[d0][r0] * rli[r0] * (gA * __builtin_amdgcn_rcpf(1.f + __expf(-gA))), oB = o[d0][r1] * rli[r1] * (gB * __builtin_amdgcn_rcpf(1.f + __expf(-gB)));
          const unsigned bA = pg8::f2bf_rne(oA), bB = pg8::f2bf_rne(oB);
          const unsigned recv = (unsigned)NSWAP(odd ? bA : bB);
          const unsigned word = odd ? (recv | (bB << 16)) : (bA | (recv << 16));
          *(unsigned*)(Ow + (long)myrow * LDO + d0 * 32 + cb2) = word; } }
      asm volatile("" ::: "memory"); }
#undef NSWAP
  }
  __syncthreads();
#undef SLOAD
#undef BLD
#undef SWRITE
#undef SWAIT
#undef RESC
}
#undef KSWZ
#undef SBAR
}
#define LAS __attribute__((address_space(3)))
typedef unsigned short bf16_t;
typedef float f32x4 __attribute__((ext_vector_type(4)));
typedef float f32x2 __attribute__((ext_vector_type(2)));
typedef short bf16x8 __attribute__((ext_vector_type(8)));
typedef unsigned u32x2 __attribute__((ext_vector_type(2)));
constexpr int DM = 1024, NB = 4, SEQ = 4096, CTXL = 256, MLAT = NB * SEQ, MCTX = NB * CTXL, MTOT = MLAT + MCTX;
constexpr float EPS = 1e-6f;
constexpr size_t MiB = 1u << 20;
constexpr size_t WS_CTL = 0, CTL_ZERO_BYTES = 256 * 1024, WS_MODS = 65536, WS_HDN = 512 * 1024, WS_GATES = 2 * MiB;
constexpr size_t WS_W0IN = 5 * MiB, WS_W0OUT = 18 * MiB, WS_QKVG = 22 * MiB, WS_XVTL = 107 * MiB, WS_XVTC = 235 * MiB, WS_A2C = 243 * MiB, WS_Y0 = 100 * MiB;
constexpr size_t WS_W1OUT = 5 * MiB, WS_W1B = 9 * MiB, WS_H1 = 17 * MiB, WS_Y1A = 51 * MiB, WS_H = 192 * MiB, WS_W1A = 192 * MiB, WS_OZ = 51 * MiB, WS_Y1 = 51 * MiB;
constexpr size_t WS_EST = 17 * MiB, WS_NST = 49 * MiB, WS_PST = 49 * MiB + 512 * 1024;
constexpr size_t WS_CTXE = 192 * MiB, WS_CTXN = 208 * MiB;
constexpr size_t WS_END = 256 * MiB;
constexpr int LDS_BYTES = 147456;
constexpr int NPHASE = 16;

__device__ __forceinline__ float bf2f(unsigned short b) { return __uint_as_float((unsigned)b << 16); }
__device__ __forceinline__ unsigned short f2bf(float f) { return pg8::f2bf_rne(f); }
__device__ __forceinline__ unsigned pk2(float lo, float hi) { return pg8::cvtpk_hw(lo, hi); }
__device__ __forceinline__ float silu_f(float x) { return x * __builtin_amdgcn_rcpf(1.f + __expf(-x)); }
__device__ __forceinline__ float sigm_f(float x) { return __builtin_amdgcn_rcpf(1.f + __expf(-x)); }
template <int CTRL, int ROWMASK> __device__ __forceinline__ float dpp_addf(float v) { return v + __builtin_bit_cast(float, __builtin_amdgcn_update_dpp(0, __builtin_bit_cast(int, v), CTRL, ROWMASK, 0xF, ROWMASK == 0xF)); }
__device__ __forceinline__ float wave_sum(float v) {
    v = dpp_addf<0xB1, 0xF>(v); v = dpp_addf<0x4E, 0xF>(v); v = dpp_addf<0x141, 0xF>(v); v = dpp_addf<0x140, 0xF>(v);
    v = dpp_addf<0x142, 0xA>(v); v = dpp_addf<0x143, 0xC>(v);
    return __builtin_bit_cast(float, __builtin_amdgcn_readlane(__builtin_bit_cast(int, v), 63));
}
#define LDS_WAIT() asm volatile("s_waitcnt lgkmcnt(0)" ::: "memory")

template <bool ROPE_PERM = false>
__device__ __forceinline__ void transpose_item(const float* __restrict__ W, int ldw, int K, int col0, bf16_t* __restrict__ WT, int row0, LAS float* scr, int kb, int lane) {
    const int k0 = 64 * kb; int sc = col0 + (lane & 31);
    if constexpr (ROPE_PERM) { const int p = sc & 127, k = p >> 1, s = p & 1; sc = (sc & ~127) + (k < 32 ? k + 32 * s : k + 32 + 32 * s); }
#pragma unroll 8
    for (int i = 0; i < 32; ++i) { const int kk = 2 * i + (lane >> 5); scr[kk * 33 + (lane & 31)] = W[(size_t)(k0 + kk) * ldw + sc]; }
    LDS_WAIT(); asm volatile("" ::: "memory");
    const int c = lane & 7;
#pragma unroll
    for (int j = 0; j < 4; ++j) { const int n = (lane >> 3) + 8 * j; const LAS float* s = scr + (8 * c) * 33 + n;
        pg8::u32x4 o; o.x = pk2(s[0 * 33], s[1 * 33]); o.y = pk2(s[2 * 33], s[3 * 33]); o.z = pk2(s[4 * 33], s[5 * 33]); o.w = pk2(s[6 * 33], s[7 * 33]);
        *(pg8::u32x4*)(WT + (size_t)(row0 + n) * K + k0 + 8 * c) = o; }
    LDS_WAIT(); asm volatile("" ::: "memory");
}

#define RIX(lane_, j) (((j) >> 1) * 128 + 2 * (lane_) + ((j) & 1))
__device__ __forceinline__ void load_row(const float* __restrict__ p, int lane, f32x4 (&v)[4]) {
#pragma unroll
    for (int j = 0; j < 4; ++j) v[j] = ((const f32x4*)p)[RIX(lane, j)];
}
__device__ __forceinline__ void load_row_bf16(const bf16_t* __restrict__ p, int lane_, f32x4 (&v)[4]) {
#pragma unroll
    for (int c = 0; c < 2; ++c) { const pg8::u32x4 w = ((const pg8::u32x4*)p)[c * 64 + lane_];
        v[2 * c] = (f32x4){bf2f((unsigned short)(w.x & 0xffffu)), bf2f((unsigned short)(w.x >> 16)), bf2f((unsigned short)(w.y & 0xffffu)), bf2f((unsigned short)(w.y >> 16))};
        v[2 * c + 1] = (f32x4){bf2f((unsigned short)(w.z & 0xffffu)), bf2f((unsigned short)(w.z >> 16)), bf2f((unsigned short)(w.w & 0xffffu)), bf2f((unsigned short)(w.w >> 16))}; }
}
__device__ __forceinline__ void store_row_bf16(bf16_t* __restrict__ p, int lane_, const f32x4 (&v)[4]) {
#pragma unroll
    for (int c = 0; c < 2; ++c) { pg8::u32x4 w; w.x = pk2(v[2 * c].x, v[2 * c].y); w.y = pk2(v[2 * c].z, v[2 * c].w); w.z = pk2(v[2 * c + 1].x, v[2 * c + 1].y); w.w = pk2(v[2 * c + 1].z, v[2 * c + 1].w);
        ((pg8::u32x4*)p)[c * 64 + lane_] = w; }
}
__device__ __forceinline__ float row_rstd(const f32x4 (&v)[4]) {
    float s = 0.f;
#pragma unroll
    for (int j = 0; j < 4; ++j) s += (v[j].x * v[j].x + v[j].y * v[j].y) + (v[j].z * v[j].z + v[j].w * v[j].w);
    return rsqrtf(wave_sum(s) * (1.f / DM) + EPS);
}
__device__ __forceinline__ void modulate_inplace(f32x4 (&v)[4], float rstd, const float* __restrict__ g, const float* __restrict__ mods, int lane) {
#pragma unroll
    for (int j = 0; j < 4; ++j) { const int q = RIX(lane, j); const f32x4 gg = ((const f32x4*)g)[q], sh = ((const f32x4*)mods)[q], sc = ((const f32x4*)(mods + DM))[q];
        v[j] = v[j] * rstd * gg * (sc + 1.f) + sh; }
}
__device__ __forceinline__ void modulate_store(const f32x4 (&v)[4], float rstd, const float* __restrict__ g, const float* __restrict__ mods, bf16_t* __restrict__ orow, int lane) {
    f32x4 h[4];
#pragma unroll
    for (int j = 0; j < 4; ++j) { const int q = RIX(lane, j); const f32x4 gg = ((const f32x4*)g)[q], sh = ((const f32x4*)mods)[q], sc = ((const f32x4*)(mods + DM))[q];
        h[j] = v[j] * rstd * gg * (sc + 1.f) + sh; }
    store_row_bf16(orow, lane, h);
}

#define HYBAR() asm volatile("s_waitcnt lgkmcnt(0)\n\ts_barrier" ::: "memory")
__device__ __forceinline__ int PH(int p) { return p + (p >> 4); }
__host__ __device__ constexpr float ck16(int k) { return k == 0 ? 1.f : k == 1 ? 0.92387953251128674f : k == 2 ? 0.70710678118654752f : k == 3 ? 0.38268343236508977f : k == 4 ? 0.f : k == 5 ? -0.38268343236508977f : k == 6 ? -0.70710678118654752f : -0.92387953251128674f; }
__host__ __device__ constexpr float sk16(int k) { return k == 0 ? 0.f : k == 1 ? 0.38268343236508977f : k == 2 ? 0.70710678118654752f : k == 3 ? 0.92387953251128674f : k == 4 ? 1.f : k == 5 ? 0.92387953251128674f : k == 6 ? 0.70710678118654752f : 0.38268343236508977f; }
template <bool INV> __device__ __forceinline__ void r16_bfly(f32x2 (&x)[16], float f8) {
    float cb[4], sb[4];
#pragma unroll
    for (int s = 0; s < 4; ++s) { const float f = f8 * (float)(1 << s); cb[s] = __builtin_amdgcn_cosf(f); sb[s] = __builtin_amdgcn_sinf(f); }
#pragma unroll
    for (int si = 0; si < 4; ++si) {
        const int s = INV ? 3 - si : si; const int hl = 8 >> s;
#pragma unroll
        for (int m0 = 0; m0 < 16; ++m0) {
            if (m0 & hl) continue;
            const int k16 = (m0 % hl) * (8 / hl);
            const float tc = cb[s] * ck16(k16) - sb[s] * sk16(k16), ts = cb[s] * sk16(k16) + sb[s] * ck16(k16);
            const f32x2 u = x[m0], v = x[m0 + hl];
            if (!INV) { const f32x2 d = u - v; x[m0] = u + v; x[m0 + hl] = (f32x2){d.x * tc + d.y * ts, d.y * tc - d.x * ts}; }
            else { const f32x2 w = (f32x2){v.x * tc - v.y * ts, v.x * ts + v.y * tc}; x[m0] = u + w; x[m0 + hl] = u - w; }
        }
    }
}
template <bool INV> __device__ __forceinline__ void r16_pass(LAS f32x2* buf, int e0, int stride, float f8) {
    f32x2 x[16];
    const int pb_ = PH(e0), step = stride + (stride >> 4);
#pragma unroll
    for (int m = 0; m < 16; ++m) x[m] = buf[pb_ + step * m];
    r16_bfly<INV>(x, f8);
#pragma unroll
    for (int m = 0; m < 16; ++m) buf[pb_ + step * m] = x[m];
}
__device__ __forceinline__ void r16_mid(LAS f32x2* zb, const LAS f32x2* fb, int e0, int ef) {
    f32x2 x[16]; const int pb_ = PH(e0), pf_ = PH(ef);
#pragma unroll
    for (int m = 0; m < 16; ++m) x[m] = zb[pb_ + m];
    r16_bfly<false>(x, 0.f);
#pragma unroll
    for (int m = 0; m < 16; ++m) { const f32x2 f = fb[pf_ + m], z = x[m]; x[m] = (f32x2){z.x * f.x - z.y * f.y, z.x * f.y + z.y * f.x}; }
    r16_bfly<true>(x, 0.f);
#pragma unroll
    for (int m = 0; m < 16; ++m) zb[pb_ + m] = x[m];
}
#define WAVE_SEAM() asm volatile("" ::: "memory")
#define OPAQUE(v) asm volatile("" : "+v"(v))
__device__ __forceinline__ void fft13_fwd_tail(LAS f32x2* buf, int tid) {
    OPAQUE(tid);
    r16_pass<false>(buf, (tid >> 8) * 4096 + (tid & 255), 256, (float)(tid & 255) * (1.f / 4096.f)); HYBAR();
    OPAQUE(tid); r16_pass<false>(buf, (tid >> 4) * 256 + (tid & 15), 16, (float)(tid & 15) * (1.f / 256.f)); WAVE_SEAM();
    OPAQUE(tid); r16_pass<false>(buf, tid * 16, 1, 0.f); HYBAR();
}
__device__ __forceinline__ void fft13_conv_core(LAS f32x2* zb, const LAS f32x2* fb, int tid) {
    OPAQUE(tid);
    r16_pass<false>(zb, (tid >> 8) * 4096 + (tid & 255), 256, (float)(tid & 255) * (1.f / 4096.f)); HYBAR();
    OPAQUE(tid); r16_pass<false>(zb, (tid >> 4) * 256 + (tid & 15), 16, (float)(tid & 15) * (1.f / 256.f)); WAVE_SEAM();
    OPAQUE(tid); r16_mid(zb, fb, tid * 16, tid * 16); WAVE_SEAM();
    OPAQUE(tid); r16_pass<true>(zb, (tid >> 4) * 256 + (tid & 15), 16, (float)(tid & 15) * (1.f / 256.f)); HYBAR();
    OPAQUE(tid); r16_pass<true>(zb, (tid >> 8) * 4096 + (tid & 255), 256, (float)(tid & 255) * (1.f / 4096.f)); HYBAR();
}
__device__ __forceinline__ void conv8(const bf16_t* __restrict__ row, int s0, int n, float w0, float w1, float w2, float bias, float (&o)[8]) {
    const bf16x8 v = *(const bf16x8*)(row + s0);
    float x[10];
    x[0] = s0 > 0 ? bf2f(row[s0 - 1]) : 0.f; x[9] = s0 + 8 < n ? bf2f(row[s0 + 8]) : 0.f;
#pragma unroll
    for (int e = 0; e < 8; ++e) x[1 + e] = bf2f((unsigned short)v[e]);
#pragma unroll
    for (int e = 0; e < 8; ++e) o[e] = bias + w0 * x[e] + w1 * x[e + 1] + w2 * x[e + 2];
}
__device__ __forceinline__ void hyena_lat_channel(LAS unsigned char* L, int c, float (&a0)[8], float (&a1)[8], const bf16_t* __restrict__ xvt,
                                                  const float* __restrict__ cw, const float* __restrict__ cb, const float* __restrict__ hyb, bf16_t* __restrict__ a2, int tid, bool last) {
    constexpr int n = 4096, N = 8192;
    OPAQUE(tid); const int lane = tid & 63, wid = tid >> 6, s0 = 8 * tid;
    LAS f32x2* Fb = (LAS f32x2*)L; LAS f32x2* Zb = (LAS f32x2*)(L + 69632); LAS float* red = (LAS float*)(L + 139264);
    {
        const float absdelta = 3.0701134573253945f + (float)c * (12.280453829301578f / 1023.f);
        float l1 = 0.f;
#pragma unroll
        for (int e = 0; e < 8; ++e) { const int t = s0 + e; const float dec = __expf(-((float)t * (1.f / (float)(n - 1))) * absdelta); a0[e] *= dec; a1[e] *= dec; l1 += fabsf(a0[e]); if (t >= 1) l1 += fabsf(a1[e]); }
        l1 = wave_sum(l1); if (lane == 0) red[wid] = l1;
        HYBAR();
        float tot = 0.f;
#pragma unroll
        for (int w = 0; w < 8; ++w) tot += red[w];
        const float scale = 1.f / (tot * (float)N);
        { const int pb = PH(s0), qb = PH(N - 8 - s0);
#pragma unroll
          for (int e = 0; e < 8; ++e) { Fb[pb + e] = (f32x2){a0[e] * scale, 0.f}; if (e >= 1) Fb[qb + 8 - e] = (f32x2){a1[e] * scale, 0.f}; }
          if (tid >= 1) Fb[PH(N - s0)] = (f32x2){a1[0] * scale, 0.f}; }
        if (tid == 0) Fb[PH(n)] = (f32x2){0.f, 0.f};
        HYBAR();
        const float w00 = cw[c], w01 = cw[3072 + c], w02 = cw[6144 + c], b0 = cb[c];
        const float w10 = cw[1024 + c], w11 = cw[3072 + 1024 + c], w12 = cw[6144 + 1024 + c], b1 = cb[1024 + c];
        const float w20 = cw[2048 + c], w21 = cw[3072 + 2048 + c], w22 = cw[6144 + 2048 + c], b2 = cb[2048 + c];
        const float hb = hyb[c];
        const int sm1 = s0 > 0 ? s0 - 1 : 0, sp8 = s0 + 8 < n ? s0 + 8 : n - 1;
        const float mlo = s0 > 0 ? 1.f : 0.f, mhi = s0 + 8 < n ? 1.f : 0.f;
#define RAWLD(V, LO, HI, rowp) do { const bf16_t* rp_ = (rowp); V = *(const bf16x8*)(rp_ + s0); LO = rp_[sm1]; HI = rp_[sp8]; } while (0)
#define RAWCONV(V, LO, HI, wA, wB, wC, bias_, out_) do { float x_[10]; x_[0] = bf2f(LO) * mlo; x_[9] = bf2f(HI) * mhi; \
        _Pragma("unroll") for (int e = 0; e < 8; ++e) x_[1 + e] = bf2f((unsigned short)V[e]); \
        _Pragma("unroll") for (int e = 0; e < 8; ++e) out_[e] = (bias_) + (wA) * x_[e] + (wB) * x_[e + 1] + (wC) * x_[e + 2]; } while (0)
        bf16x8 fa0, fb0, fa1, fb1; unsigned short fa0l, fa0h, fb0l, fb0h, fa1l, fa1h, fb1l, fb1h;
        { const bf16_t* r0 = xvt; const bf16_t* r1 = xvt + (size_t)4096 * n;
          RAWLD(fa0, fa0l, fa0h, r0 + (size_t)(2048 + c) * n); RAWLD(fb0, fb0l, fb0h, r0 + (size_t)(1024 + c) * n);
          RAWLD(fa1, fa1l, fa1h, r1 + (size_t)(2048 + c) * n); RAWLD(fb1, fb1l, fb1h, r1 + (size_t)(1024 + c) * n); }
        { const int pt = PH(tid);
#pragma unroll
          for (int k = 0; k < 8; ++k) { const float f = (float)(tid + 512 * k) * (1.f / 8192.f); const float cc_ = __builtin_amdgcn_cosf(f), ss_ = __builtin_amdgcn_sinf(f);
            const int i0 = pt + 544 * k, i1 = i0 + 4352;
            const f32x2 u = Fb[i0], v = Fb[i1], d = u - v; Fb[i0] = u + v; Fb[i1] = (f32x2){d.x * cc_ + d.y * ss_, d.y * cc_ - d.x * ss_}; } }
        HYBAR();
        fft13_fwd_tail(Fb, tid);
#pragma unroll 1
        for (int pair = 0; pair < 2; ++pair) {
            const bf16_t* r0 = xvt + ((size_t)(2 * pair) * 4096) * n; const bf16_t* r1 = xvt + ((size_t)(2 * pair + 1) * 4096) * n;
            float g0[8], g1[8];
            { float tmp[8];
              RAWCONV(fa0, fa0l, fa0h, w20, w21, w22, b2, g0); RAWCONV(fb0, fb0l, fb0h, w10, w11, w12, b1, tmp);
#pragma unroll
              for (int e = 0; e < 8; ++e) g0[e] *= tmp[e];
              RAWCONV(fa1, fa1l, fa1h, w20, w21, w22, b2, g1); RAWCONV(fb1, fb1l, fb1h, w10, w11, w12, b1, tmp);
#pragma unroll
              for (int e = 0; e < 8; ++e) g1[e] *= tmp[e]; }
#pragma unroll
            for (int e = 0; e < 8; ++e) { const int s = s0 + e; const float f = (float)s * (1.f / 8192.f); const float cc_ = __builtin_amdgcn_cosf(f), ss_ = __builtin_amdgcn_sinf(f); const int pb = PH(s0);
                Zb[pb + e] = (f32x2){g0[e], g1[e]}; Zb[pb + 4352 + e] = (f32x2){g0[e] * cc_ + g1[e] * ss_, g1[e] * cc_ - g0[e] * ss_}; }
            HYBAR();
            bf16x8 xr0, xr1; unsigned short xl0, xh0, xl1, xh1;
            RAWLD(xr0, xl0, xh0, r0 + (size_t)c * n); RAWLD(xr1, xl1, xh1, r1 + (size_t)c * n);
            const bf16x8 gh0 = *(const bf16x8*)(r0 + (size_t)(3072 + c) * n + s0), gh1 = *(const bf16x8*)(r1 + (size_t)(3072 + c) * n + s0);
            pg8::u32x4 qa0 = {}, qa1 = {}, qa2 = {}, qb0 = {}, qb1 = {}, qb2 = {};
            if (last) { const bf16_t* pa = r0 + (size_t)(1024 + c) * n + s0; const bf16_t* pb_ = r1 + (size_t)(1024 + c) * n + s0;
                qa0 = *(const pg8::u32x4*)(pa - 3 * (size_t)n); qa1 = *(const pg8::u32x4*)(pa - 2 * (size_t)n); qa2 = *(const pg8::u32x4*)(pa - (size_t)n);
                qb0 = *(const pg8::u32x4*)(pb_ - 3 * (size_t)n); qb1 = *(const pg8::u32x4*)(pb_ - 2 * (size_t)n); qb2 = *(const pg8::u32x4*)(pb_ - (size_t)n); }
            fft13_conv_core(Zb, Fb, tid);
            float oa[8], ob[8];
            { float x0a[8], x0b[8];
              RAWCONV(xr0, xl0, xh0, w00, w01, w02, b0, x0a); RAWCONV(xr1, xl1, xh1, w00, w01, w02, b0, x0b);
#pragma unroll
              for (int e = 0; e < 8; ++e) { const int t = s0 + e; const float f = (float)t * (1.f / 8192.f); const float cc_ = __builtin_amdgcn_cosf(f), ss_ = __builtin_amdgcn_sinf(f);
                  const int pb = PH(s0); const f32x2 u = Zb[pb + e], v = Zb[pb + 4352 + e];
                  const float ya = u.x + (v.x * cc_ - v.y * ss_), yb = u.y + (v.x * ss_ + v.y * cc_);
                  oa[e] = x0a[e] * (ya + g0[e] * hb) * silu_f(bf2f((unsigned short)gh0[e])); ob[e] = x0b[e] * (yb + g1[e] * hb) * silu_f(bf2f((unsigned short)gh1[e])); } }
            { const bf16_t* n0 = xvt + ((size_t)(2 * (pair ^ 1)) * 4096) * n; const bf16_t* n1 = n0 + (size_t)4096 * n;
              RAWLD(fa0, fa0l, fa0h, n0 + (size_t)(2048 + c) * n); RAWLD(fb0, fb0l, fb0h, n0 + (size_t)(1024 + c) * n);
              RAWLD(fa1, fa1l, fa1h, n1 + (size_t)(2048 + c) * n); RAWLD(fb1, fb1l, fb1h, n1 + (size_t)(1024 + c) * n); }
            { int s0 = 8 * tid; OPAQUE(s0);
              bf16_t* ppa = (bf16_t*)r0 + (size_t)(1024 + c) * n + s0; bf16_t* ppb = (bf16_t*)r1 + (size_t)(1024 + c) * n + s0;
              if (!last) { *(pg8::u32x4*)ppa = (pg8::u32x4){pk2(oa[0], oa[1]), pk2(oa[2], oa[3]), pk2(oa[4], oa[5]), pk2(oa[6], oa[7])};
                           *(pg8::u32x4*)ppb = (pg8::u32x4){pk2(ob[0], ob[1]), pk2(ob[2], ob[3]), pk2(ob[4], ob[5]), pk2(ob[6], ob[7])}; }
              else {
                  const unsigned QA0[4] = {qa0.x, qa0.y, qa0.z, qa0.w}, QA1[4] = {qa1.x, qa1.y, qa1.z, qa1.w}, QA2[4] = {qa2.x, qa2.y, qa2.z, qa2.w};
                  const unsigned QB0[4] = {qb0.x, qb0.y, qb0.z, qb0.w}, QB1[4] = {qb1.x, qb1.y, qb1.z, qb1.w}, QB2[4] = {qb2.x, qb2.y, qb2.z, qb2.w};
#pragma unroll
                  for (int e = 0; e < 8; ++e) { const int t = s0 + e; const int sh = (e & 1) * 16;
                      const unsigned lo = ((QA0[e >> 1] >> sh) & 0xffffu) | (((QA1[e >> 1] >> sh) & 0xffffu) << 16), hi = ((QA2[e >> 1] >> sh) & 0xffffu) | ((unsigned)f2bf(oa[e]) << 16);
                      *(u32x2*)(a2 + ((size_t)(2 * pair) * n + t) * 2048 + c - 3) = (u32x2){lo, hi}; }
#pragma unroll
                  for (int e = 0; e < 8; ++e) { const int t = s0 + e; const int sh = (e & 1) * 16;
                      const unsigned lo = ((QB0[e >> 1] >> sh) & 0xffffu) | (((QB1[e >> 1] >> sh) & 0xffffu) << 16), hi = ((QB2[e >> 1] >> sh) & 0xffffu) | ((unsigned)f2bf(ob[e]) << 16);
                      *(u32x2*)(a2 + ((size_t)(2 * pair + 1) * n + t) * 2048 + c - 3) = (u32x2){lo, hi}; } } }
            HYBAR();
        }
#undef RAWLD
#undef RAWCONV
    }
}
__device__ __forceinline__ void hyena_lat4(LAS unsigned char* L, int c0, const bf16_t* __restrict__ xvt, const bf16_t* __restrict__ hdnt, const float* __restrict__ w3,
                                           const float* __restrict__ cw, const float* __restrict__ cb, const float* __restrict__ hyb, bf16_t* __restrict__ a2, int tid, float* __restrict__ park) {
    LAS float* w3s = (LAS float*)(L + 139264) + 16;
    { const int ci_ = tid >> 7, r_ = tid & 127; w3s[ci_ * 128 + (r_ & 63) * 2 + (r_ >> 6)] = w3[(r_ & 63) * 2048 + (r_ >> 6) * 1024 + c0 + ci_]; }
    HYBAR();
#pragma unroll 1
    for (int cp = 0; cp < 2; ++cp) {
        OPAQUE(tid); const int s0 = 8 * tid;
        float a0[8], a1[8]; f32x2 ta[8], tb[8];
#pragma unroll
        for (int e = 0; e < 8; ++e) { ta[e] = (f32x2){0.f, 0.f}; tb[e] = (f32x2){0.f, 0.f}; }
#pragma unroll 8
        for (int j = 0; j < 64; ++j) { const pg8::u32x4 hw = *(const pg8::u32x4*)(hdnt + (size_t)j * 4352 + s0);
            const float hh[8] = {__uint_as_float(hw.x << 16), __uint_as_float(hw.x & 0xffff0000u), __uint_as_float(hw.y << 16), __uint_as_float(hw.y & 0xffff0000u),
                                 __uint_as_float(hw.z << 16), __uint_as_float(hw.z & 0xffff0000u), __uint_as_float(hw.w << 16), __uint_as_float(hw.w & 0xffff0000u)};
            const f32x2 wa = *(const LAS f32x2*)(w3s + (2 * cp) * 128 + 2 * j), wb = *(const LAS f32x2*)(w3s + (2 * cp + 1) * 128 + 2 * j);
#pragma unroll
            for (int e = 0; e < 8; ++e) { ta[e] = ta[e] + wa * hh[e]; tb[e] = tb[e] + wb * hh[e]; } }
#pragma unroll
        for (int e = 0; e < 8; ++e) { park[e * 512 + tid] = tb[e].x; park[(8 + e) * 512 + tid] = tb[e].y; a0[e] = ta[e].x; a1[e] = ta[e].y; }
        hyena_lat_channel(L, c0 + 2 * cp, a0, a1, xvt, cw, cb, hyb, a2, tid, false);
        OPAQUE(tid);
#pragma unroll
        for (int e = 0; e < 8; ++e) { a0[e] = park[e * 512 + tid]; a1[e] = park[(8 + e) * 512 + tid]; }
        hyena_lat_channel(L, c0 + 2 * cp + 1, a0, a1, xvt, cw, cb, hyb, a2, tid, cp == 1);
    }
}
__device__ __forceinline__ void hyena_ctx4(LAS unsigned char* L, int c0, const bf16_t* __restrict__ xvt, const bf16_t* __restrict__ hdnt, const float* __restrict__ w3,
                                           const float* __restrict__ cw, const float* __restrict__ cb, const float* __restrict__ hyb, bf16_t* __restrict__ a2, int tid) {
    constexpr int n = 256, N = 512;
    OPAQUE(tid);
    const int lane = tid & 63, wid = tid >> 6;
    LAS f32x2* Fb = (LAS f32x2*)L; LAS f32x2* Zb = (LAS f32x2*)(L + 69632); LAS float* red = (LAS float*)(L + 139264);
    { const int fc = tid >> 7, c = c0 + fc, t0 = 2 * (tid & 127);
      float a0[2] = {0.f, 0.f}, a1[2] = {0.f, 0.f};
#pragma unroll 16
      for (int j = 0; j < 64; ++j) { const unsigned hw_ = *(const unsigned*)(hdnt + (size_t)j * 4352 + t0); const f32x2 hv = (f32x2){__uint_as_float(hw_ << 16), __uint_as_float(hw_ & 0xffff0000u)}; const float wf = w3[j * 2048 + c], wb = w3[j * 2048 + 1024 + c];
          a0[0] += hv.x * wf; a0[1] += hv.y * wf; a1[0] += hv.x * wb; a1[1] += hv.y * wb; }
      const float absdelta = 3.0701134573253945f + (float)c * (12.280453829301578f / 1023.f);
      float l1 = 0.f;
#pragma unroll
      for (int e = 0; e < 2; ++e) { const int t = t0 + e; const float dec = __expf(-((float)t * (1.f / (float)(n - 1))) * absdelta); a0[e] *= dec; a1[e] *= dec; l1 += fabsf(a0[e]); if (t >= 1) l1 += fabsf(a1[e]); }
      l1 = wave_sum(l1); if (lane == 0) red[wid] = l1;
      HYBAR();
      const float scale = 1.f / ((red[2 * fc] + red[2 * fc + 1]) * (float)N);
#pragma unroll
      for (int e = 0; e < 2; ++e) { const int t = t0 + e; Fb[PH(fc * 512 + t)] = (f32x2){a0[e] * scale, 0.f}; if (t >= 1) Fb[PH(fc * 512 + N - t)] = (f32x2){a1[e] * scale, 0.f}; }
      if ((tid & 127) == 0) Fb[PH(fc * 512 + n)] = (f32x2){0.f, 0.f};
      HYBAR();
#pragma unroll
      for (int i = 0; i < 2; ++i) { const int q = tid + 512 * i, sl = q >> 8, p = q & 255; const float f = (float)p * (1.f / 512.f); const float cc_ = __builtin_amdgcn_cosf(f), ss_ = __builtin_amdgcn_sinf(f);
          const int i0 = PH(sl * 512 + p), i1 = i0 + 272; const f32x2 u = Fb[i0], v = Fb[i1], d = u - v; Fb[i0] = u + v; Fb[i1] = (f32x2){d.x * cc_ + d.y * ss_, d.y * cc_ - d.x * ss_}; }
      HYBAR();
      OPAQUE(tid); r16_pass<false>(Fb, (tid >> 4) * 256 + (tid & 15), 16, (float)(tid & 15) * (1.f / 256.f)); HYBAR();
      OPAQUE(tid); r16_pass<false>(Fb, tid * 16, 1, 0.f); HYBAR(); }
    const int ch = wid >> 1, pair = wid & 1, c = c0 + ch, s0 = 4 * lane;
    const float w00 = cw[c], w01 = cw[3072 + c], w02 = cw[6144 + c], b0 = cb[c];
    const float w10 = cw[1024 + c], w11 = cw[3072 + 1024 + c], w12 = cw[6144 + 1024 + c], b1 = cb[1024 + c];
    const float w20 = cw[2048 + c], w21 = cw[3072 + 2048 + c], w22 = cw[6144 + 2048 + c], b2 = cb[2048 + c];
    const float hb = hyb[c];
    const bf16_t* r0 = xvt + ((size_t)(2 * pair) * 4096) * n; const bf16_t* r1 = xvt + ((size_t)(2 * pair + 1) * 4096) * n;
    float g0[4], g1[4];
#define CONV4(row_, wA, wB, wC, bias_, out_) do { const bf16_t* rp_ = (row_); const u32x2 v_ = *(const u32x2*)(rp_ + s0); float x_[6]; \
        x_[0] = bf2f(rp_[s0 > 0 ? s0 - 1 : 0]) * (s0 > 0 ? 1.f : 0.f); x_[5] = bf2f(rp_[s0 + 4 < n ? s0 + 4 : n - 1]) * (s0 + 4 < n ? 1.f : 0.f);        \
        x_[1] = bf2f((unsigned short)(v_.x & 0xffffu)); x_[2] = bf2f((unsigned short)(v_.x >> 16)); x_[3] = bf2f((unsigned short)(v_.y & 0xffffu)); x_[4] = bf2f((unsigned short)(v_.y >> 16)); \
        _Pragma("unroll") for (int e = 0; e < 4; ++e) out_[e] = (bias_) + (wA) * x_[e] + (wB) * x_[e + 1] + (wC) * x_[e + 2]; } while (0)
    { float tmp[4];
      CONV4(r0 + (size_t)(2048 + c) * n, w20, w21, w22, b2, g0); CONV4(r0 + (size_t)(1024 + c) * n, w10, w11, w12, b1, tmp);
#pragma unroll
      for (int e = 0; e < 4; ++e) g0[e] *= tmp[e];
      CONV4(r1 + (size_t)(2048 + c) * n, w20, w21, w22, b2, g1); CONV4(r1 + (size_t)(1024 + c) * n, w10, w11, w12, b1, tmp);
#pragma unroll
      for (int e = 0; e < 4; ++e) g1[e] *= tmp[e]; }
#pragma unroll
    for (int e = 0; e < 4; ++e) { const int s = s0 + e; const float f = (float)s * (1.f / 512.f); const float cc_ = __builtin_amdgcn_cosf(f), ss_ = __builtin_amdgcn_sinf(f);
        const int pb = PH(wid * 512 + s0); Zb[pb + e] = (f32x2){g0[e], g1[e]}; Zb[pb + 272 + e] = (f32x2){g0[e] * cc_ + g1[e] * ss_, g1[e] * cc_ - g0[e] * ss_}; }
    HYBAR();
    OPAQUE(tid); r16_pass<false>(Zb, (tid >> 4) * 256 + (tid & 15), 16, (float)(tid & 15) * (1.f / 256.f)); WAVE_SEAM();
    OPAQUE(tid); r16_mid(Zb, Fb, tid * 16, (tid >> 6) * 512 + ((tid * 16) & 511)); WAVE_SEAM();
    OPAQUE(tid); r16_pass<true>(Zb, (tid >> 4) * 256 + (tid & 15), 16, (float)(tid & 15) * (1.f / 256.f)); HYBAR();
    { float x0a[4], x0b[4];
      CONV4(r0 + (size_t)c * n, w00, w01, w02, b0, x0a); CONV4(r1 + (size_t)c * n, w00, w01, w02, b0, x0b);
      const u32x2 gha = *(const u32x2*)(r0 + (size_t)(3072 + c) * n + s0), ghb = *(const u32x2*)(r1 + (size_t)(3072 + c) * n + s0);
#pragma unroll
      for (int e = 0; e < 4; ++e) { const int t = s0 + e; const float f = (float)t * (1.f / 512.f); const float cc_ = __builtin_amdgcn_cosf(f), ss_ = __builtin_amdgcn_sinf(f);
          const int pb = PH(wid * 512 + s0); const f32x2 u = Zb[pb + e], v = Zb[pb + 272 + e];
          const float ya = u.x + (v.x * cc_ - v.y * ss_), yb = u.y + (v.x * ss_ + v.y * cc_);
          const unsigned ga_ = e < 2 ? gha.x : gha.y, gb_ = e < 2 ? ghb.x : ghb.y; const float gva = bf2f((unsigned short)((e & 1) ? (ga_ >> 16) : (ga_ & 0xffffu))), gvb = bf2f((unsigned short)((e & 1) ? (gb_ >> 16) : (gb_ & 0xffffu)));
          const float oa = x0a[e] * (ya + g0[e] * hb) * silu_f(gva), ob = x0b[e] * (yb + g1[e] * hb) * silu_f(gvb);
          a2[((size_t)(2 * pair) * n + t) * 2048 + c] = f2bf(oa); a2[((size_t)(2 * pair + 1) * n + t) * 2048 + c] = f2bf(ob); } }
#undef CONV4
    HYBAR();
}
namespace ml2 {
typedef short v4i16 __attribute__((ext_vector_type(4)));
constexpr int RAWS = 264, QS = 136, KTS = 72, VS = 264, SS = 72;
constexpr int OFF_RAW = 0, OFF_V = 34848, OFF_KTA = 68640, OFF_X = 87072, OFF_Q = 87072, OFF_K = 104480, OFF_KTB = 87072, OFF_S = 121888, OFF_G = 131104;
constexpr int G_DEN = 0, G_INV = 64, G_NQ = 128, G_BB = 192, G_CS = 256, G_EB = 320, G_AA = 384, G_NV = 448, G_NV2 = 576, G_SEGA = 704, G_SCAN = 1728, G_MISC = 1744;
constexpr size_t EST_SLOT = 16384;

__device__ __forceinline__ float logsig(float x) { return fminf(x, 0.f) - log1pf(__expf(-fabsf(x))); }
__device__ __forceinline__ unsigned pkbf(float lo, float hi) { return pg8::cvtpk_hw(lo, hi); }
template <int CTRL> __device__ __forceinline__ float dpp_add(float v) { return v + __builtin_bit_cast(float, __builtin_amdgcn_update_dpp(0, __builtin_bit_cast(int, v), CTRL, 0xF, 0xF, true)); }
__device__ __forceinline__ float sum8(float v) { v = dpp_add<0xB1>(v); v = dpp_add<0x4E>(v); return dpp_add<0x141>(v); }
__device__ __forceinline__ float sum16(float v) { return dpp_add<0x140>(sum8(v)); }
template <int CTRL, int ROWMASK> __device__ __forceinline__ float dpp_add_rm(float v) { return v + __builtin_bit_cast(float, __builtin_amdgcn_update_dpp(0, __builtin_bit_cast(int, v), CTRL, ROWMASK, 0xF, ROWMASK == 0xF)); }
__device__ __forceinline__ float wave_scan_incl(float v) {
    v = dpp_add_rm<0x111, 0xF>(v); v = dpp_add_rm<0x112, 0xF>(v); v = dpp_add_rm<0x114, 0xF>(v); v = dpp_add_rm<0x118, 0xF>(v);
    v = dpp_add_rm<0x142, 0xA>(v); v = dpp_add_rm<0x143, 0xC>(v);
    return v;
}
__device__ __forceinline__ bf16x8 vfrag(LAS unsigned char* vs, int srow, int vcol0, int lane) {
    const int g = lane >> 4, i = lane & 15, q = i >> 2, p = i & 3;
    LAS v4i16* a0 = (LAS v4i16*)(vs + ((srow + 8 * g + q) * VS + vcol0 + 4 * p) * 2);
    LAS v4i16* a1 = (LAS v4i16*)(vs + ((srow + 8 * g + 4 + q) * VS + vcol0 + 4 * p) * 2);
    const v4i16 lo = __builtin_amdgcn_ds_read_tr16_b64_v4i16(a0), hi = __builtin_amdgcn_ds_read_tr16_b64_v4i16(a1);
    return (bf16x8){lo[0], lo[1], lo[2], lo[3], hi[0], hi[1], hi[2], hi[3]};
}
__device__ __forceinline__ float block_scan(float x, LAS float* scan, int tid, float* tot) {
    const int lane = tid & 63, wid = tid >> 6; const float v = wave_scan_incl(x);
    if (lane == 63) scan[wid] = v;
    __syncthreads();
    float pre = 0.f, all = 0.f;
#pragma unroll
    for (int w = 0; w < 8; ++w) { const float s = scan[w]; if (w < wid) pre += s; all += s; }
    __syncthreads();
    *tot = all; return v + pre;
}
constexpr int OFF_TAPS = 138240;
__device__ __forceinline__ void stage_taps(LAS unsigned char* L, const float* __restrict__ cw, const float* __restrict__ cb, int h, int tid) {
    LAS float* tp = (LAS float*)(L + OFF_TAPS);
    if (tid < 256) { const int col = tid < 128 ? h * 128 + tid : 1024 + h * 128 + (tid - 128); tp[tid] = cw[col]; tp[256 + tid] = cw[2048 + col]; tp[512 + tid] = cw[4096 + col]; tp[768 + tid] = cb[col]; }
}
__device__ __forceinline__ void conv_row8(LAS unsigned char* L, int r, int cbyte, int tcol, float scale, float (&o)[8]) {
    LAS unsigned char* raw = L + OFF_RAW; const LAS float* tp = (const LAS float*)(L + OFF_TAPS) + tcol;
    const bf16x8 xm = *(const LAS bf16x8*)(raw + r * (RAWS * 2) + cbyte), x0 = *(const LAS bf16x8*)(raw + (r + 1) * (RAWS * 2) + cbyte), xp = *(const LAS bf16x8*)(raw + (r + 2) * (RAWS * 2) + cbyte);
#pragma unroll
    for (int e = 0; e < 8; ++e) { const float a = tp[768 + e] + tp[e] * bf2f((unsigned short)xm[e]) + tp[256 + e] * bf2f((unsigned short)x0[e]) + tp[512 + e] * bf2f((unsigned short)xp[e]);
        o[e] = silu_f(a) * scale; }
}

__device__ __forceinline__ void passA(LAS unsigned char* L, const bf16_t* __restrict__ Y1A, const float* __restrict__ GATES, const float* __restrict__ cw, const float* __restrict__ cb,
                                      unsigned* __restrict__ EST, float* __restrict__ NST, float* __restrict__ PST, unsigned* __restrict__ CTXE, float* __restrict__ CTXN, int bid, int G) {
    int tid = threadIdx.x; asm volatile("" : "+v"(tid));
    const int lane0 = tid & 63, wid = __builtin_amdgcn_readfirstlane(tid >> 6);
    LAS float* gl = (LAS float*)(L + OFF_G);
    LAS unsigned short* kta = (LAS unsigned short*)(L + OFF_KTA); LAS unsigned short* ktb = (LAS unsigned short*)(L + OFF_KTB);
    for (int item = bid; item < 256; item += G) {
        const int b = item >> 6, h = (item >> 3) & 7, g = item & 7;
        stage_taps(L, cw, cb, h, tid);
        const int njobs = 2;
        for (int job = 0; job < njobs; ++job) {
            const bool ctxjob = job == 1; const int ntok = ctxjob ? CTXL : 512, nseq = ctxjob ? CTXL : SEQ, tseg = ctxjob ? 0 : g * 512;
            const size_t rowbase = ctxjob ? (size_t)MLAT + b * CTXL : (size_t)b * SEQ;
            const bool en_f = !ctxjob || g < 4, en_b = !ctxjob || g >= 4; const int cj = g & 3;
            float lff = 0.f, lfb = 0.f, ipf = 0.f, ipb = 0.f;
            if (tid < ntok) { const float* gp = GATES + (rowbase + tseg + tid) * 32 + h; ipf = gp[0]; lff = logsig(gp[8]); ipb = gp[16]; lfb = logsig(gp[24]); }
            float totf, totb; const float Bf = block_scan(lff, gl + G_SCAN, tid, &totf); const float Bbi = block_scan(lfb, gl + G_SCAN, tid, &totb);
            const float Bb = totb - (Bbi - lfb);
            if (tid < ntok) { gl[G_SEGA + tid] = en_f ? __expf(totf - Bf + ipf) : 0.f; gl[G_SEGA + 512 + tid] = en_b ? __expf(totb - Bb + ipb) : 0.f; }
            if (tid < 256) gl[G_NV + tid] = 0.f;
            const int nch = ntok / 64, bh = b * 8 + h; const int c0 = ctxjob ? cj : 0, c1 = ctxjob ? cj + 1 : nch;
#pragma unroll 1
            for (int dir = 0; dir < 2; ++dir) {
                if (!(dir == 0 ? en_f : en_b)) continue;
                f32x4 acc[8][2];
#pragma unroll
                for (int dt = 0; dt < 8; ++dt)
#pragma unroll
                    for (int nt = 0; nt < 2; ++nt) acc[dt][nt] = (f32x4){0.f, 0.f, 0.f, 0.f};
                bf16x8 rk[3], rv[4];
#define A_ISSUE(ci_) do { const int t0_ = tseg + (ci_) * 64; \
                    _Pragma("unroll") for (int i = 0; i < 3; ++i) { const int c = tid + 512 * i; const int rr = c >> 4, cc8 = (c & 15) * 8; int tt = t0_ - 1 + rr; \
                        const bool ok = (tt >= 0) && (tt < nseq) && (c < 1056); tt = tt < 0 ? 0 : (tt > nseq - 1 ? nseq - 1 : tt); \
                        rk[i] = *(const bf16x8*)(Y1A + (rowbase + tt) * 4096 + 1024 + h * 128 + cc8); }   \
                    _Pragma("unroll") for (int i = 0; i < 4; ++i) { const int c = tid + 512 * i; const int rr = c >> 5, cc8 = (c & 31) * 8; \
                        rv[i] = *(const bf16x8*)(Y1A + (rowbase + t0_ + rr) * 4096 + 2048 + h * 256 + cc8); } } while (0)
                A_ISSUE(c0);
#pragma unroll 1
                for (int ci = c0; ci < c1; ++ci) {
                    int lane = lane0; asm volatile("" : "+v"(lane)); const int fr = lane & 15, fq = lane >> 4;
#pragma unroll
                    for (int i = 0; i < 3; ++i) { const int c = tid + 512 * i; const int tt = tseg + ci * 64 - 1 + (c >> 4); const bool ok = (tt >= 0) && (tt < nseq);
                        if (c < 1056) *(LAS bf16x8*)(L + OFF_RAW + (c >> 4) * (RAWS * 2) + (c & 15) * 16) = ok ? rk[i] : (bf16x8){0, 0, 0, 0, 0, 0, 0, 0}; }
#pragma unroll
                    for (int i = 0; i < 4; ++i) { const int c = tid + 512 * i; *(LAS bf16x8*)(L + OFF_V + (c >> 5) * (VS * 2) + (c & 31) * 16) = rv[i]; }
                    __syncthreads();
                    if (ci + 1 < c1) A_ISSUE(ci + 1);
#pragma unroll
                    for (int i = 0; i < 2; ++i) { const int r = tid & 63, d0 = (wid + 8 * i) * 8; float kv[8]; conv_row8(L, r, d0 * 2, 128 + d0, 0.08838834764831845f, kv);
                        const float aw = gl[G_SEGA + dir * 512 + ci * 64 + r];
#pragma unroll
                        for (int e = 0; e < 8; ++e) kta[(d0 + e) * KTS + r] = pg8::f2bf_rne(kv[e] * aw); }
                    __syncthreads();
#pragma unroll
                    for (int kk = 0; kk < 2; ++kk) { bf16x8 bv[2];
#pragma unroll
                        for (int nt = 0; nt < 2; ++nt) bv[nt] = vfrag(L + OFF_V, kk * 32, wid * 32 + nt * 16, lane);
#pragma unroll
                        for (int dt = 0; dt < 8; ++dt) { const bf16x8 af = *(const LAS bf16x8*)(L + OFF_KTA + ((dt * 16 + fr) * KTS + kk * 32 + fq * 8) * 2);
#pragma unroll
                            for (int nt = 0; nt < 2; ++nt) acc[dt][nt] = __builtin_amdgcn_mfma_f32_16x16x32_bf16(af, bv[nt], acc[dt][nt], 0, 0, 0); } }
                    if (tid < 128) { const LAS unsigned short* rowp = kta + tid * KTS; float s = 0.f;
#pragma unroll
                        for (int q = 0; q < 8; ++q) { const bf16x8 x = *(const LAS bf16x8*)(rowp + q * 8);
#pragma unroll
                            for (int e = 0; e < 8; ++e) s += bf2f((unsigned short)x[e]); }
                        gl[G_NV + dir * 128 + tid] += s; }
                    __syncthreads();
                }
#undef A_ISSUE
                const bool own_unused = !ctxjob && (dir == 0 ? g == 7 : g == 0);
                if (!own_unused) { const int slot = ctxjob ? (bh * 2 + dir) * 4 + cj : (bh * 8 + g) * 2 + dir; unsigned* ep = (ctxjob ? CTXE : EST) + (size_t)slot * EST_SLOT + tid;
#pragma unroll
                    for (int dt = 0; dt < 8; ++dt)
#pragma unroll
                        for (int nt = 0; nt < 2; ++nt) { ep[((dt * 2 + nt) * 2 + 0) * 512] = pkbf(acc[dt][nt][0], acc[dt][nt][1]); ep[((dt * 2 + nt) * 2 + 1) * 512] = pkbf(acc[dt][nt][2], acc[dt][nt][3]); }
                    if (tid < 128) (ctxjob ? CTXN : NST)[slot * 128 + tid] = gl[G_NV + dir * 128 + tid]; if (tid == 0 && !ctxjob) PST[slot] = __expf(dir == 0 ? totf : totb); }
            }
            __syncthreads();
        }
    }
}

#if defined(PROBE_A)
#define ML_STAMP(i) do { if (blockIdx.x == 0) ((unsigned long long*)PROBE_STAMPS)[i] = __builtin_amdgcn_s_memrealtime(); } while (0)
#else
#define ML_STAMP(i) do { } while (0)
#endif
__device__ __forceinline__ void passB(LAS unsigned char* L, const bf16_t* __restrict__ Y1A, const float* __restrict__ GATES, const float* __restrict__ cw, const float* __restrict__ cb,
                                      const unsigned* __restrict__ EST, const float* __restrict__ NST, const float* __restrict__ PST, bf16_t* __restrict__ H, int bid, int G, unsigned char* PROBE_STAMPS) {
    int tid = threadIdx.x; asm volatile("" : "+v"(tid));
    const int lane0 = tid & 63, wid = __builtin_amdgcn_readfirstlane(tid >> 6);
    LAS float* gl = (LAS float*)(L + OFF_G);
    LAS unsigned short* q_s = (LAS unsigned short*)(L + OFF_Q); LAS unsigned short* k_s = (LAS unsigned short*)(L + OFF_K);
    LAS unsigned short* kta = (LAS unsigned short*)(L + OFF_KTA); LAS unsigned short* S_s = (LAS unsigned short*)(L + OFF_S);
    for (int item = bid; item < 256; item += G) {
        const int b = item >> 6, h = (item >> 3) & 7, g = item & 7, bh = b * 8 + h;
        stage_taps(L, cw, cb, h, tid);
        const size_t rowbase = (size_t)b * SEQ;
#pragma unroll 1
        for (int dir = 0; dir < 2; ++dir) {
            f32x4 C[8][2];
            { const int sg = dir == 0 ? (g == 0 ? 7 : g - 1) : (g == 7 ? 0 : g + 1);
              const int slot = (bh * 8 + sg) * 2 + dir; const unsigned* ep = EST + (size_t)slot * EST_SLOT + tid;
#pragma unroll
              for (int dt = 0; dt < 8; ++dt)
#pragma unroll
                for (int nt = 0; nt < 2; ++nt) { const unsigned w0 = ep[((dt * 2 + nt) * 2 + 0) * 512], w1 = ep[((dt * 2 + nt) * 2 + 1) * 512];
                    C[dt][nt] = (f32x4){bf2f((unsigned short)(w0 & 0xffffu)), bf2f((unsigned short)(w0 >> 16)), bf2f((unsigned short)(w1 & 0xffffu)), bf2f((unsigned short)(w1 >> 16))}; }
              if (tid < 128) gl[G_NV + tid] = NST[slot * 128 + tid]; }
            ML_STAMP(30 + 2 * dir);
            bf16x8 rq[5]; float rg0 = 0.f, rg1 = 0.f;
#define B_ISSUE(ci_) do { const int t0_ = g * 512 + (ci_) * 64; \
                _Pragma("unroll") for (int i = 0; i < 5; ++i) { const int c = tid + 512 * i; const int rr = c >> 5, c5 = c & 31; int tt = t0_ - 1 + rr; \
                    const bool ok = (tt >= 0) && (tt < SEQ) && (c < 2112); tt = tt < 0 ? 0 : (tt > SEQ - 1 ? SEQ - 1 : tt); \
                    const int col = c5 < 16 ? h * 128 + c5 * 8 : 1024 + h * 128 + (c5 - 16) * 8; \
                    rq[i] = *(const bf16x8*)(Y1A + (rowbase + tt) * 4096 + col); } \
                { const float* gp = GATES + (rowbase + t0_ + (tid & 63)) * 32 + dir * 16 + h; rg0 = gp[0]; rg1 = gp[8]; } } while (0)
            B_ISSUE(dir == 0 ? 0 : 7);
            bf16x8 rv[4];
#define V_ISSUE(ci_) do { const int tv_ = g * 512 + (ci_) * 64; _Pragma("unroll") for (int i = 0; i < 4; ++i) { const int c = tid + 512 * i; \
                rv[i] = *(const bf16x8*)(Y1A + (rowbase + tv_ + (c >> 5)) * 4096 + 2048 + h * 256 + (c & 31) * 8); } } while (0)
#pragma unroll 1
            for (int st = 0; st < 8; ++st) {
                const int ci = dir == 0 ? st : 7 - st; const int t0 = g * 512 + ci * 64;
                ML_STAMP(40);
                V_ISSUE(ci);
                int lane = lane0; asm volatile("" : "+v"(lane)); const int fr = lane & 15, fq = lane >> 4;
#pragma unroll
                for (int i = 0; i < 5; ++i) { const int c = tid + 512 * i; const int tt = t0 - 1 + (c >> 5); const bool ok = (tt >= 0) && (tt < SEQ);
                    if (c < 2112) *(LAS bf16x8*)(L + OFF_RAW + (c >> 5) * (RAWS * 2) + (c & 31) * 16) = ok ? rq[i] : (bf16x8){0, 0, 0, 0, 0, 0, 0, 0}; }
                if (wid == 0) { const float ip = rg0, lf = logsig(rg1); const float v = wave_scan_incl(lf);
                    const float tot = __builtin_bit_cast(float, __builtin_amdgcn_readlane(__builtin_bit_cast(int, v), 63)); const float bb = dir == 0 ? v : tot - (v - lf);
                    gl[G_BB + lane] = bb; gl[G_CS + lane] = bb - ip; gl[G_EB + lane] = __expf(bb); gl[G_AA + lane] = __expf(tot - bb + ip); gl[G_DEN + lane] = 0.f;
                    if (lane == 0) gl[G_MISC] = __expf(tot); }
                __syncthreads(); ML_STAMP(41);
                if (st + 1 < 8) B_ISSUE(dir == 0 ? st + 1 : 6 - st);
#pragma unroll
                for (int i = 0; i < 4; ++i) { const int r = tid & 63, cgi = wid + 8 * i; float o[8]; conv_row8(L, r, cgi * 16, cgi * 8, cgi < 16 ? 1.f : 0.08838834764831845f, o);
                    pg8::u32x4 w; w.x = pkbf(o[0], o[1]); w.y = pkbf(o[2], o[3]); w.z = pkbf(o[4], o[5]); w.w = pkbf(o[6], o[7]);
                    if (cgi < 16) *(LAS pg8::u32x4*)(q_s + r * QS + cgi * 8) = w;
                    else { *(LAS pg8::u32x4*)(k_s + r * QS + (cgi - 16) * 8) = w; const float a = gl[G_AA + r]; const int d0 = (cgi - 16) * 8;
#pragma unroll
                        for (int e = 0; e < 8; ++e) kta[(d0 + e) * KTS + r] = pg8::f2bf_rne(o[e] * a); } }
#pragma unroll
                for (int i = 0; i < 4; ++i) { const int c = tid + 512 * i; *(LAS bf16x8*)(L + OFF_V + (c >> 5) * (VS * 2) + (c & 31) * 16) = rv[i]; }
                __syncthreads(); ML_STAMP(42);
                { const int mt = wid >> 1;
#pragma unroll
                  for (int q2 = 0; q2 < 2; ++q2) { const int nt = (wid & 1) * 2 + q2; f32x4 acc = (f32x4){0.f, 0.f, 0.f, 0.f};
                    const bool need = dir == 0 ? (nt <= mt) : (nt >= mt);
                    if (need) {
#pragma unroll
                      for (int kk = 0; kk < 4; ++kk) { const bf16x8 af = *(const LAS bf16x8*)(L + OFF_Q + ((mt * 16 + fr) * QS + kk * 32 + fq * 8) * 2);
                        const bf16x8 bfr = *(const LAS bf16x8*)(L + OFF_K + ((nt * 16 + fr) * QS + kk * 32 + fq * 8) * 2);
                        acc = __builtin_amdgcn_mfma_f32_16x16x32_bf16(af, bfr, acc, 0, 0, 0); } }
                    const int s = nt * 16 + fr; const float css = gl[G_CS + s];
#pragma unroll
                    for (int j = 0; j < 4; ++j) { const int t = mt * 16 + fq * 4 + j; const bool in = dir == 0 ? (s <= t) : (s >= t);
                      float w = in ? acc[j] * __expf(gl[G_BB + t] - css) : 0.f; S_s[t * SS + s] = pg8::f2bf_rne(w);
                      const float rs = sum16(w);
                      if (need && fr == 0) (void)__hip_atomic_fetch_add(&gl[G_DEN + t], rs, __ATOMIC_RELAXED, __HIP_MEMORY_SCOPE_WORKGROUP); } } }
                { const int row = wid * 8 + (lane >> 3), part = lane & 7;
                  const bf16x8 xa = *(const LAS bf16x8*)(q_s + row * QS + part * 16), xb = *(const LAS bf16x8*)(q_s + row * QS + part * 16 + 8); float s = 0.f;
#pragma unroll
                  for (int e = 0; e < 8; ++e) s += bf2f((unsigned short)xa[e]) * gl[G_NV + part * 16 + e] + bf2f((unsigned short)xb[e]) * gl[G_NV + part * 16 + 8 + e];
                  s = sum8(s);
                  if (part == 0) __hip_atomic_fetch_add(&gl[G_DEN + row], s * gl[G_EB + row], __ATOMIC_RELAXED, __HIP_MEMORY_SCOPE_WORKGROUP); }
                __syncthreads(); ML_STAMP(43);
                bf16x8 cfr[2][4];
#pragma unroll
                for (int nt = 0; nt < 2; ++nt)
#pragma unroll
                    for (int kk = 0; kk < 4; ++kk) { pg8::u32x4 w; w.x = pkbf(C[2 * kk][nt][0], C[2 * kk][nt][1]); w.y = pkbf(C[2 * kk][nt][2], C[2 * kk][nt][3]);
                        w.z = pkbf(C[2 * kk + 1][nt][0], C[2 * kk + 1][nt][1]); w.w = pkbf(C[2 * kk + 1][nt][2], C[2 * kk + 1][nt][3]); cfr[nt][kk] = __builtin_bit_cast(bf16x8, w); }
                bf16x8 vfr[2][2];
#pragma unroll
                for (int nt = 0; nt < 2; ++nt)
#pragma unroll
                    for (int kk = 0; kk < 2; ++kk) vfr[nt][kk] = vfrag(L + OFF_V, kk * 32, wid * 32 + nt * 16, lane);
#pragma unroll
                for (int mt = 0; mt < 4; ++mt) { f32x4 o2[2] = {(f32x4){0.f, 0.f, 0.f, 0.f}, (f32x4){0.f, 0.f, 0.f, 0.f}};
#pragma unroll
                    for (int kk = 0; kk < 4; ++kk) {
                        const u32x2 lo = *(const LAS u32x2*)(L + OFF_Q + ((mt * 16 + fr) * QS + kk * 32 + fq * 4) * 2), hi = *(const LAS u32x2*)(L + OFF_Q + ((mt * 16 + fr) * QS + kk * 32 + 16 + fq * 4) * 2);
                        pg8::u32x4 w; w.x = lo.x; w.y = lo.y; w.z = hi.x; w.w = hi.y; const bf16x8 af = __builtin_bit_cast(bf16x8, w);
#pragma unroll
                        for (int nt = 0; nt < 2; ++nt) o2[nt] = __builtin_amdgcn_mfma_f32_16x16x32_bf16(af, cfr[nt][kk], o2[nt], 0, 0, 0); }
#pragma unroll
                    for (int nt = 0; nt < 2; ++nt)
#pragma unroll
                        for (int j = 0; j < 4; ++j) o2[nt][j] *= gl[G_EB + mt * 16 + fq * 4 + j];
#pragma unroll
                    for (int kk = 0; kk < 2; ++kk) { const bf16x8 af = *(const LAS bf16x8*)(L + OFF_S + ((mt * 16 + fr) * SS + kk * 32 + fq * 8) * 2);
#pragma unroll
                        for (int nt = 0; nt < 2; ++nt) o2[nt] = __builtin_amdgcn_mfma_f32_16x16x32_bf16(af, vfr[nt][kk], o2[nt], 0, 0, 0); }
#pragma unroll
                    for (int j = 0; j < 4; ++j) { const int t = mt * 16 + fq * 4 + j; const float inv = __builtin_amdgcn_rcpf(fmaxf(fabsf(gl[G_DEN + t]), 1.f));
                        LAS unsigned short* hs = (LAS unsigned short*)(L + OFF_RAW + wid * 4096) + t * 32 + fr;
                        hs[0] = pg8::f2bf_rne(o2[0][j] * inv); hs[16] = pg8::f2bf_rne(o2[1][j] * inv); } }
                __builtin_amdgcn_sched_barrier(0);
                { const float ap = gl[G_MISC];
#pragma unroll
                  for (int dt = 0; dt < 8; ++dt)
#pragma unroll
                    for (int nt = 0; nt < 2; ++nt) C[dt][nt] = C[dt][nt] * ap;
#pragma unroll
                  for (int kk = 0; kk < 2; ++kk)
#pragma unroll
                    for (int dt = 0; dt < 8; ++dt) { const bf16x8 af = *(const LAS bf16x8*)(L + OFF_KTA + ((dt * 16 + fr) * KTS + kk * 32 + fq * 8) * 2);
#pragma unroll
                        for (int nt = 0; nt < 2; ++nt) C[dt][nt] = __builtin_amdgcn_mfma_f32_16x16x32_bf16(af, vfr[nt][kk], C[dt][nt], 0, 0, 0); }
                  if (tid >= 384) { const int d = tid - 384; const LAS unsigned short* rowp = kta + d * KTS; float s = 0.f;
#pragma unroll
                    for (int q = 0; q < 8; ++q) { const bf16x8 x = *(const LAS bf16x8*)(rowp + q * 8);
#pragma unroll
                        for (int e = 0; e < 8; ++e) s += bf2f((unsigned short)x[e]); }
                    gl[G_NV + d] = gl[G_NV + d] * ap + s; } }
                { const int row4 = lane >> 2, ch = lane & 3;
#pragma unroll
                  for (int ib = 0; ib < 2; ++ib) {
                    pg8::u32x4 hold[2];
                    if (dir == 1) {
#pragma unroll
                      for (int i2 = 0; i2 < 2; ++i2) hold[i2] = *(const pg8::u32x4*)(H + (rowbase + t0 + (ib * 2 + i2) * 16 + row4) * 2048 + h * 256 + wid * 32 + ch * 8); }
#pragma unroll
                    for (int i2 = 0; i2 < 2; ++i2) { const int t = (ib * 2 + i2) * 16 + row4; const pg8::u32x4 w = *(const LAS pg8::u32x4*)(L + OFF_RAW + wid * 4096 + t * 64 + ch * 16);
                      pg8::u32x4* hp = (pg8::u32x4*)(H + (rowbase + t0 + t) * 2048 + h * 256 + wid * 32 + ch * 8);
                      if (dir == 0) *hp = w;
                      else { const pg8::u32x4 o = hold[i2]; pg8::u32x4 r;
                        r.x = pkbf(bf2f((unsigned short)(o.x & 0xffffu)) + bf2f((unsigned short)(w.x & 0xffffu)), bf2f((unsigned short)(o.x >> 16)) + bf2f((unsigned short)(w.x >> 16)));
                        r.y = pkbf(bf2f((unsigned short)(o.y & 0xffffu)) + bf2f((unsigned short)(w.y & 0xffffu)), bf2f((unsigned short)(o.y >> 16)) + bf2f((unsigned short)(w.y >> 16)));
                        r.z = pkbf(bf2f((unsigned short)(o.z & 0xffffu)) + bf2f((unsigned short)(w.z & 0xffffu)), bf2f((unsigned short)(o.z >> 16)) + bf2f((unsigned short)(w.z >> 16)));
                        r.w = pkbf(bf2f((unsigned short)(o.w & 0xffffu)) + bf2f((unsigned short)(w.w & 0xffffu)), bf2f((unsigned short)(o.w >> 16)) + bf2f((unsigned short)(w.w >> 16)));
                        *hp = r; } }
                    asm volatile("" ::: "memory"); } }
                __syncthreads(); ML_STAMP(44);
            }
#undef B_ISSUE
#undef V_ISSUE
            ML_STAMP(31 + 2 * dir);
        }
    }
}
__device__ __forceinline__ void scan_phase(unsigned* __restrict__ EST, float* __restrict__ NST, const float* __restrict__ PST, const unsigned* __restrict__ CTXE, const float* __restrict__ CTXN, int bid, int G) {
    const int tid = threadIdx.x;
    for (int idx = bid * 512 + tid; idx < 64 * (int)EST_SLOT; idx += G * 512) {
        const int chain = idx >> 14, bh = chain >> 1, dir = chain & 1, e = idx & 16383;
        float s0 = 0.f, s1 = 0.f; unsigned cwd[4];
#pragma unroll
        for (int j = 0; j < 4; ++j) cwd[j] = CTXE[(size_t)((bh * 2 + dir) * 4 + j) * EST_SLOT + e];
        unsigned ew[7]; float Pw[7];
#pragma unroll
        for (int f = 0; f < 7; ++f) { const int gj = dir == 0 ? f : 7 - f; const int slot = (bh * 8 + gj) * 2 + dir; Pw[f] = PST[slot]; ew[f] = EST[(size_t)slot * EST_SLOT + e]; }
#pragma unroll
        for (int j = 0; j < 4; ++j) { s0 += bf2f((unsigned short)(cwd[j] & 0xffffu)); s1 += bf2f((unsigned short)(cwd[j] >> 16)); }
        const unsigned seedw = pkbf(s0, s1);
#pragma unroll
        for (int f = 0; f < 7; ++f) { s0 = s0 * Pw[f] + bf2f((unsigned short)(ew[f] & 0xffffu)); s1 = s1 * Pw[f] + bf2f((unsigned short)(ew[f] >> 16)); ew[f] = pkbf(s0, s1); }
        EST[(size_t)((bh * 8 + (dir == 0 ? 7 : 0)) * 2 + dir) * EST_SLOT + e] = seedw;
#pragma unroll
        for (int f = 0; f < 7; ++f) { const int gj = dir == 0 ? f : 7 - f; const int slot = (bh * 8 + gj) * 2 + dir; EST[(size_t)slot * EST_SLOT + e] = ew[f]; }
    }
    for (int idx = bid * 512 + tid; idx < 64 * 128; idx += G * 512) {
        const int chain = idx >> 7, bh = chain >> 1, dir = chain & 1, e = idx & 127;
        float s = 0.f;
#pragma unroll
        for (int j = 0; j < 4; ++j) s += CTXN[((bh * 2 + dir) * 4 + j) * 128 + e];
        const float seedn = s;
        float nw[7], Pn[7];
#pragma unroll
        for (int f = 0; f < 7; ++f) { const int gj = dir == 0 ? f : 7 - f; const int slot = (bh * 8 + gj) * 2 + dir; Pn[f] = PST[slot]; nw[f] = NST[slot * 128 + e]; }
#pragma unroll
        for (int f = 0; f < 7; ++f) { s = s * Pn[f] + nw[f]; nw[f] = s; }
#pragma unroll
        for (int f = 0; f < 7; ++f) { const int gj = dir == 0 ? f : 7 - f; const int slot = (bh * 8 + gj) * 2 + dir; NST[slot * 128 + e] = nw[f]; }
        NST[((bh * 8 + (dir == 0 ? 7 : 0)) * 2 + dir) * 128 + e] = seedn;
    }
}
}
#define XB_TMO      128
#define XB_XCNT(j)  (256  + 64 * (j))
#define XB_XSUB(j)  (1280 + 64 * (j))
#define XB_XGEN(j)  (2304 + 64 * (j))
#define XB_TOP      3328
#define XB_TOPGEN   3392
#define XCD_BAR_WORDS 3456
#define XB_SPIN_CAP (1u << 18)

__device__ __forceinline__ unsigned xb_ld(unsigned* p)              { return __hip_atomic_load(p, __ATOMIC_RELAXED, __HIP_MEMORY_SCOPE_AGENT); }
__device__ __forceinline__ unsigned xb_add(unsigned* p, unsigned v) { return __hip_atomic_fetch_add(p, v, __ATOMIC_RELAXED, __HIP_MEMORY_SCOPE_AGENT); }
__device__ __forceinline__ unsigned xb_xcc_id() { return (unsigned)__builtin_amdgcn_s_getreg((3 << 11) | 20) & 0xFu; }
#define XB_SPIN(cond, bar) do { unsigned _sp = 0; while (cond) { __builtin_amdgcn_s_sleep(1); \
    if ((++_sp & 255u) == 0u) { if (xb_ld(&(bar)[XB_TMO])) break; if (_sp > XB_SPIN_CAP) { atomicAdd(&(bar)[XB_TMO], 1u); break; } } } } while (0)

struct XcdBarrier {
    unsigned* bar; unsigned x;
    volatile LAS unsigned* st;
};

__device__ __forceinline__ XcdBarrier xcd_barrier_post(unsigned* bar, volatile LAS unsigned* st) {
    XcdBarrier b; b.bar = bar; b.x = xb_xcc_id(); b.st = st;
    if (threadIdx.x == 0) (void)xb_add(&bar[XB_XCNT(b.x)], 1u);
    return b;
}
__device__ __forceinline__ void xcd_barrier_complete(unsigned* bar, unsigned x, unsigned& nloc, unsigned& nx) {
    const unsigned G = gridDim.x * gridDim.y * gridDim.z;
    unsigned sum, cnt, mine, sp = 0u;
    for (;;) {
        sum = 0u; cnt = 0u; mine = 0u;
#pragma unroll
        for (unsigned j = 0; j < 16; ++j) { const unsigned c = xb_ld(&bar[XB_XCNT(j)]); sum += c; cnt += (c > 0u) ? 1u : 0u; mine = (j == x) ? c : mine; }
        if (sum == G) break;
        __builtin_amdgcn_s_sleep(1);
        if ((++sp & 255u) == 0u) { if (xb_ld(&bar[XB_TMO])) break; if (sp > XB_SPIN_CAP) { atomicAdd(&bar[XB_TMO], 1u); break; } }
    }
    nloc = mine > 0u ? mine : 1u; nx = cnt > 0u ? cnt : 1u;
}

__device__ __forceinline__ void xcd_barrier(const XcdBarrier& b) {
    asm volatile("s_waitcnt vmcnt(0)" ::: "memory");
    __syncthreads();
    if (threadIdx.x == 0) {
        unsigned* bar = b.bar;
        __builtin_amdgcn_s_waitcnt(0);
        unsigned nloc = b.st[0], nx = b.st[1];
        if (nloc == 0u) { xcd_barrier_complete(bar, b.x, nloc, nx); b.st[0] = nloc; b.st[1] = nx; }
        const unsigned old = xb_add(&bar[XB_XSUB(b.x)], 1u);
        const unsigned gen = old / nloc;
        if (old + 1u == (gen + 1u) * nloc) {
            __builtin_amdgcn_fence(__ATOMIC_RELEASE, "agent");
            asm volatile("s_waitcnt vmcnt(0)" ::: "memory");
            const unsigned og = xb_add(&bar[XB_TOP], 1u);
            const unsigned tg = og / nx;
            if (og + 1u == (tg + 1u) * nx) xb_add(&bar[XB_TOPGEN], 1u);
            else XB_SPIN(xb_ld(&bar[XB_TOPGEN]) == tg, bar);
            __builtin_amdgcn_fence(__ATOMIC_ACQUIRE, "agent");
            xb_add(&bar[XB_XGEN(b.x)], 1u);
            asm volatile("s_waitcnt vmcnt(0)" ::: "memory");
        } else {
            XB_SPIN(xb_ld(&bar[XB_XGEN(b.x)]) == gen, bar);
            __builtin_amdgcn_fence(__ATOMIC_ACQUIRE, "agent");
            asm volatile("s_waitcnt vmcnt(0)" ::: "memory");
        }
    }
    __syncthreads();
}

struct Args { const float* in[27]; float* out; unsigned char* ws; int ph_lo, ph_hi; };
enum { I_X = 0, I_C, I_CTX, I_CCTX, I_WMOD, I_BMOD, I_GPRE, I_GPOST, I_EWIN, I_ECW, I_ECB, I_FW1, I_FB1, I_FFREQ, I_FW2, I_FB2, I_FW3, I_HYB, I_QN, I_KN, I_EWOUT,
       I_OWIN, I_OCW, I_OCB, I_OGB, I_OHN, I_OWOUT };

__device__ __forceinline__ const float* inp(int i) {
    const __attribute__((address_space(4))) unsigned char* p = (const __attribute__((address_space(4))) unsigned char*)__builtin_amdgcn_kernarg_segment_ptr();
    asm volatile("" : "+s"(p));
    return *(const float* const __attribute__((address_space(4)))*)(p + 8 * i);
}
__global__ void __launch_bounds__(512, 2) fwd_kernel(Args a) {
    extern __shared__ __attribute__((aligned(16))) unsigned char lds_raw[];
    LAS unsigned char* lds = (LAS unsigned char*)lds_raw;
    cg::grid_group grid = cg::this_grid();
#define tid ((int)threadIdx.x)
#define lane ((int)(threadIdx.x & 63))
#define wid (__builtin_amdgcn_readfirstlane((int)(threadIdx.x >> 6)))
#define G ((int)gridDim.x)
#define bid ((int)blockIdx.x)
#define gw (bid * 8 + wid)
#define NGW (G * 8)
    unsigned char* ws = a.ws;
#define MODS ((float*)(ws + WS_MODS))
#define HDN ((bf16_t*)(ws + WS_HDN))
#define GATES ((float*)(ws + WS_GATES))
#define W0IN ((bf16_t*)(ws + WS_W0IN))
#define W0OUT ((bf16_t*)(ws + WS_W0OUT))
#define QKVG ((bf16_t*)(ws + WS_QKVG))
#define XVTL ((bf16_t*)(ws + WS_XVTL))
#define XVTC ((bf16_t*)(ws + WS_XVTC))
#define A2C ((bf16_t*)(ws + WS_A2C))
#define Y0L ((bf16_t*)(ws + WS_Y0))
#define Y0C ((float*)(ws + WS_Y0 + 32 * MiB))
#define W1OUT ((bf16_t*)(ws + WS_W1OUT))
#define W1B ((bf16_t*)(ws + WS_W1B))
#define H1 ((bf16_t*)(ws + WS_H1))
#define Y1A ((bf16_t*)(ws + WS_Y1A))
#define HB ((bf16_t*)(ws + WS_H))
#define W1A ((bf16_t*)(ws + WS_W1A))
#define OZ ((bf16_t*)(ws + WS_OZ))
#define Y1 ((bf16_t*)(ws + WS_Y1))
#define H0 ((bf16_t*)a.out)
#define A2L ((bf16_t*)a.out)
#define X1B ((bf16_t*)a.out + (size_t)MLAT * DM)
#define ESTP ((unsigned*)a.out)
#ifdef DUPPH
    const int lo = a.ph_lo, hi = a.ph_hi & 255, xm = a.ph_hi >> 8;
#define XOFF(bit) ((xm >> (bit)) & 1)
#else
    const int lo = a.ph_lo, hi = a.ph_hi;
#define XOFF(bit) 0
#endif
    volatile LAS unsigned* MISC = (volatile LAS unsigned*)(lds + 143360);
    if (tid < 2) MISC[tid] = 0u;
    __syncthreads();
    if (a.ph_lo < 0) grid.sync();
    XcdBarrier xbar = xcd_barrier_post((unsigned*)(ws + WS_CTL), MISC);
#ifndef PHMASK
#define PHMASK 0xFFFFF
#endif
#define IN(k) ((((PHMASK) >> (k)) & 1) && lo <= (k) && (k) < hi)
#if defined(PROBE_A)
#ifndef PROBE_SCALE
#define PROBE_SCALE 1.f
#endif
#define stamps ((unsigned long long*)(ws + 32768))
#define SEAM(k) do { if (IN(k) && IN((k) + 1)) { xcd_barrier(xbar); } if (((k) + 1 == PROBE_A || (k) == PROBE_A || (k) + 1 == PROBE_B || (k) == PROBE_B) && bid == 0) stamps[(k) + 1] = __builtin_amdgcn_s_memrealtime(); } while (0)
    if (bid == 0) stamps[0] = __builtin_amdgcn_s_memrealtime();
#else
#define SEAM(k) do { if (IN(k) && IN((k) + 1)) { xcd_barrier(xbar); } } while (0)
#endif

    if (IN(0)) {
        LAS float* scr = (LAS float*)(lds + wid * 16384);
        if (!XOFF(0)) for (int it = gw; it < 3328 + 1024; it += NGW) {
            if (it < 3328) { const int kb = it / 208, cb_ = it % 208;
                if (cb_ >= 128 && cb_ < 168) transpose_item<true>(inp(I_EWIN), 6656, 1024, cb_ * 32, W0IN, cb_ * 32, scr, kb, lane);
                else transpose_item(inp(I_EWIN), 6656, 1024, cb_ * 32, W0IN, cb_ * 32, scr, kb, lane); }
            else { const int r = it - 3328, kb = r / 32, cb_ = r % 32; transpose_item(inp(I_EWOUT), 1024, 2048, cb_ * 32, W0OUT, cb_ * 32, scr, kb, lane); }
        }
        if (!XOFF(1)) for (int it = bid; it < 192; it += G) {
            const int l = it / 96, r = it % 96, cc = r / 16, kc = r % 16, col = cc * 512 + tid;
            const float* wm = inp(I_WMOD) + ((size_t)l * 1024 + kc * 64) * 3072 + col; const float* cv = inp(I_C) + kc * 64; const float* ccx = inp(I_CCTX) + kc * 64;
            float acc[5] = {0.f, 0.f, 0.f, 0.f, 0.f};
            LAS float* sl = (LAS float*)lds;
            __syncthreads();
            if (tid < 320) { const int j = tid >> 6, k = tid & 63; sl[tid] = silu_f(j < 4 ? cv[j * 1024 + k] : ccx[k]); }
            __syncthreads();
#pragma unroll 16
            for (int k = 0; k < 64; ++k) { const float w = wm[(size_t)k * 3072];
#pragma unroll
                for (int j = 0; j < 5; ++j) acc[j] += sl[j * 64 + k] * w; }
            const float bm = (kc == 0) ? inp(I_BMOD)[l * 3072 + col] : 0.f;
#pragma unroll
            for (int j = 0; j < 5; ++j) atomicAdd(&MODS[(l * 5 + j) * 3072 + col], acc[j] + bm);
        }
        if (!XOFF(2)) {
            float w1r[33], w2r[64];
            { const float* w1 = inp(I_FW1); const float* w2 = inp(I_FW2);
#pragma unroll
              for (int i = 0; i < 33; ++i) w1r[i] = w1[i * 64 + lane];
#pragma unroll
              for (int i = 0; i < 64; ++i) w2r[i] = w2[i * 64 + lane]; }
            const float fr_ = inp(I_FFREQ)[lane] * 0.15915494309189535f, fb1_ = inp(I_FB1)[lane], fb2_ = inp(I_FB2)[lane];
            for (int r = gw; r < 4352; r += NGW) {
                const int n = r < 4096 ? 4096 : 256, t = r < 4096 ? r : r - 4096;
                float acc = ((float)t / (float)(n - 1)) * w1r[0];
                const float tn = (float)t / (float)n;
#pragma unroll
                for (int i = 0; i < 16; ++i) { const float band = 1e-4f + (float)i * ((15.f - 1e-4f) / 15.f); const float rev = __builtin_amdgcn_fractf(tn * band);
                    acc += __builtin_amdgcn_cosf(rev) * w1r[1 + i] - __builtin_amdgcn_sinf(rev) * w1r[17 + i]; }
                const float h1 = __builtin_amdgcn_sinf(__builtin_amdgcn_fractf(fr_ * (acc + fb1_)));
                float acc2 = 0.f;
#pragma unroll
                for (int i = 0; i < 64; ++i) acc2 += __builtin_bit_cast(float, __builtin_amdgcn_readlane(__builtin_bit_cast(int, h1), i)) * w2r[i];
                HDN[(size_t)lane * 4352 + r] = f2bf(__builtin_amdgcn_sinf(__builtin_amdgcn_fractf(fr_ * (acc2 + fb2_))));
            }
        }
    }
    SEAM(0);
    if (IN(1)) {
        for (int m0 = gw; m0 < MTOT; m0 += 4 * NGW) {
            f32x4 v[4][4];
#pragma unroll
            for (int r = 0; r < 4; ++r) { const int m = m0 + r * NGW;
                if (m < MTOT) load_row(m < MLAT ? inp(I_X) + (size_t)m * DM : inp(I_CTX) + (size_t)(m - MLAT) * DM, lane, v[r]); }
#pragma unroll
            for (int r = 0; r < 4; ++r) { const int m = m0 + r * NGW; const int j = m < MLAT ? (m >> 12) : 4;
                if (m < MTOT) { const float rstd = row_rstd(v[r]); modulate_inplace(v[r], rstd, inp(I_GPRE), MODS + (size_t)j * 3072, lane); } }
#pragma unroll
            for (int r = 0; r < 4; ++r) { const int m = m0 + r * NGW; if (m < MTOT) store_row_bf16(H0 + (size_t)m * DM, lane, v[r]); }
        }
    }
    SEAM(1);
    if (IN(2)) {
        pg8::Gemm g{H0, W0IN, MTOT, 6656, 1024, H0, 1 << 30, 1024, 0}; pg8::StaticOrder S; S.init(MTOT, 6656, G, bid); pg8::EpiL0 E{XVTL, XVTC, QKVG, inp(I_QN), inp(I_KN), (LAS float*)(lds + 131072)};
        pg8::gemm_phase<pg8::EpiL0, pg8::StaticOrder, true, true>(lds, g, S, E);
    }
    SEAM(2);
    if (IN(4)) {
        if (wid >= 4) __builtin_amdgcn_s_setprio(1);
        if ((bid >> 3) & 1) {
        for (int it = bid; it < 256; it += G) hyena_lat4(lds, (it & 7) * 128 + (it >> 3) * 4, XVTL, HDN, inp(I_FW3), inp(I_ECW), inp(I_ECB), inp(I_HYB), A2L, tid, (float*)(ws + 247 * MiB) + (size_t)bid * 8192);
        }
        __syncthreads();
        for (int u = bid; u < 768; u += G) {
            const bf16_t *Qb, *Gb; bf16_t* Ob; int seg0, seq, wrows; unsigned kb0, kb1;
            if (u < 512) { const int b = u >> 7, h = (u >> 4) & 7, qb = u & 15; const size_t q0 = (size_t)b * SEQ + qb * 256;
                Qb = QKVG + q0 * 2560 + h * 128; kb0 = (unsigned)(((size_t)b * SEQ * 2560 + 1024 + (h >> 2) * 128) * 2); kb1 = (unsigned)(((size_t)(MLAT + b * CTXL) * 2560 + 1024 + (h >> 2) * 128) * 2);
                seg0 = SEQ; seq = SEQ + CTXL; wrows = 32; Gb = QKVG + q0 * 2560 + 1536 + h * 128; Ob = A2L + q0 * 2048 + 1024 + h * 128; }
            else { const int p = u - 512, v = p >> 3, sub = p & 7, b = v >> 3, h = v & 7; const size_t q0 = (size_t)MLAT + b * CTXL;
                Qb = QKVG + (q0 + sub * 32) * 2560 + h * 128; kb0 = (unsigned)((q0 * 2560 + 1024 + (h >> 2) * 128) * 2); kb1 = kb0; seg0 = CTXL; seq = CTXL; wrows = 0;
                Gb = QKVG + (q0 + sub * 32) * 2560 + 1536 + h * 128; Ob = A2C + ((size_t)b * CTXL + sub * 32) * 2048 + 1024 + h * 128; }
            const __amdgpu_buffer_rsrc_t kvrs = __builtin_amdgcn_make_buffer_rsrc((void*)QKVG, (short)0, (int)(MTOT * 2560 * 2), 0x00020000);
            attn::attn_dense_body(Qb, kvrs, kb0, kb1, seg0, Gb, Ob, seq, (char*)lds_raw, wrows);
        }
        __syncthreads();
        if (!((bid >> 3) & 1)) {
        for (int it = bid; it < 256; it += G) hyena_lat4(lds, (it & 7) * 128 + (it >> 3) * 4, XVTL, HDN, inp(I_FW3), inp(I_ECW), inp(I_ECB), inp(I_HYB), A2L, tid, (float*)(ws + 247 * MiB) + (size_t)bid * 8192);
        }
        __syncthreads();
#if defined(PROBE_A) && defined(PROBE_P4PARTS)
        xcd_barrier(xbar); if (bid == 0 && tid == 0) stamps[20] = __builtin_amdgcn_s_memrealtime();
#endif
#ifndef NO_HYENA
#if defined(PROBE_A) && defined(PROBE_P4PARTS)
        xcd_barrier(xbar); if (bid == 0 && tid == 0) stamps[21] = __builtin_amdgcn_s_memrealtime();
#endif
        for (int it = bid; it < 256; it += G) hyena_ctx4(lds, (it & 7) * 128 + (it >> 3) * 4, XVTC, HDN + 4096, inp(I_FW3), inp(I_ECW), inp(I_ECB), inp(I_HYB), A2C, tid);
#endif
    }
    __builtin_amdgcn_s_setprio(0);
    SEAM(4);
    if (IN(5)) {
        { pg8::Gemm g{A2L, W0OUT, MLAT, 1024, 2048, A2L, 1 << 30, 2048, 0}; pg8::StaticOrder S; S.init(MLAT, 1024, G, bid); pg8::EpiBf16<0> E{Y0L, 1024, nullptr, 0, 0, 1.f};
          pg8::gemm_phase<pg8::EpiBf16<0>, pg8::StaticOrder, true, true>(lds, g, S, E); }
        { pg8::Gemm g{A2C, W0OUT, MCTX, 1024, 256, A2C, 1 << 30, 2048, 512}; pg8::SplitKOrder S{G, bid}; pg8::EpiF32Slab E{Y0C, 1024, (size_t)MCTX * 1024};
          pg8::gemm_phase<pg8::EpiF32Slab, pg8::SplitKOrder, true, true>(lds, g, S, E); }
    }
    SEAM(5);
    if (IN(6)) {
        for (int m0 = gw; m0 < MLAT; m0 += 2 * NGW) {
            f32x4 y[2][4], x[2][4];
#pragma unroll
            for (int r = 0; r < 2; ++r) { const int m = m0 + r * NGW; load_row_bf16(Y0L + (size_t)m * DM, lane, y[r]); load_row(inp(I_X) + (size_t)m * DM, lane, x[r]); }
#pragma unroll
            for (int r = 0; r < 2; ++r) { const int m = m0 + r * NGW; const int j = m >> 12; const float ry = row_rstd(y[r]);
                const float* ga = MODS + (size_t)j * 3072 + 2048;
#pragma unroll
                for (int q = 0; q < 4; ++q) { const int idx = RIX(lane, q); x[r][q] = x[r][q] + ((const f32x4*)ga)[idx] * (y[r][q] * ry * ((const f32x4*)inp(I_GPOST))[idx]); }
                const float rx = row_rstd(x[r]);
#pragma unroll
                for (int q = 0; q < 4; ++q) y[r][q] = x[r][q];
                modulate_inplace(y[r], rx, inp(I_GPRE) + DM, MODS + (size_t)(5 + j) * 3072, lane); }
#pragma unroll
            for (int r = 0; r < 2; ++r) { const int m = m0 + r * NGW; store_row_bf16(X1B + (size_t)m * DM, lane, x[r]); store_row_bf16(H1 + (size_t)m * DM, lane, y[r]); }
        }
        for (int m = MLAT + gw; m < MTOT; m += NGW) {
            f32x4 y[4], x[4];
            load_row(Y0C + (size_t)(m - MLAT) * DM, lane, y);
#pragma unroll
            for (int kc = 1; kc < 8; ++kc) { f32x4 p[4]; load_row(Y0C + (size_t)kc * MCTX * DM + (size_t)(m - MLAT) * DM, lane, p);
#pragma unroll
                for (int q = 0; q < 4; ++q) y[q] = y[q] + p[q]; }
            load_row(inp(I_CTX) + (size_t)(m - MLAT) * DM, lane, x); const float ry = row_rstd(y);
            const float* ga = MODS + (size_t)4 * 3072 + 2048;
#pragma unroll
            for (int q = 0; q < 4; ++q) { const int idx = RIX(lane, q); x[q] = x[q] + ((const f32x4*)ga)[idx] * (y[q] * ry * ((const f32x4*)inp(I_GPOST))[idx]); }
            const float rx = row_rstd(x);
            modulate_store(x, rx, inp(I_GPRE) + DM, MODS + (size_t)(5 + 4) * 3072, H1 + (size_t)m * DM, lane);
        }
        LAS float* scr = (LAS float*)(lds + wid * 16384);
        for (int it = gw; it < 2048 + 16 + 2048 + 1024; it += NGW) {
            if (it < 2048) { const int kb = it / 128, cb_ = it % 128; transpose_item(inp(I_OWIN), 8224, 1024, cb_ * 32, W1A, cb_ * 32, scr, kb, lane); }
            else if (it < 2064) { const int kb = it - 2048; transpose_item(inp(I_OWIN), 8224, 1024, 8192, W1A, 4096, scr, kb, lane); }
            else if (it < 4112) { const int r = it - 2064, kb = r / 128, cb_ = r % 128; transpose_item(inp(I_OWIN), 8224, 1024, 4096 + cb_ * 32, W1B, cb_ * 32, scr, kb, lane); }
            else { const int r = it - 4112, kb = r / 32, cb_ = r % 32; transpose_item(inp(I_OWOUT), 1024, 2048, cb_ * 32, W1OUT, cb_ * 32, scr, kb, lane); }
        }
    }
    SEAM(6);
    if (IN(7)) {
        pg8::Gemm g{H1, W1A, MTOT, 4352, 1024, H1, 1 << 30, 1024, 0}; pg8::StaticOrder S; S.init(MTOT, 4352, G, bid); pg8::EpiL1a E{Y1A, GATES, inp(I_OGB)};
        if (bid >= 132) { for (int i_ = 0; i_ < 4; ++i_) __builtin_amdgcn_s_sleep(127); }
        pg8::gemm_phase<pg8::EpiL1a, pg8::StaticOrder, true, true>(lds, g, S, E);
    }
    SEAM(7);
    if (IN(8)) { if (wid >= 4) __builtin_amdgcn_s_setprio(1); }
    if (IN(8)) ml2::passA(lds, Y1A, GATES, inp(I_OCW), inp(I_OCB), ESTP, (float*)(ws + WS_NST), (float*)(ws + WS_PST), (unsigned*)(ws + WS_CTXE), (float*)(ws + WS_CTXN), bid, G);
    SEAM(8);
    if (IN(9)) ml2::scan_phase(ESTP, (float*)(ws + WS_NST), (const float*)(ws + WS_PST), (const unsigned*)(ws + WS_CTXE), (const float*)(ws + WS_CTXN), bid, G);
    SEAM(9);
    if (IN(10)) ml2::passB(lds, Y1A, GATES, inp(I_OCW), inp(I_OCB), (const unsigned*)ESTP, (const float*)(ws + WS_NST), (const float*)(ws + WS_PST), HB, bid, G, ws + 32768);
    __builtin_amdgcn_s_setprio(0);
    SEAM(10);
    if (IN(12)) {
        pg8::Gemm g{H1, W1B, MLAT, 4096, 1024, H1, 1 << 30, 1024, 0}; pg8::PairOrder S{G, bid}; pg8::EpiOZ E{HB, inp(I_OHN), (LAS float*)(lds + 131072)};
        pg8::gemm_phase<pg8::EpiOZ, pg8::PairOrder, true, true>(lds, g, S, E);
    }
    SEAM(12);
    if (IN(14)) {
        pg8::Gemm g{HB, W1OUT, MLAT, 1024, 2048, HB, 1 << 30, 2048, 0}; pg8::StaticOrder S; S.init(MLAT, 1024, G, bid); pg8::EpiBf16<0> E{Y1, 1024, nullptr, 0, 0, 1.f};
        pg8::gemm_phase<pg8::EpiBf16<0>, pg8::StaticOrder, true, true>(lds, g, S, E);
    }
    SEAM(14);
#if defined(PROBE_A) && !defined(PROBE_KEEP15)
    if (false) {
#else
    if (IN(15)) {
#endif
        f32x4 res[8][4];
#pragma unroll
        for (int r = 0; r < 8; ++r) { const int m = gw + r * NGW;
            if (m < MLAT) { f32x4 y[4], x[4], gav[4], gpv[4]; load_row_bf16(Y1 + (size_t)m * DM, lane, y); load_row_bf16(X1B + (size_t)m * DM, lane, x);
                const float* ga = MODS + (size_t)(5 + (m >> 12)) * 3072 + 2048;
#pragma unroll
                for (int q = 0; q < 4; ++q) { const int idx = RIX(lane, q); gav[q] = ((const f32x4*)ga)[idx]; gpv[q] = ((const f32x4*)(inp(I_GPOST) + DM))[idx]; }
                asm volatile("" ::: "memory");
                const float ry = row_rstd(y);
#pragma unroll
                for (int q = 0; q < 4; ++q) res[r][q] = x[q] + gav[q] * (y[q] * ry * gpv[q]); } }
        xcd_barrier(xbar);
#pragma unroll
        for (int r = 0; r < 8; ++r) { const int m = gw + r * NGW;
            if (m < MLAT) {
#pragma unroll
                for (int q = 0; q < 4; ++q) ((f32x4*)(a.out + (size_t)m * DM))[RIX(lane, q)] = res[r][q]; } }
    }
#if defined(PROBE_A)
    xcd_barrier(xbar);
    if (bid == 0) {
        stamps[NPHASE] = __builtin_amdgcn_s_memrealtime();
        __syncthreads();
#define PDUR(p) ((p) < NPHASE ? (float)(stamps[(p) + 1] - stamps[(p)]) : (p) >= 30 ? (float)(stamps[(p) + 1] - stamps[(p)]) : (p) == 20 ? (float)(stamps[20] - stamps[4]) : (p) == 21 ? (float)(stamps[21] - stamps[20]) : (float)(stamps[5] - stamps[21]))
        float ta = PDUR(PROBE_A) * 0.01f;
        ta = exp2f(rintf(2.f * log2f(ta * PROBE_SCALE) + PROBE_SHIFT) / 2.f);
#if PROBE_B >= 0
#ifdef PROBE_LIN
        float tb = PDUR(PROBE_B) * 0.01f; tb = fmaxf(8.f, rintf((tb - PROBE_T0) / PROBE_Q) * PROBE_Q * PROBE_K);
#else
        float tb = PDUR(PROBE_B) * 0.01f; tb = exp2f(rintf(2.f * log2f(tb * PROBE_SCALE) + PROBE_SHIFT) / 2.f);
#endif
#else
        const float tb = 100.f;
#endif
        for (int i = tid; i < (1 << 20); i += 512) a.out[i] = (i == 0) ? (1000.f + 10.f * ta) : tb;
    }
#endif
#undef IN
#undef SEAM
#undef tid
#undef lane
#undef wid
#undef G
#undef bid
#undef gw
#undef NGW
}

#ifndef MK_MULTI
#define MK_MULTI 0
#endif
extern "C" void kernel_launch(void* const* d_in, const int* in_sizes, int n_in, void* d_out, int out_size, void* d_ws, size_t ws_size, hipStream_t stream) {
    static int grid = 0;
    if (grid == 0) {
        if (n_in != 27 || out_size != MLAT * DM || ws_size < WS_END) { fprintf(stderr, "kernel_launch: unexpected shapes (n_in %d out %d ws %zu)\n", n_in, out_size, ws_size); grid = -1; return; }
        int dev = 0, cus = 0, per_cu = 0;
        if (hipGetDevice(&dev) != hipSuccess || hipDeviceGetAttribute(&cus, hipDeviceAttributeMultiprocessorCount, dev) != hipSuccess) { grid = -1; return; }
        if (hipFuncSetAttribute((const void*)fwd_kernel, hipFuncAttributeMaxDynamicSharedMemorySize, LDS_BYTES) != hipSuccess) { fprintf(stderr, "kernel_launch: hipFuncSetAttribute failed\n"); grid = -1; return; }
        if (hipOccupancyMaxActiveBlocksPerMultiprocessor(&per_cu, (const void*)fwd_kernel, 512, LDS_BYTES) != hipSuccess || per_cu < 1) { fprintf(stderr, "kernel_launch: occupancy query failed (%d)\n", per_cu); (void)hipGetLastError(); per_cu = 1; }
        grid = cus * (per_cu > 1 ? 1 : per_cu);
        if (grid != 256) { fprintf(stderr, "kernel_launch: this kernel's static work split assumes 256 CUs (got %d); nothing launched\n", grid); grid = -1; return; }
    }
    if (grid < 0) return;
    (void)hipMemsetAsync((char*)d_ws + WS_CTL, 0, CTL_ZERO_BYTES, stream);
    Args a{};
    for (int i = 0; i < 27; ++i) a.in[i] = (const float*)d_in[i];
    a.out = (float*)d_out; a.ws = (unsigned char*)d_ws;
#if MK_MULTI
    for (int p = 0; p < NPHASE; ++p) { a.ph_lo = p; a.ph_hi = p + 1; hipLaunchKernelGGL(fwd_kernel, dim3(grid), dim3(512), LDS_BYTES, stream, a); }
#else
    a.ph_lo = 0; a.ph_hi = NPHASE;
    void* args[] = {&a};
    hipError_t e = hipLaunchCooperativeKernel((const void*)fwd_kernel, dim3(grid), dim3(512), args, LDS_BYTES, stream);
    if (e != hipSuccess) fprintf(stderr, "kernel_launch: cooperative launch failed: %s (grid %d)\n", hipGetErrorString(e), grid);
#ifdef DUPPH
    Args a2 = a; a2.ph_lo = DUPPH; a2.ph_hi = (DUPPH + 1) | (DUPX << 8); void* args2[] = {&a2};
    for (int r = 0; r < DUPN; ++r) (void)hipLaunchCooperativeKernel((const void*)fwd_kernel, dim3(grid), dim3(512), args2, LDS_BYTES, stream);
#endif
#endif
}
```

```cpp
#include <hip/hip_runtime.h>
#include <hip/hip_cooperative_groups.h>
#include <hip/hip_bf16.h>
#include <cstdio>
#include <cstdint>
#include <cmath>
namespace cg = cooperative_groups;
namespace pg8 {
#define PG8_LAS __attribute__((address_space(3)))
typedef unsigned short bf16_t;
typedef short bf16x8 __attribute__((ext_vector_type(8)));
typedef float f32x4 __attribute__((ext_vector_type(4)));
typedef unsigned u32x4 __attribute__((ext_vector_type(4)));
constexpr int BM = 256, BK = 64, HALF = 128, HTB = HALF * BK * 2  , STAGE_BYTES = 8 * HTB, NXCD = 8, WGM = 8;

__host__ __device__ __forceinline__ int lds_byte(int r, int c) { const int st = (r >> 4) * 2 + (c >> 5), rr = r & 15, cc = c & 31, ob = rr * 64 + cc * 2; return st * 1024 + (ob ^ (((ob >> 9) & 1) << 5)); }
__host__ __device__ __forceinline__ void stage_rc(int b, int& R, int& C) { const int st = b / 1024, sb = b % 1024, swz = sb ^ (((sb >> 9) & 1) << 5); R = (st >> 1) * 16 + swz / 64; C = (st & 1) * 32 + (swz % 64) / 2; }
__host__ __device__ __forceinline__ int perm32(int rho) { const int n = rho >> 4, i = rho & 15; return 8 * (i >> 2) + 4 * n + (i & 3); }

struct Unit { int pm, pn, kc; };
struct Gemm { const bf16_t* A; const bf16_t* Bt; int M, N, K; const bf16_t* A2; int split_pm; int ld; int kcb; };

struct StaticOrder {
    int nM, nN, nwg, G, c;
    __host__ __device__ void init(int M, int N, int G_, int c_) { nM = M / BM; nN = N / BM; nwg = nM * nN; G = G_; c = c_; }
    __host__ __device__ bool next(int i, Unit& u) const {
        const long L = (long)i * G + c; if (L >= nwg) return false;
        int wgid = (int)L; { const int q = nwg / NXCD, r = nwg % NXCD, xcd = wgid % NXCD, off = wgid / NXCD; wgid = (xcd < r ? xcd * (q + 1) : r * (q + 1) + (xcd - r) * q) + off; }
        const int nig = WGM * nN, gid = wgid / nig, fm = gid * WGM, gsz = (nM - fm) < WGM ? (nM - fm) : WGM;
        u.pm = fm + ((wgid % nig) % gsz); u.pn = (wgid % nig) / gsz; u.kc = 0; return true;
    }
    __device__ __forceinline__ void a_ready(const Unit&) const {}
    __device__ __forceinline__ void done(const Unit&) const {}
};

__device__ __forceinline__ unsigned cvt_pk_bf16(float lo, float hi) { unsigned r; asm volatile("v_cvt_pk_bf16_f32 %0, %1, %2" : "=v"(r) : "v"(lo), "v"(hi)); return r; }
typedef float f32x2 __attribute__((ext_vector_type(2)));
__device__ __forceinline__ f32x2 gelu_pk(f32x2 v) {
    const f32x2 av = __builtin_elementwise_abs(v), d = av * 0.2316418882f + 1.0f;
    f32x2 t; t.x = __builtin_amdgcn_rcpf(d.x); t.y = __builtin_amdgcn_rcpf(d.y);
    f32x2 q = t * 0.5307027145f + (-0.7265760135f); q = q * t + 0.7107068705f; q = q * t + (-0.142248368f); q = q * t + 0.127414796f; q = q * t;
    const f32x2 s = (v * v) * (-0.72134752044f);
    f32x2 e; e.x = __builtin_amdgcn_exp2f(s.x); e.y = __builtin_amdgcn_exp2f(s.y);
    const f32x2 m = v * (q * e), r = v - m;
    f32x2 o; o.x = v.x < 0.f ? m.x : r.x; o.y = v.y < 0.f ? m.y : r.y; return o;
}

template <int ACT  > struct EpiBf16 {
    static constexpr bool PERM = true, AFTER_DRAIN = false; static_assert(ACT == 0 || ACT == 1, "EpiBf16: ACT is 0 (none) or 1 (gelu_pk)");
    bf16_t* O; int ldc; const float* bias; int split_cols; size_t split_stride; float scale0;
    __device__ __forceinline__ void operator()(const f32x4 (&acc)[2][2][4][2], const Unit& u, int wr, int wc, int fr, int fq) const {
        const int row0 = u.pm * BM + wr * 64 + fr; int colt = u.pn * BM; bf16_t* base = O;
        float sc = 1.f; if (split_cols) { const int t = colt / split_cols; base += (size_t)t * split_stride; colt -= t * split_cols; if (t == 0) sc = scale0; }
        const int col0 = colt + wc * 32 + 8 * fq, bcol0 = u.pn * BM + wc * 32 + 8 * fq;
        f32x4 bv[2][2];
#pragma unroll
        for (int bj = 0; bj < 2; ++bj)
#pragma unroll
            for (int n = 0; n < 2; ++n) bv[bj][n] = bias ? *(const f32x4*)(bias + bcol0 + bj * HALF + 4 * n) : (f32x4){0.f, 0.f, 0.f, 0.f};
#pragma unroll
        for (int ai = 0; ai < 2; ++ai)
#pragma unroll
            for (int m = 0; m < 4; ++m) { bf16_t* rowp = base + (size_t)(row0 + ai * HALF + m * 16) * ldc + col0;
#pragma unroll
                for (int bj = 0; bj < 2; ++bj) { f32x4 v0 = acc[ai][bj][m][0] + bv[bj][0], v1 = acc[ai][bj][m][1] + bv[bj][1];
                    if (ACT == 1) { f32x2 a = gelu_pk((f32x2){v0[0], v0[1]}), b = gelu_pk((f32x2){v0[2], v0[3]}), c = gelu_pk((f32x2){v1[0], v1[1]}), d = gelu_pk((f32x2){v1[2], v1[3]});
                        v0 = (f32x4){a.x, a.y, b.x, b.y}; v1 = (f32x4){c.x, c.y, d.x, d.y}; }
                    v0 = v0 * sc; v1 = v1 * sc; u32x4 w; w.x = cvt_pk_bf16(v0[0], v0[1]); w.y = cvt_pk_bf16(v0[2], v0[3]); w.z = cvt_pk_bf16(v1[0], v1[1]); w.w = cvt_pk_bf16(v1[2], v1[3]);
                    *(u32x4*)(rowp + bj * HALF) = w; } }
    }
};
struct EpiF32 {
    static constexpr bool PERM = false, AFTER_DRAIN = false;
    float* C; int ldc; const float* bias;
    __device__ __forceinline__ void operator()(const f32x4 (&acc)[2][2][4][2], const Unit& u, int wr, int wc, int fr, int fq) const {
        const int row0 = u.pm * BM + wr * 64 + fr, col0 = u.pn * BM + wc * 32 + 4 * fq;
        f32x4 bv[2][2];
#pragma unroll
        for (int bj = 0; bj < 2; ++bj)
#pragma unroll
            for (int n = 0; n < 2; ++n) bv[bj][n] = bias ? *(const f32x4*)(bias + col0 + bj * HALF + n * 16) : (f32x4){0.f, 0.f, 0.f, 0.f};
#pragma unroll
        for (int ai = 0; ai < 2; ++ai)
#pragma unroll
            for (int m = 0; m < 4; ++m) { float* rowp = C + (size_t)(row0 + ai * HALF + m * 16) * ldc + col0;
#pragma unroll
                for (int bj = 0; bj < 2; ++bj)
#pragma unroll
                    for (int n = 0; n < 2; ++n) *(f32x4*)(rowp + bj * HALF + n * 16) = acc[ai][bj][m][n] + bv[bj][n]; }
    }
};
template <class Epi, class Sched, bool ALIGN_EPI = false, bool SP2 = false>
__device__ __forceinline__ void gemm_phase(PG8_LAS unsigned char* lds, const Gemm g, const Sched& S, const Epi& E) {
    int tid_ = threadIdx.x; asm volatile("" : "+v"(tid_));
    const int tid = tid_, wid = __builtin_amdgcn_readfirstlane(tid >> 6), lane = tid & 63, wr = wid >> 2, wc = wid & 3, fr = lane & 15, fq = lane >> 4;
    const int K = g.K, nt = K / BK;
    unsigned voffA[2], voffB[2];
#pragma unroll
    for (int i = 0; i < 2; ++i) { int R, C; stage_rc(tid * 16 + i * 8192, R, C); const int Rb = Epi::PERM ? ((R & ~31) + perm32(R & 31)) : R;
        voffA[i] = (unsigned)(R * g.ld + C) * 2u; voffB[i] = (unsigned)(Rb * g.ld + C) * 2u; }
    const size_t kstep = (size_t)(BK * 2);
    const size_t hstep = (size_t)HALF * g.ld * 2;
    const size_t tstep = 2 * hstep;
    const unsigned ldsw = (unsigned)wid * 1024u;
    const int aoff = lds_byte(wr * 64 + fr, fq * 8), boff = lds_byte(wc * 32 + fr, fq * 8);
#define PG8_ABASE(pm_) (((pm_) < g.split_pm) ? ((const char*)g.A + (size_t)(pm_) * tstep) : ((const char*)g.A2 + (size_t)((pm_) - g.split_pm) * tstep))
#define PG8_SA(b, h) (((b) * 2 + (h)) * HTB)
#define PG8_SB(b, h) ((4 + (b) * 2 + (h)) * HTB)
#define PG8_STAGE(bufoff, gbase, voff) do { _Pragma("unroll") for (int _i = 0; _i < 2; ++_i) \
        __builtin_amdgcn_global_load_lds((const unsigned*)((const char*)(gbase) + (voff)[_i]), (PG8_LAS unsigned*)(lds + (bufoff) + ldsw + _i * 8192), 16, 0, 0); } while (0)
#define PG8_LDA(dst, b, h) do { _Pragma("unroll") for (int m = 0; m < 4; ++m) _Pragma("unroll") for (int k = 0; k < 2; ++k) dst[m][k] = *(const PG8_LAS bf16x8*)(lds + PG8_SA(b, h) + aoff + m * 2048 + k * 1024); } while (0)
#define PG8_LDB(dst, b, h) do { _Pragma("unroll") for (int n = 0; n < 2; ++n) _Pragma("unroll") for (int k = 0; k < 2; ++k) dst[n][k] = *(const PG8_LAS bf16x8*)(lds + PG8_SB(b, h) + boff + n * 2048 + k * 1024); } while (0)
#define PG8_MMA(ai, bj, At, Bt) do { __builtin_amdgcn_s_setprio(1); _Pragma("unroll") for (int m = 0; m < 4; ++m) _Pragma("unroll") for (int n = 0; n < 2; ++n) _Pragma("unroll") for (int k = 0; k < 2; ++k) \
        acc[ai][bj][m][n] = __builtin_amdgcn_mfma_f32_16x16x32_bf16(Bt[n][k], At[m][k], acc[ai][bj][m][n], 0, 0, 0); __builtin_amdgcn_s_setprio(0); } while (0)
#define PG8_WAIT_V(n) asm volatile("s_waitcnt vmcnt(" #n ")" ::: "memory")
#define PG8_WAIT_L(n) asm volatile("s_waitcnt lgkmcnt(" #n ")" ::: "memory")
#define PG8_BAR __builtin_amdgcn_s_barrier()
#define PG8_SCHED __builtin_amdgcn_sched_barrier(0)
    Unit cur, nxt; int ui = 0;
    if (!S.next(0, cur)) return;
    f32x4 acc[2][2][4][2];
#pragma unroll
    for (int a = 0; a < 2; ++a)
#pragma unroll
        for (int b = 0; b < 2; ++b)
#pragma unroll
            for (int m = 0; m < 4; ++m)
#pragma unroll
                for (int n = 0; n < 2; ++n) acc[a][b][m][n] = (f32x4){0.f, 0.f, 0.f, 0.f};
    bf16x8 At[4][2], B0[2][2], B1[2][2];
    const char* cA = PG8_ABASE(cur.pm) + (size_t)cur.kc * g.kcb; const char* cB = (const char*)g.Bt + (size_t)cur.pn * tstep + (size_t)cur.kc * g.kcb;
    S.a_ready(cur);
    if constexpr (SP2) {
        PG8_STAGE(PG8_SB(0, 0), cB, voffB); PG8_STAGE(PG8_SB(0, 1), cB + hstep, voffB); PG8_STAGE(PG8_SA(0, 0), cA, voffA); PG8_STAGE(PG8_SA(0, 1), cA + hstep, voffA);
        if (wr == 1) PG8_BAR;
        PG8_WAIT_V(2); PG8_BAR;
        PG8_STAGE(PG8_SB(1, 0), cB + kstep, voffB); PG8_STAGE(PG8_SA(1, 0), cA + kstep, voffA); PG8_STAGE(PG8_SB(1, 1), cB + hstep + kstep, voffB);
        PG8_WAIT_V(6); PG8_BAR;
    } else {
        PG8_STAGE(PG8_SB(0, 0), cB, voffB); PG8_STAGE(PG8_SA(0, 0), cA, voffA); PG8_STAGE(PG8_SB(0, 1), cB + hstep, voffB); PG8_STAGE(PG8_SA(0, 1), cA + hstep, voffA);
        if (wr == 1) PG8_BAR;
        PG8_WAIT_V(4); PG8_BAR;
        PG8_STAGE(PG8_SB(1, 0), cB + kstep, voffB); PG8_STAGE(PG8_SA(1, 0), cA + kstep, voffA); PG8_STAGE(PG8_SB(1, 1), cB + hstep + kstep, voffB);
        PG8_WAIT_V(6); PG8_BAR;
    }
    for (;;) {
        const bool has_next = S.next(ui + 1, nxt);
        const char* nA = has_next ? PG8_ABASE(nxt.pm) + (size_t)nxt.kc * g.kcb : cA; const char* nB = has_next ? (const char*)g.Bt + (size_t)nxt.pn * tstep + (size_t)nxt.kc * g.kcb : cB;
        for (int t = 0; t < nt; t += 2) {
            const bool last = (t == nt - 2);
            const char* a1 = cA + (size_t)(t + 1) * kstep;
            const char* a2 = last ? nA : cA + (size_t)(t + 2) * kstep; const char* b2 = last ? nB : cB + (size_t)(t + 2) * kstep;
            const char* a3 = a2 + kstep; const char* b3 = b2 + kstep;
            if (last && has_next) S.a_ready(nxt);
            if constexpr (SP2) {
            PG8_LDB(B0, 0, 0); PG8_LDB(B1, 0, 1); PG8_SCHED; PG8_LDA(At, 0, 0); PG8_STAGE(PG8_SA(1, 1), a1 + hstep, voffA);
            PG8_WAIT_V(8); PG8_WAIT_L(0); PG8_BAR; PG8_MMA(0, 0, At, B0); PG8_MMA(0, 1, At, B1); PG8_BAR; PG8_SCHED;
            PG8_LDA(At, 0, 1); PG8_STAGE(PG8_SB(0, 0), b2, voffB); PG8_STAGE(PG8_SB(0, 1), b2 + hstep, voffB); PG8_STAGE(PG8_SA(0, 0), a2, voffA);
            PG8_WAIT_V(8); PG8_WAIT_L(0); PG8_BAR; PG8_MMA(1, 0, At, B0); PG8_MMA(1, 1, At, B1); PG8_BAR; PG8_SCHED;
            PG8_LDB(B0, 1, 0); PG8_LDB(B1, 1, 1); PG8_SCHED; PG8_LDA(At, 1, 0); PG8_STAGE(PG8_SA(0, 1), a2 + hstep, voffA);
            PG8_WAIT_V(8); PG8_WAIT_L(0); PG8_BAR; PG8_MMA(0, 0, At, B0); PG8_MMA(0, 1, At, B1); PG8_BAR; PG8_SCHED;
            PG8_LDA(At, 1, 1); PG8_STAGE(PG8_SB(1, 0), b3, voffB); PG8_STAGE(PG8_SB(1, 1), b3 + hstep, voffB); PG8_STAGE(PG8_SA(1, 0), a3, voffA);
            PG8_WAIT_V(8); PG8_WAIT_L(0); PG8_BAR; PG8_MMA(1, 0, At, B0); PG8_MMA(1, 1, At, B1); PG8_BAR; PG8_SCHED;
            } else {
            PG8_LDB(B0, 0, 0); PG8_SCHED; PG8_LDA(At, 0, 0); PG8_STAGE(PG8_SA(1, 1), a1 + hstep, voffA);
            PG8_WAIT_L(8); PG8_BAR; PG8_WAIT_L(0); PG8_MMA(0, 0, At, B0); PG8_BAR; PG8_SCHED;
            PG8_LDB(B1, 0, 1); PG8_STAGE(PG8_SB(0, 0), b2, voffB);
            PG8_BAR; PG8_WAIT_L(0); PG8_MMA(0, 1, At, B1); PG8_BAR;
            PG8_LDA(At, 0, 1); PG8_STAGE(PG8_SA(0, 0), a2, voffA);
            PG8_BAR; PG8_WAIT_L(0); PG8_MMA(1, 0, At, B0); PG8_BAR; PG8_SCHED;
            PG8_STAGE(PG8_SB(0, 1), b2 + hstep, voffB);
            PG8_WAIT_V(6); PG8_BAR; PG8_MMA(1, 1, At, B1); PG8_BAR;
            PG8_LDB(B0, 1, 0); PG8_SCHED; PG8_LDA(At, 1, 0); PG8_STAGE(PG8_SA(0, 1), a2 + hstep, voffA);
            PG8_WAIT_L(8); PG8_BAR; PG8_WAIT_L(0); PG8_MMA(0, 0, At, B0); PG8_BAR; PG8_SCHED;
            PG8_LDB(B1, 1, 1); PG8_STAGE(PG8_SB(1, 0), b3, voffB);
            PG8_BAR; PG8_WAIT_L(0); PG8_MMA(0, 1, At, B1); PG8_BAR;
            PG8_LDA(At, 1, 1); PG8_STAGE(PG8_SA(1, 0), a3, voffA);
            PG8_BAR; PG8_WAIT_L(0); PG8_MMA(1, 0, At, B0); PG8_BAR; PG8_SCHED;
            PG8_STAGE(PG8_SB(1, 1), b3 + hstep, voffB);
            PG8_WAIT_V(6); PG8_BAR; PG8_MMA(1, 1, At, B1); PG8_BAR;
            }
        }
        if constexpr (ALIGN_EPI) { if (wr == 0) PG8_BAR; }
        if constexpr (!Epi::AFTER_DRAIN) { E(acc, cur, wr, wc, fr, fq); S.done(cur); }
        if (!has_next) break;
#pragma unroll
        for (int a = 0; a < 2; ++a)
#pragma unroll
            for (int b = 0; b < 2; ++b)
#pragma unroll
                for (int m = 0; m < 4; ++m)
#pragma unroll
                    for (int n = 0; n < 2; ++n) acc[a][b][m][n] = (f32x4){0.f, 0.f, 0.f, 0.f};
        cur = nxt; cA = nA; cB = nB; ++ui;
        if constexpr (ALIGN_EPI) { if (wr == 1) PG8_BAR; }
    }
    PG8_WAIT_V(0);
    if constexpr (!ALIGN_EPI) { if (wr == 0) PG8_BAR; }
    PG8_BAR;
    if constexpr (Epi::AFTER_DRAIN) { E.fused(acc, cur, wr, wc, fr, fq, lds, wid, lane); S.done(cur); }
#undef PG8_SA
#undef PG8_ABASE
#undef PG8_SB
#undef PG8_STAGE
#undef PG8_LDA
#undef PG8_LDB
#undef PG8_MMA
#undef PG8_WAIT_V
#undef PG8_WAIT_L
#undef PG8_BAR
#undef PG8_SCHED
}
}
namespace pg8 {
typedef float f32x2_t __attribute__((ext_vector_type(2))); typedef __bf16 bf16x2_t __attribute__((ext_vector_type(2)));
__device__ __forceinline__ unsigned cvtpk_hw(float lo, float hi) { f32x2_t v = {lo, hi}; bf16x2_t b = __builtin_convertvector(v, bf16x2_t); return __builtin_bit_cast(unsigned, b); }
__device__ __forceinline__ unsigned short f2bf_rne(float f) { return (unsigned short)(cvtpk_hw(f, 0.f) & 0xffffu); }
struct EpiL0 {
    static constexpr bool PERM = true, AFTER_DRAIN = false;
    bf16_t* xvt_lat; bf16_t* xvt_ctx; bf16_t* qkvg; const float* qn; const float* kn; PG8_LAS float* xch;
    __device__ __forceinline__ void operator()(f32x4 (&acc)[2][2][4][2], const Unit& u, int wr, int wc, int fr, int fq) const {
        if (u.pn >= 16 && u.pn <= 20) {
            const float* gw = u.pn < 20 ? qn : kn; const bool lat = u.pm < 64;
#pragma unroll
            for (int ai = 0; ai < 2; ++ai)
#pragma unroll
                for (int m = 0; m < 4; ++m)
#pragma unroll
                    for (int bj = 0; bj < 2; ++bj) { const f32x4 v0 = acc[ai][bj][m][0], v1 = acc[ai][bj][m][1];
                        float ss = (v0[0] * v0[0] + v0[1] * v0[1]) + (v0[2] * v0[2] + v0[3] * v0[3]) + (v1[0] * v1[0] + v1[1] * v1[1]) + (v1[2] * v1[2] + v1[3] * v1[3]);
                        ss += __shfl_xor(ss, 16); ss += __shfl_xor(ss, 32);
                        if (fq == 0) xch[((ai * HALF + wr * 64 + m * 16 + fr) * 2 + bj) * 4 + wc] = ss; }
            asm volatile("s_waitcnt lgkmcnt(0)" ::: "memory"); __builtin_amdgcn_s_barrier(); asm volatile("" ::: "memory");
            const int kb = 16 * wc + 4 * fq;
            const int ob = wc < 2 ? kb : kb + 32;
            float iv[4];
#pragma unroll
            for (int q = 0; q < 4; ++q) { iv[q] = __builtin_amdgcn_exp2f(-(float)((kb + q) & 31) * (13.287712379549449f / 32.f)) * 0.15915494309189535f; }
            const int row0 = u.pm * BM + wr * 64 + fr; const int col0 = (u.pn - 16) * BM + wc * 32 + 8 * fq;
#pragma unroll
            for (int ai = 0; ai < 2; ++ai)
#pragma unroll
                for (int m = 0; m < 4; ++m) { const int rl = ai * HALF + wr * 64 + m * 16 + fr; const int t = (u.pm * BM + rl) & 4095; const float pos = (float)(wc < 2 ? (t >> 6) : (t & 63));
                    float cs[4], sn[4];
#pragma unroll
                    for (int q = 0; q < 4; ++q) { const float a = pos * iv[q]; cs[q] = lat ? __builtin_amdgcn_cosf(a) : 1.f; sn[q] = lat ? __builtin_amdgcn_sinf(a) : 0.f; }
                    bf16_t* rowp = qkvg + (size_t)(row0 + ai * HALF + m * 16) * 2560 + col0;
                    asm volatile("" ::: "memory");
                    const f32x4 gA = *(const f32x4*)(gw + ob), gB = *(const f32x4*)(gw + ob + 32); const float g1[4] = {gA[0], gA[1], gA[2], gA[3]}, g2[4] = {gB[0], gB[1], gB[2], gB[3]};
#pragma unroll
                    for (int bj = 0; bj < 2; ++bj) { const f32x4 p = *(const PG8_LAS f32x4*)(xch + (rl * 2 + bj) * 4); const float r = __builtin_amdgcn_rsqf(((p[0] + p[1]) + (p[2] + p[3])) * (1.f / 128.f) + 1e-6f);
                        const f32x4 v0 = acc[ai][bj][m][0], v1 = acc[ai][bj][m][1];
                        const float a0 = v0[0] * r * g1[0], b0 = v0[1] * r * g2[0], a1 = v0[2] * r * g1[1], b1 = v0[3] * r * g2[1];
                        const float a2 = v1[0] * r * g1[2], b2 = v1[1] * r * g2[2], a3 = v1[2] * r * g1[3], b3 = v1[3] * r * g2[3];
                        u32x4 w; w.x = cvt_pk_bf16(a0 * cs[0] - b0 * sn[0], a0 * sn[0] + b0 * cs[0]); w.y = cvt_pk_bf16(a1 * cs[1] - b1 * sn[1], a1 * sn[1] + b1 * cs[1]);
                        w.z = cvt_pk_bf16(a2 * cs[2] - b2 * sn[2], a2 * sn[2] + b2 * cs[2]); w.w = cvt_pk_bf16(a3 * cs[3] - b3 * sn[3], a3 * sn[3] + b3 * cs[3]);
                        *(u32x4*)(rowp + bj * HALF) = w; } }
        } else if (u.pn >= 16) {
            const int row0 = u.pm * BM + wr * 64 + fr; const int col0 = (u.pn - 16) * BM + wc * 32 + 8 * fq;
#pragma unroll
            for (int ai = 0; ai < 2; ++ai)
#pragma unroll
                for (int m = 0; m < 4; ++m) { bf16_t* rowp = qkvg + (size_t)(row0 + ai * HALF + m * 16) * 2560 + col0;
#pragma unroll
                    for (int bj = 0; bj < 2; ++bj) { const f32x4 v0 = acc[ai][bj][m][0], v1 = acc[ai][bj][m][1];
                        u32x4 w; w.x = cvt_pk_bf16(v0[0], v0[1]); w.y = cvt_pk_bf16(v0[2], v0[3]); w.z = cvt_pk_bf16(v1[0], v1[1]); w.w = cvt_pk_bf16(v1[2], v1[3]);
                        *(u32x4*)(rowp + bj * HALF) = w; } }
        } else {
            bf16_t* dst; int nt, t0;
            if (u.pm < 64) { const int b = u.pm >> 4; nt = 4096; t0 = (u.pm & 15) * 256; dst = xvt_lat + (size_t)b * 4096 * 4096; }
            else { const int b = u.pm - 64; nt = 256; t0 = 0; dst = xvt_ctx + (size_t)b * 4096 * 256; }
            const int ch0 = u.pn * BM + wc * 32 + 8 * fq; const int tl0 = t0 + wr * 64 + fr;
#pragma unroll
            for (int bj = 0; bj < 2; ++bj)
#pragma unroll
                for (int n = 0; n < 2; ++n)
#pragma unroll
                    for (int j = 0; j < 4; ++j) { bf16_t* cp = dst + (size_t)(ch0 + bj * HALF + 4 * n + j) * nt + tl0;
#pragma unroll
                        for (int ai = 0; ai < 2; ++ai)
#pragma unroll
                            for (int m = 0; m < 4; ++m) cp[ai * HALF + m * 16] = f2bf_rne(acc[ai][bj][m][n][j]); }
        }
    }
};
struct EpiL1a {
    static constexpr bool PERM = true, AFTER_DRAIN = false;
    bf16_t* y; float* gates; const float* gate_b;
    __device__ __forceinline__ void operator()(const f32x4 (&acc)[2][2][4][2], const Unit& u, int wr, int wc, int fr, int fq) const {
        const int row0 = u.pm * BM + wr * 64 + fr;
        if (u.pn < 16) {
            const int col0 = u.pn * BM + wc * 32 + 8 * fq;
#pragma unroll
            for (int ai = 0; ai < 2; ++ai)
#pragma unroll
                for (int m = 0; m < 4; ++m) { bf16_t* rowp = y + (size_t)(row0 + ai * HALF + m * 16) * 4096 + col0;
#pragma unroll
                    for (int bj = 0; bj < 2; ++bj) { const f32x4 v0 = acc[ai][bj][m][0], v1 = acc[ai][bj][m][1];
                        u32x4 w; w.x = cvt_pk_bf16(v0[0], v0[1]); w.y = cvt_pk_bf16(v0[2], v0[3]); w.z = cvt_pk_bf16(v1[0], v1[1]); w.w = cvt_pk_bf16(v1[2], v1[3]);
                        *(u32x4*)(rowp + bj * HALF) = w; } }
        } else if (wc == 0) {
            const int c0 = 8 * fq;
            const f32x4 b0 = *(const f32x4*)(gate_b + c0), b1 = *(const f32x4*)(gate_b + c0 + 4);
#pragma unroll
            for (int ai = 0; ai < 2; ++ai)
#pragma unroll
                for (int m = 0; m < 4; ++m) { float* rowp = gates + (size_t)(row0 + ai * HALF + m * 16) * 32 + c0;
                    *(f32x4*)(rowp) = acc[ai][0][m][0] + b0; *(f32x4*)(rowp + 4) = acc[ai][0][m][1] + b1; }
        }
    }
};
struct EpiF32Slab {
    static constexpr bool PERM = false, AFTER_DRAIN = false;
    float* C; int ldc; size_t slab;
    __device__ __forceinline__ void operator()(const f32x4 (&acc)[2][2][4][2], const Unit& u, int wr, int wc, int fr, int fq) const {
        const int row0 = u.pm * BM + wr * 64 + fr, col0 = u.pn * BM + wc * 32 + 4 * fq; float* Cs = C + (size_t)u.kc * slab;
#pragma unroll
        for (int ai = 0; ai < 2; ++ai)
#pragma unroll
            for (int m = 0; m < 4; ++m) { float* rowp = Cs + (size_t)(row0 + ai * HALF + m * 16) * ldc + col0;
#pragma unroll
                for (int bj = 0; bj < 2; ++bj)
#pragma unroll
                    for (int n = 0; n < 2; ++n) *(f32x4*)(rowp + bj * HALF + n * 16) = acc[ai][bj][m][n]; }
    }
};
struct SplitKOrder {
    int G, c;
    __device__ bool next(int i, Unit& u) const { const int L = i * G + c; if (L >= 128) return false; u.kc = L & 7; u.pm = (L >> 3) >> 2; u.pn = (L >> 3) & 3; return true; }
    __device__ __forceinline__ void a_ready(const Unit&) const {}
    __device__ __forceinline__ void done(const Unit&) const {}
};
}

namespace pg8 {
struct EpiOZ {
    static constexpr bool PERM = true, AFTER_DRAIN = false;
    bf16_t* hb; const float* hn; PG8_LAS float* xch;
    __device__ __forceinline__ static float bflo(unsigned w) { return __builtin_bit_cast(float, w << 16); }
    __device__ __forceinline__ static float bfhi(unsigned w) { return __builtin_bit_cast(float, w & 0xffff0000u); }
    __device__ __forceinline__ void operator()(f32x4 (&acc)[2][2][4][2], const Unit& u, int wr, int wc, int fr, int fq) const {
        const int row0 = u.pm * BM + wr * 64 + fr;
        if (u.pn < 8) {
            const int col0 = u.pn * BM + wc * 32 + 8 * fq;
#pragma unroll
            for (int ai = 0; ai < 2; ++ai)
#pragma unroll
                for (int m = 0; m < 4; ++m) { const bf16_t* rowp = hb + (size_t)(row0 + ai * HALF + m * 16) * 2048 + col0; float ss = 0.f;
#pragma unroll
                    for (int bj = 0; bj < 2; ++bj) { const u32x4 hv = *(const u32x4*)(rowp + bj * HALF); f32x4& v0 = acc[ai][bj][m][0]; f32x4& v1 = acc[ai][bj][m][1];
                        v0[0] = bflo(hv.x) * __builtin_amdgcn_rcpf(1.f + __expf(-v0[0])); v0[1] = bfhi(hv.x) * __builtin_amdgcn_rcpf(1.f + __expf(-v0[1])); v0[2] = bflo(hv.y) * __builtin_amdgcn_rcpf(1.f + __expf(-v0[2])); v0[3] = bfhi(hv.y) * __builtin_amdgcn_rcpf(1.f + __expf(-v0[3]));
                        v1[0] = bflo(hv.z) * __builtin_amdgcn_rcpf(1.f + __expf(-v1[0])); v1[1] = bfhi(hv.z) * __builtin_amdgcn_rcpf(1.f + __expf(-v1[1])); v1[2] = bflo(hv.w) * __builtin_amdgcn_rcpf(1.f + __expf(-v1[2])); v1[3] = bfhi(hv.w) * __builtin_amdgcn_rcpf(1.f + __expf(-v1[3]));
                        ss += (v0[0] * v0[0] + v0[1] * v0[1]) + (v0[2] * v0[2] + v0[3] * v0[3]) + (v1[0] * v1[0] + v1[1] * v1[1]) + (v1[2] * v1[2] + v1[3] * v1[3]); }
                    ss += __shfl_xor(ss, 16); ss += __shfl_xor(ss, 32);
                    if (fq == 0) xch[(ai * HALF + wr * 64 + m * 16 + fr) * 4 + wc] = ss; }
            asm volatile("s_waitcnt lgkmcnt(0)" ::: "memory"); __builtin_amdgcn_s_barrier(); asm volatile("" ::: "memory");
#pragma unroll
            for (int bj = 0; bj < 2; ++bj) { const f32x4 g0 = *(const f32x4*)(hn + col0 + bj * HALF), g1 = *(const f32x4*)(hn + col0 + bj * HALF + 4);
#pragma unroll
                for (int ai = 0; ai < 2; ++ai)
#pragma unroll
                    for (int m = 0; m < 4; ++m) { const int rl = ai * HALF + wr * 64 + m * 16 + fr; const f32x4 p = *(const PG8_LAS f32x4*)(xch + rl * 4);
                        const float r = __builtin_amdgcn_rsqf(((p[0] + p[1]) + (p[2] + p[3])) * (1.f / 256.f) + 1e-6f);
                        bf16_t* rowp = hb + (size_t)(row0 + ai * HALF + m * 16) * 2048 + col0;
                        const f32x4 v0 = acc[ai][bj][m][0] * r * g0, v1 = acc[ai][bj][m][1] * r * g1;
                        u32x4 w; w.x = cvt_pk_bf16(v0[0], v0[1]); w.y = cvt_pk_bf16(v0[2], v0[3]); w.z = cvt_pk_bf16(v1[0], v1[1]); w.w = cvt_pk_bf16(v1[2], v1[3]);
                        *(u32x4*)(rowp + bj * HALF) = w; } }
        } else {
            const int col0 = (u.pn - 8) * BM + wc * 32 + 8 * fq;
#pragma unroll
            for (int ai = 0; ai < 2; ++ai)
#pragma unroll
                for (int m = 0; m < 4; ++m) { bf16_t* rowp = hb + (size_t)(row0 + ai * HALF + m * 16) * 2048 + col0;
                    const u32x4 hq[2] = {*(const u32x4*)rowp, *(const u32x4*)(rowp + HALF)};
#pragma unroll
                    for (int bj = 0; bj < 2; ++bj) { const u32x4 hv = hq[bj]; const f32x4 a0 = acc[ai][bj][m][0], a1 = acc[ai][bj][m][1];
                        u32x4 w; w.x = cvt_pk_bf16(bflo(hv.x) * a0[0] * __builtin_amdgcn_rcpf(1.f + __expf(-a0[0])), bfhi(hv.x) * a0[1] * __builtin_amdgcn_rcpf(1.f + __expf(-a0[1])));
                        w.y = cvt_pk_bf16(bflo(hv.y) * a0[2] * __builtin_amdgcn_rcpf(1.f + __expf(-a0[2])), bfhi(hv.y) * a0[3] * __builtin_amdgcn_rcpf(1.f + __expf(-a0[3])));
                        w.z = cvt_pk_bf16(bflo(hv.z) * a1[0] * __builtin_amdgcn_rcpf(1.f + __expf(-a1[0])), bfhi(hv.z) * a1[1] * __builtin_amdgcn_rcpf(1.f + __expf(-a1[1])));
                        w.w = cvt_pk_bf16(bflo(hv.w) * a1[2] * __builtin_amdgcn_rcpf(1.f + __expf(-a1[2])), bfhi(hv.w) * a1[3] * __builtin_amdgcn_rcpf(1.f + __expf(-a1[3])));
                        *(u32x4*)(rowp + bj * HALF) = w; } }
        }
    }
};
struct PairOrder {
    int G, c;
    __device__ bool next(int i, Unit& u) const { const int r = i >> 1; if (r >= 512 / G) return false; const int x = c & 7, y = c >> 3, head = y & 7; u.pm = r * (G >> 3) + x * (G >> 6) + (y >> 3); u.pn = (i & 1) ? 8 + head : head; u.kc = 0; return true; }
    __device__ __forceinline__ void a_ready(const Unit&) const {}
    __device__ __forceinline__ void done(const Unit&) const {}
};
}
namespace attn {
using bf16 = unsigned short;
constexpr int D = 128, NW = 8, QBLK = 32, KVBLK = 64;
constexpr float SCALE = 0.088388347648318440f;
constexpr float THR = 8.f;
constexpr int SDEPTH = 2;
constexpr int LDQ = 2560, LDK = 2560, LDO = 2048, VOFF = 256, GOFF = 1536;
constexpr size_t SHM_V = KVBLK * D * 2, SHM_K = KVBLK * D * 2, SHM_ATTN = 2 * SHM_V + 2 * SHM_K + NW * 64 * 4;
using bf16x8 = __attribute__((ext_vector_type(8))) short;
using s16x4  = __attribute__((ext_vector_type(4))) short;
using f32x16 = __attribute__((ext_vector_type(16))) float;
using u32x4  = __attribute__((ext_vector_type(4))) unsigned;
#define KSWZ(row, colB) ((row) * 256 + ((colB) ^ (((row) & 7) << 4)))
#define SBAR() __builtin_amdgcn_sched_barrier(0)
__device__ __forceinline__ int crow(int r, int hi) { return (r & 3) + 8 * (r >> 2) + 4 * hi; }
__device__ __forceinline__ unsigned cvtpk(float lo, float hi) { unsigned r; asm volatile("v_cvt_pk_bf16_f32 %0, %1, %2" : "=v"(r) : "v"(lo), "v"(hi)); return r; }
__device__ __forceinline__ bf16x8 ld8(const bf16* p) { return *reinterpret_cast<const bf16x8*>(p); }
__device__ __forceinline__ void partialSM(f32x16& p0, f32x16& p1, float& m_reg, float& mn, float& alpha) {
  constexpr float C = SCALE * 1.4426950408889634f;
  float pmax = p0[0]; for (int r = 1; r < 16; ++r) pmax = fmaxf(pmax, p0[r]); for (int r = 0; r < 16; ++r) pmax = fmaxf(pmax, p1[r]);
  { auto rr = __builtin_amdgcn_permlane32_swap(__float_as_uint(pmax), __float_as_uint(pmax), false, false);
    pmax = fmaxf(__uint_as_float(rr[0]), __uint_as_float(rr[1])); }
  if (__builtin_expect(__all(pmax - m_reg <= THR / SCALE), 1)) { mn = m_reg; alpha = 1.f; }
  else { mn = fmaxf(m_reg, pmax); alpha = __builtin_amdgcn_exp2f((m_reg - mn) * C); m_reg = mn; }
  float mnC = -mn * C;
  for (int r = 0; r < 16; ++r) p0[r] = fmaf(p0[r], C, mnC); for (int r = 0; r < 16; ++r) p1[r] = fmaf(p1[r], C, mnC);
  for (int r = 0; r < 16; ++r) p0[r] = __builtin_amdgcn_exp2f(p0[r]);
}
__device__ __forceinline__ void finishSM(f32x16& p0, f32x16& p1, float alpha, float& l_reg, bf16x8& pa0, bf16x8& pa1, bf16x8& pa2, bf16x8& pa3) {
  for (int r = 0; r < 16; ++r) p1[r] = __builtin_amdgcn_exp2f(p1[r]);
  float ps = 0; for (int r = 0; r < 16; ++r) ps += p0[r]; for (int r = 0; r < 16; ++r) ps += p1[r];
  { auto rr = __builtin_amdgcn_permlane32_swap(__float_as_uint(ps), __float_as_uint(ps), false, false);
    ps = __uint_as_float(rr[0]) + __uint_as_float(rr[1]); }
  l_reg = l_reg * alpha + ps;
#define PK4(P, BASE, OUT) do { unsigned a0 = cvtpk(P[BASE + 0], P[BASE + 1]), a1 = cvtpk(P[BASE + 2], P[BASE + 3]);   \
    unsigned b0 = cvtpk(P[BASE + 4], P[BASE + 5]), b1 = cvtpk(P[BASE + 6], P[BASE + 7]);                              \
    auto r0 = __builtin_amdgcn_permlane32_swap(a0, b0, false, false); auto r1 = __builtin_amdgcn_permlane32_swap(a1, b1, false, false); \
    u32x4 w = {r0[0], r1[0], r0[1], r1[1]}; OUT = *reinterpret_cast<bf16x8*>(&w); } while (0)
  PK4(p0, 0, pa0); PK4(p0, 8, pa1); PK4(p1, 0, pa2); PK4(p1, 8, pa3);
#undef PK4
}
__device__ __forceinline__ void qkt(f32x16& p0, f32x16& p1, const bf16* Ks, const bf16x8* qr, int r32, int hi) {
  p0 = f32x16{}; p1 = f32x16{};
  for (int d0 = 0; d0 < 8; ++d0) { int cb = (d0 * 16 + hi * 8) * 2;
    bf16x8 b0 = *reinterpret_cast<const bf16x8*>((const char*)Ks + KSWZ(r32, cb));
    bf16x8 b1 = *reinterpret_cast<const bf16x8*>((const char*)Ks + KSWZ(32 + r32, cb));
    p0 = __builtin_amdgcn_mfma_f32_32x32x16_bf16(b0, qr[d0], p0, 0, 0, 0);
    p1 = __builtin_amdgcn_mfma_f32_32x32x16_bf16(b1, qr[d0], p1, 0, 0, 0); }
}
__device__ __forceinline__ int v_st(int k, int c) { const int kk = (k & ~0xC) | ((k & 4) << 1) | ((k & 8) >> 1); return ((kk >> 3) * 4 + (c >> 5)) * 512 + ((kk & 7) * 32 + (c & 31)) * 2; }
__device__ __forceinline__ int v_rd_base(int lane) { return ((lane & 3) << 3) | (((lane >> 2) & 3) << 6) | (((lane >> 4) & 1) << 5) | (((lane >> 5) & 1) << 8); }
constexpr int v_rd_off(int d0, int ks, int half) { return d0 * 512 + ks * 4096 + half * 2048; }
template <int OFF> __device__ __forceinline__ s16x4 tr_read(int vb) {
  s16x4 r; asm volatile("ds_read_b64_tr_b16 %0, %1 offset:%2" : "=&v"(r) : "v"(vb), "i"(OFF) : "memory"); return r;
}
template <int D0> __device__ __forceinline__ void pv_one(f32x16& od, int vb, bf16x8 pa0, bf16x8 pa1, bf16x8 pa2, bf16x8 pa3) {
  const s16x4 l0 = tr_read<v_rd_off(D0, 0, 0)>(vb), h0 = tr_read<v_rd_off(D0, 0, 1)>(vb), l1 = tr_read<v_rd_off(D0, 1, 0)>(vb), h1 = tr_read<v_rd_off(D0, 1, 1)>(vb);
  const s16x4 l2 = tr_read<v_rd_off(D0, 2, 0)>(vb), h2 = tr_read<v_rd_off(D0, 2, 1)>(vb), l3 = tr_read<v_rd_off(D0, 3, 0)>(vb), h3 = tr_read<v_rd_off(D0, 3, 1)>(vb);
  asm volatile("s_waitcnt lgkmcnt(0)" ::: "memory"); SBAR();
#define PK(L, H) (bf16x8){L[0], L[1], L[2], L[3], H[0], H[1], H[2], H[3]}
  od = __builtin_amdgcn_mfma_f32_32x32x16_bf16(pa0, PK(l0, h0), od, 0, 0, 0);
  od = __builtin_amdgcn_mfma_f32_32x32x16_bf16(pa1, PK(l1, h1), od, 0, 0, 0);
  od = __builtin_amdgcn_mfma_f32_32x32x16_bf16(pa2, PK(l2, h2), od, 0, 0, 0);
  od = __builtin_amdgcn_mfma_f32_32x32x16_bf16(pa3, PK(l3, h3), od, 0, 0, 0);
#undef PK
}
__device__ __forceinline__ void pv_d0(f32x16* o, int vb, bf16x8 pa0, bf16x8 pa1, bf16x8 pa2, bf16x8 pa3) {
  pv_one<0>(o[0], vb, pa0, pa1, pa2, pa3); pv_one<1>(o[1], vb, pa0, pa1, pa2, pa3); pv_one<2>(o[2], vb, pa0, pa1, pa2, pa3); pv_one<3>(o[3], vb, pa0, pa1, pa2, pa3);
}
__device__ __forceinline__ void attn_dense_body(const bf16* __restrict__ Qb, __amdgpu_buffer_rsrc_t kvrs, unsigned kb0, unsigned kb1, int seg0, const bf16* __restrict__ Gb,
                                                bf16* __restrict__ Ob, int seq, char* lds, int wrows = QBLK) {
  int tid_ = threadIdx.x; asm volatile("" : "+v"(tid_));
  const int tid = tid_, wid = tid >> 6, lane = tid & 63, r32 = lane & 31, hi = lane >> 5;
  bf16* V_lds = (bf16*)lds; bf16* K_lds = (bf16*)(lds + 2 * SHM_V);
  float* ws = (float*)(lds + 2 * SHM_V + 2 * SHM_K) + wid * 64; float* li_l = ws; float* al_l = ws + 32;
  float m_reg = -1e30f, l_reg = 0; f32x16 o[4] = {}; bf16x8 qr[8];
  const bf16* Qw = Qb + (long)(wid * wrows + r32) * LDQ + hi * 8;
#pragma unroll
  for (int d0 = 0; d0 < 8; ++d0) qr[d0] = ld8(Qw + d0 * 16);
  const int sr = tid >> 4, sc = (tid & 15) * 8, vst0 = v_st(sr, sc), vst1 = v_st(32 + sr, sc);
  const int vb0 = (int)(uintptr_t)V_lds + v_rd_base(lane);
  struct { bf16x8 vs0, vs1, ks0, ks1; } sr_[SDEPTH];
  const unsigned vo0 = (unsigned)(sr * LDK + sc) * 2u, vo1 = (unsigned)((32 + sr) * LDK + sc) * 2u;
#define BLD(vo, so) __builtin_bit_cast(bf16x8, __builtin_amdgcn_raw_buffer_load_b128(kvrs, (int)(vo), (int)(so), 0))
#define SLOAD(i, k0) do { const unsigned so_ = ((k0) < seg0) ? kb0 + (unsigned)(k0) * (LDK * 2) : kb1 + (unsigned)((k0) - seg0) * (LDK * 2); \
    sr_[i].vs0 = BLD(vo0 + VOFF * 2, so_); sr_[i].vs1 = BLD(vo1 + VOFF * 2, so_); \
    sr_[i].ks0 = BLD(vo0, so_); sr_[i].ks1 = BLD(vo1, so_); } while (0)
#define SWRITE(b, i) do { *(bf16x8*)((char*)V_lds + (b) * SHM_V + vst0) = sr_[i].vs0;          \
    *(bf16x8*)((char*)V_lds + (b) * SHM_V + vst1) = sr_[i].vs1; int kc = sc * 2;               \
    *(bf16x8*)((char*)K_lds + (b) * SHM_K + KSWZ(sr, kc)) = sr_[i].ks0;                       \
    *(bf16x8*)((char*)K_lds + (b) * SHM_K + KSWZ(32 + sr, kc)) = sr_[i].ks1; } while (0)
#define SWAIT() do { if constexpr (SDEPTH == 2) asm volatile("s_waitcnt vmcnt(4)" ::: "memory"); else asm volatile("s_waitcnt vmcnt(0)" ::: "memory"); } while (0)
#define RESC(a) do { if (__any((a) < 1.f)) { if (hi == 0) al_l[r32] = (a); asm volatile("s_waitcnt lgkmcnt(0)" ::: "memory"); \
    for (int d = 0; d < 4; ++d) for (int r = 0; r < 16; ++r) o[d][r] *= al_l[crow(r, hi)]; } } while (0)
  f32x16 pA0, pA1, pB0, pB1; float mnA, mnB, alA, alB; bf16x8 pa0, pa1, pa2, pa3; const int NT = seq / KVBLK;
  constexpr int SE = 0, SO = SDEPTH - 1;
  SLOAD(SE, 0); asm volatile("s_waitcnt vmcnt(0)" ::: "memory"); SWRITE(0, SE); __syncthreads();
  qkt(pA0, pA1, K_lds, qr, r32, hi); partialSM(pA0, pA1, m_reg, mnA, alA);
  SLOAD(SO, KVBLK); if constexpr (SDEPTH == 2) { if (2 < NT) SLOAD(SE, 2 * KVBLK); }
  SWAIT(); SWRITE(1, SO); __syncthreads();
  for (int j = 1; j + 1 < NT; j += 2) {
    SBAR(); qkt(pB0, pB1, (bf16*)((char*)K_lds + SHM_K), qr, r32, hi);
    finishSM(pA0, pA1, alA, l_reg, pa0, pa1, pa2, pa3); SBAR();
    SLOAD(SO, (j + SDEPTH) * KVBLK); SBAR();
    pv_d0(o, vb0, pa0, pa1, pa2, pa3); partialSM(pB0, pB1, m_reg, mnB, alB);
    __syncthreads(); SWAIT(); SWRITE(0, SE);
    RESC(alB); __syncthreads();
    SBAR(); qkt(pA0, pA1, K_lds, qr, r32, hi);
    finishSM(pB0, pB1, alB, l_reg, pa0, pa1, pa2, pa3); SBAR();
    if (SDEPTH == 1 || j + 3 < NT) SLOAD(SE, (j + 1 + SDEPTH) * KVBLK); SBAR();
    pv_d0(o, vb0 + (int)SHM_V, pa0, pa1, pa2, pa3); partialSM(pA0, pA1, m_reg, mnA, alA);
    __syncthreads(); SWAIT(); SWRITE(1, SO);
    RESC(alA); __syncthreads();
  }
  SBAR(); qkt(pB0, pB1, (bf16*)((char*)K_lds + SHM_K), qr, r32, hi);
  finishSM(pA0, pA1, alA, l_reg, pa0, pa1, pa2, pa3); SBAR();
  pv_d0(o, vb0, pa0, pa1, pa2, pa3); partialSM(pB0, pB1, m_reg, mnB, alB);
  __syncthreads(); RESC(alB);
  finishSM(pB0, pB1, alB, l_reg, pa0, pa1, pa2, pa3); SBAR();
  pv_d0(o, vb0 + (int)SHM_V, pa0, pa1, pa2, pa3);
  if (hi == 0) li_l[r32] = l_reg; asm volatile("s_waitcnt lgkmcnt(0)" ::: "memory");
  float rli[16];
#pragma unroll
  for (int r = 0; r < 16; ++r) rli[r] = __builtin_amdgcn_rcpf(li_l[crow(r, hi)]);
  bf16* Ow = Ob + (long)(wid * wrows) * LDO; const bf16* Gw = Gb + (long)(wid * wrows) * LDQ;
  asm volatile("" ::: "memory"); SBAR();
#pragma unroll
  for (int rh = 0; rh < 2; ++rh) {
    unsigned short gv[8][4];
#pragma unroll
    for (int r8 = 0; r8 < 8; ++r8) { const int orow = crow(rh * 8 + r8, hi);
#pragma unroll
      for (int d0 = 0; d0 < 4; ++d0) gv[r8][d0] = Gw[(long)orow * LDQ + d0 * 32 + r32]; }
    asm volatile("" ::: "memory");
#pragma unroll
    for (int r8 = 0; r8 < 8; ++r8) { const int r = rh * 8 + r8; const int orow = crow(r, hi);
#pragma unroll
      for (int d0 = 0; d0 < 4; ++d0) { const float gt = __uint_as_float((unsigned)gv[r8][d0] << 16);
        const float val = o[d0][r] * rli[r] * (gt * __builtin_amdgcn_rcpf(1.f + __expf(-gt)));
        Ow[(long)orow * LDO + d0 * 32 + r32] = pg8::f2bf_rne(val); } }
    asm volatile("" ::: "memory"); }
  __syncthreads();
#undef SLOAD
#undef BLD
#undef SWRITE
#undef SWAIT
#undef RESC
}
#undef KSWZ
#undef SBAR
}
#define LAS __attribute__((address_space(3)))
typedef unsigned short bf16_t;
typedef float f32x4 __attribute__((ext_vector_type(4)));
typedef float f32x2 __attribute__((ext_vector_type(2)));
typedef short bf16x8 __attribute__((ext_vector_type(8)));
typedef unsigned u32x2 __attribute__((ext_vector_type(2)));
constexpr int DM = 1024, NB = 4, SEQ = 4096, CTXL = 256, MLAT = NB * SEQ, MCTX = NB * CTXL, MTOT = MLAT + MCTX;
constexpr float EPS = 1e-6f;
constexpr size_t MiB = 1u << 20;
constexpr size_t WS_CTL = 0, CTL_ZERO_BYTES = 256 * 1024, WS_MODS = 65536, WS_HDN = 512 * 1024, WS_GATES = 2 * MiB;
constexpr size_t WS_W0IN = 5 * MiB, WS_W0OUT = 18 * MiB, WS_QKVG = 22 * MiB, WS_XVTL = 107 * MiB, WS_XVTC = 235 * MiB, WS_A2C = 243 * MiB, WS_Y0 = 100 * MiB;
constexpr size_t WS_W1OUT = 5 * MiB, WS_W1B = 9 * MiB, WS_H1 = 17 * MiB, WS_Y1A = 51 * MiB, WS_H = 192 * MiB, WS_W1A = 192 * MiB, WS_OZ = 51 * MiB, WS_Y1 = 51 * MiB;
constexpr size_t WS_EST = 17 * MiB, WS_NST = 49 * MiB, WS_PST = 49 * MiB + 512 * 1024;
constexpr size_t WS_CTXE = 192 * MiB, WS_CTXN = 208 * MiB;
constexpr size_t WS_END = 256 * MiB;
constexpr int LDS_BYTES = 147456;
constexpr int NPHASE = 16;

__device__ __forceinline__ float bf2f(unsigned short b) { return __uint_as_float((unsigned)b << 16); }
__device__ __forceinline__ unsigned short f2bf(float f) { return pg8::f2bf_rne(f); }
__device__ __forceinline__ unsigned pk2(float lo, float hi) { return pg8::cvtpk_hw(lo, hi); }
__device__ __forceinline__ float silu_f(float x) { return x * __builtin_amdgcn_rcpf(1.f + __expf(-x)); }
__device__ __forceinline__ float sigm_f(float x) { return __builtin_amdgcn_rcpf(1.f + __expf(-x)); }
template <int CTRL, int ROWMASK> __device__ __forceinline__ float dpp_addf(float v) { return v + __builtin_bit_cast(float, __builtin_amdgcn_update_dpp(0, __builtin_bit_cast(int, v), CTRL, ROWMASK, 0xF, ROWMASK == 0xF)); }
__device__ __forceinline__ float wave_sum(float v) {
    v = dpp_addf<0xB1, 0xF>(v); v = dpp_addf<0x4E, 0xF>(v); v = dpp_addf<0x141, 0xF>(v); v = dpp_addf<0x140, 0xF>(v);
    v = dpp_addf<0x142, 0xA>(v); v = dpp_addf<0x143, 0xC>(v);
    return __builtin_bit_cast(float, __builtin_amdgcn_readlane(__builtin_bit_cast(int, v), 63));
}
#define LDS_WAIT() asm volatile("s_waitcnt lgkmcnt(0)" ::: "memory")

template <bool ROPE_PERM = false>
__device__ __forceinline__ void transpose_item(const float* __restrict__ W, int ldw, int K, int col0, bf16_t* __restrict__ WT, int row0, LAS float* scr, int kb, int lane) {
    const int k0 = 64 * kb; int sc = col0 + (lane & 31);
    if constexpr (ROPE_PERM) { const int p = sc & 127, k = p >> 1, s = p & 1; sc = (sc & ~127) + (k < 32 ? k + 32 * s : k + 32 + 32 * s); }
#pragma unroll 8
    for (int i = 0; i < 32; ++i) { const int kk = 2 * i + (lane >> 5); scr[kk * 33 + (lane & 31)] = W[(size_t)(k0 + kk) * ldw + sc]; }
    LDS_WAIT(); asm volatile("" ::: "memory");
    const int c = lane & 7;
#pragma unroll
    for (int j = 0; j < 4; ++j) { const int n = (lane >> 3) + 8 * j; const LAS float* s = scr + (8 * c) * 33 + n;
        pg8::u32x4 o; o.x = pk2(s[0 * 33], s[1 * 33]); o.y = pk2(s[2 * 33], s[3 * 33]); o.z = pk2(s[4 * 33], s[5 * 33]); o.w = pk2(s[6 * 33], s[7 * 33]);
        *(pg8::u32x4*)(WT + (size_t)(row0 + n) * K + k0 + 8 * c) = o; }
    LDS_WAIT(); asm volatile("" ::: "memory");
}

#define RIX(lane_, j) (((j) >> 1) * 128 + 2 * (lane_) + ((j) & 1))
__device__ __forceinline__ void load_row(const float* __restrict__ p, int lane, f32x4 (&v)[4]) {
#pragma unroll
    for (int j = 0; j < 4; ++j) v[j] = ((const f32x4*)p)[RIX(lane, j)];
}
__device__ __forceinline__ void load_row_bf16(const bf16_t* __restrict__ p, int lane_, f32x4 (&v)[4]) {
#pragma unroll
    for (int c = 0; c < 2; ++c) { const pg8::u32x4 w = ((const pg8::u32x4*)p)[c * 64 + lane_];
        v[2 * c] = (f32x4){bf2f((unsigned short)(w.x & 0xffffu)), bf2f((unsigned short)(w.x >> 16)), bf2f((unsigned short)(w.y & 0xffffu)), bf2f((unsigned short)(w.y >> 16))};
        v[2 * c + 1] = (f32x4){bf2f((unsigned short)(w.z & 0xffffu)), bf2f((unsigned short)(w.z >> 16)), bf2f((unsigned short)(w.w & 0xffffu)), bf2f((unsigned short)(w.w >> 16))}; }
}
__device__ __forceinline__ void store_row_bf16(bf16_t* __restrict__ p, int lane_, const f32x4 (&v)[4]) {
#pragma unroll
    for (int c = 0; c < 2; ++c) { pg8::u32x4 w; w.x = pk2(v[2 * c].x, v[2 * c].y); w.y = pk2(v[2 * c].z, v[2 * c].w); w.z = pk2(v[2 * c + 1].x, v[2 * c + 1].y); w.w = pk2(v[2 * c + 1].z, v[2 * c + 1].w);
        ((pg8::u32x4*)p)[c * 64 + lane_] = w; }
}
__device__ __forceinline__ float row_rstd(const f32x4 (&v)[4]) {
    float s = 0.f;
#pragma unroll
    for (int j = 0; j < 4; ++j) s += (v[j].x * v[j].x + v[j].y * v[j].y) + (v[j].z * v[j].z + v[j].w * v[j].w);
    return rsqrtf(wave_sum(s) * (1.f / DM) + EPS);
}
__device__ __forceinline__ void modulate_inplace(f32x4 (&v)[4], float rstd, const float* __restrict__ g, const float* __restrict__ mods, int lane) {
#pragma unroll
    for (int j = 0; j < 4; ++j) { const int q = RIX(lane, j); const f32x4 gg = ((const f32x4*)g)[q], sh = ((const f32x4*)mods)[q], sc = ((const f32x4*)(mods + DM))[q];
        v[j] = v[j] * rstd * gg * (sc + 1.f) + sh; }
}
__device__ __forceinline__ void modulate_store(const f32x4 (&v)[4], float rstd, const float* __restrict__ g, const float* __restrict__ mods, bf16_t* __restrict__ orow, int lane) {
    f32x4 h[4];
#pragma unroll
    for (int j = 0; j < 4; ++j) { const int q = RIX(lane, j); const f32x4 gg = ((const f32x4*)g)[q], sh = ((const f32x4*)mods)[q], sc = ((const f32x4*)(mods + DM))[q];
        h[j] = v[j] * rstd * gg * (sc + 1.f) + sh; }
    store_row_bf16(orow, lane, h);
}

#define HYBAR() asm volatile("s_waitcnt lgkmcnt(0)\n\ts_barrier" ::: "memory")
__device__ __forceinline__ int PH(int p) { return p + (p >> 4); }
__host__ __device__ constexpr float ck16(int k) { return k == 0 ? 1.f : k == 1 ? 0.92387953251128674f : k == 2 ? 0.70710678118654752f : k == 3 ? 0.38268343236508977f : k == 4 ? 0.f : k == 5 ? -0.38268343236508977f : k == 6 ? -0.70710678118654752f : -0.92387953251128674f; }
__host__ __device__ constexpr float sk16(int k) { return k == 0 ? 0.f : k == 1 ? 0.38268343236508977f : k == 2 ? 0.70710678118654752f : k == 3 ? 0.92387953251128674f : k == 4 ? 1.f : k == 5 ? 0.92387953251128674f : k == 6 ? 0.70710678118654752f : 0.38268343236508977f; }
template <bool INV> __device__ __forceinline__ void r16_bfly(f32x2 (&x)[16], float f8) {
    float cb[4], sb[4];
#pragma unroll
    for (int s = 0; s < 4; ++s) { const float f = f8 * (float)(1 << s); cb[s] = __builtin_amdgcn_cosf(f); sb[s] = __builtin_amdgcn_sinf(f); }
#pragma unroll
    for (int si = 0; si < 4; ++si) {
        const int s = INV ? 3 - si : si; const int hl = 8 >> s;
#pragma unroll
        for (int m0 = 0; m0 < 16; ++m0) {
            if (m0 & hl) continue;
            const int k16 = (m0 % hl) * (8 / hl);
            const float tc = cb[s] * ck16(k16) - sb[s] * sk16(k16), ts = cb[s] * sk16(k16) + sb[s] * ck16(k16);
            const f32x2 u = x[m0], v = x[m0 + hl];
            if (!INV) { const f32x2 d = u - v; x[m0] = u + v; x[m0 + hl] = (f32x2){d.x * tc + d.y * ts, d.y * tc - d.x * ts}; }
            else { const f32x2 w = (f32x2){v.x * tc - v.y * ts, v.x * ts + v.y * tc}; x[m0] = u + w; x[m0 + hl] = u - w; }
        }
    }
}
template <bool INV> __device__ __forceinline__ void r16_pass(LAS f32x2* buf, int e0, int stride, float f8) {
    f32x2 x[16];
    const int pb_ = PH(e0), step = stride + (stride >> 4);
#pragma unroll
    for (int m = 0; m < 16; ++m) x[m] = buf[pb_ + step * m];
    r16_bfly<INV>(x, f8);
#pragma unroll
    for (int m = 0; m < 16; ++m) buf[pb_ + step * m] = x[m];
}
__device__ __forceinline__ void r16_mid(LAS f32x2* zb, const LAS f32x2* fb, int e0, int ef) {
    f32x2 x[16]; const int pb_ = PH(e0), pf_ = PH(ef);
#pragma unroll
    for (int m = 0; m < 16; ++m) x[m] = zb[pb_ + m];
    r16_bfly<false>(x, 0.f);
#pragma unroll
    for (int m = 0; m < 16; ++m) { const f32x2 f = fb[pf_ + m], z = x[m]; x[m] = (f32x2){z.x * f.x - z.y * f.y, z.x * f.y + z.y * f.x}; }
    r16_bfly<true>(x, 0.f);
#pragma unroll
    for (int m = 0; m < 16; ++m) zb[pb_ + m] = x[m];
}
#define WAVE_SEAM() asm volatile("" ::: "memory")
#define OPAQUE(v) asm volatile("" : "+v"(v))
__device__ __forceinline__ void fft13_fwd_tail(LAS f32x2* buf, int tid) {
    OPAQUE(tid);
    r16_pass<false>(buf, (tid >> 8) * 4096 + (tid & 255), 256, (float)(tid & 255) * (1.f / 4096.f)); HYBAR();
    OPAQUE(tid); r16_pass<false>(buf, (tid >> 4) * 256 + (tid & 15), 16, (float)(tid & 15) * (1.f / 256.f)); WAVE_SEAM();
    OPAQUE(tid); r16_pass<false>(buf, tid * 16, 1, 0.f); HYBAR();
}
__device__ __forceinline__ void fft13_conv_core(LAS f32x2* zb, const LAS f32x2* fb, int tid) {
    OPAQUE(tid);
    r16_pass<false>(zb, (tid >> 8) * 4096 + (tid & 255), 256, (float)(tid & 255) * (1.f / 4096.f)); HYBAR();
    OPAQUE(tid); r16_pass<false>(zb, (tid >> 4) * 256 + (tid & 15), 16, (float)(tid & 15) * (1.f / 256.f)); WAVE_SEAM();
    OPAQUE(tid); r16_mid(zb, fb, tid * 16, tid * 16); WAVE_SEAM();
    OPAQUE(tid); r16_pass<true>(zb, (tid >> 4) * 256 + (tid & 15), 16, (float)(tid & 15) * (1.f / 256.f)); HYBAR();
    OPAQUE(tid); r16_pass<true>(zb, (tid >> 8) * 4096 + (tid & 255), 256, (float)(tid & 255) * (1.f / 4096.f)); HYBAR();
}
__device__ __forceinline__ void conv8(const bf16_t* __restrict__ row, int s0, int n, float w0, float w1, float w2, float bias, float (&o)[8]) {
    const bf16x8 v = *(const bf16x8*)(row + s0);
    float x[10];
    x[0] = s0 > 0 ? bf2f(row[s0 - 1]) : 0.f; x[9] = s0 + 8 < n ? bf2f(row[s0 + 8]) : 0.f;
#pragma unroll
    for (int e = 0; e < 8; ++e) x[1 + e] = bf2f((unsigned short)v[e]);
#pragma unroll
    for (int e = 0; e < 8; ++e) o[e] = bias + w0 * x[e] + w1 * x[e + 1] + w2 * x[e + 2];
}
__device__ __forceinline__ void hyena_lat_channel(LAS unsigned char* L, int c, float (&a0)[8], float (&a1)[8], const bf16_t* __restrict__ xvt,
                                                  const float* __restrict__ cw, const float* __restrict__ cb, const float* __restrict__ hyb, bf16_t* __restrict__ a2, int tid, bool last) {
    constexpr int n = 4096, N = 8192;
    OPAQUE(tid); const int lane = tid & 63, wid = tid >> 6, s0 = 8 * tid;
    LAS f32x2* Fb = (LAS f32x2*)L; LAS f32x2* Zb = (LAS f32x2*)(L + 69632); LAS float* red = (LAS float*)(L + 139264);
    {
        const float absdelta = 3.0701134573253945f + (float)c * (12.280453829301578f / 1023.f);
        float l1 = 0.f;
#pragma unroll
        for (int e = 0; e < 8; ++e) { const int t = s0 + e; const float dec = __expf(-((float)t * (1.f / (float)(n - 1))) * absdelta); a0[e] *= dec; a1[e] *= dec; l1 += fabsf(a0[e]); if (t >= 1) l1 += fabsf(a1[e]); }
        l1 = wave_sum(l1); if (lane == 0) red[wid] = l1;
        HYBAR();
        float tot = 0.f;
#pragma unroll
        for (int w = 0; w < 8; ++w) tot += red[w];
        const float scale = 1.f / (tot * (float)N);
        { const int pb = PH(s0), qb = PH(N - 8 - s0);
#pragma unroll
          for (int e = 0; e < 8; ++e) { Fb[pb + e] = (f32x2){a0[e] * scale, 0.f}; if (e >= 1) Fb[qb + 8 - e] = (f32x2){a1[e] * scale, 0.f}; }
          if (tid >= 1) Fb[PH(N - s0)] = (f32x2){a1[0] * scale, 0.f}; }
        if (tid == 0) Fb[PH(n)] = (f32x2){0.f, 0.f};
        HYBAR();
        const float w00 = cw[c], w01 = cw[3072 + c], w02 = cw[6144 + c], b0 = cb[c];
        const float w10 = cw[1024 + c], w11 = cw[3072 + 1024 + c], w12 = cw[6144 + 1024 + c], b1 = cb[1024 + c];
        const float w20 = cw[2048 + c], w21 = cw[3072 + 2048 + c], w22 = cw[6144 + 2048 + c], b2 = cb[2048 + c];
        const float hb = hyb[c];
        const int sm1 = s0 > 0 ? s0 - 1 : 0, sp8 = s0 + 8 < n ? s0 + 8 : n - 1;
        const float mlo = s0 > 0 ? 1.f : 0.f, mhi = s0 + 8 < n ? 1.f : 0.f;
#define RAWLD(V, LO, HI, rowp) do { const bf16_t* rp_ = (rowp); V = *(const bf16x8*)(rp_ + s0); LO = rp_[sm1]; HI = rp_[sp8]; } while (0)
#define RAWCONV(V, LO, HI, wA, wB, wC, bias_, out_) do { float x_[10]; x_[0] = bf2f(LO) * mlo; x_[9] = bf2f(HI) * mhi; \
        _Pragma("unroll") for (int e = 0; e < 8; ++e) x_[1 + e] = bf2f((unsigned short)V[e]); \
        _Pragma("unroll") for (int e = 0; e < 8; ++e) out_[e] = (bias_) + (wA) * x_[e] + (wB) * x_[e + 1] + (wC) * x_[e + 2]; } while (0)
        bf16x8 fa0, fb0, fa1, fb1; unsigned short fa0l, fa0h, fb0l, fb0h, fa1l, fa1h, fb1l, fb1h;
        { const bf16_t* r0 = xvt; const bf16_t* r1 = xvt + (size_t)4096 * n;
          RAWLD(fa0, fa0l, fa0h, r0 + (size_t)(2048 + c) * n); RAWLD(fb0, fb0l, fb0h, r0 + (size_t)(1024 + c) * n);
          RAWLD(fa1, fa1l, fa1h, r1 + (size_t)(2048 + c) * n); RAWLD(fb1, fb1l, fb1h, r1 + (size_t)(1024 + c) * n); }
        { const int pt = PH(tid);
#pragma unroll
          for (int k = 0; k < 8; ++k) { const float f = (float)(tid + 512 * k) * (1.f / 8192.f); const float cc_ = __builtin_amdgcn_cosf(f), ss_ = __builtin_amdgcn_sinf(f);
            const int i0 = pt + 544 * k, i1 = i0 + 4352;
            const f32x2 u = Fb[i0], v = Fb[i1], d = u - v; Fb[i0] = u + v; Fb[i1] = (f32x2){d.x * cc_ + d.y * ss_, d.y * cc_ - d.x * ss_}; } }
        HYBAR();
        fft13_fwd_tail(Fb, tid);
#pragma unroll 1
        for (int pair = 0; pair < 2; ++pair) {
            const bf16_t* r0 = xvt + ((size_t)(2 * pair) * 4096) * n; const bf16_t* r1 = xvt + ((size_t)(2 * pair + 1) * 4096) * n;
            float g0[8], g1[8];
            { float tmp[8];
              RAWCONV(fa0, fa0l, fa0h, w20, w21, w22, b2, g0); RAWCONV(fb0, fb0l, fb0h, w10, w11, w12, b1, tmp);
#pragma unroll
              for (int e = 0; e < 8; ++e) g0[e] *= tmp[e];
              RAWCONV(fa1, fa1l, fa1h, w20, w21, w22, b2, g1); RAWCONV(fb1, fb1l, fb1h, w10, w11, w12, b1, tmp);
#pragma unroll
              for (int e = 0; e < 8; ++e) g1[e] *= tmp[e]; }
#pragma unroll
            for (int e = 0; e < 8; ++e) { const int s = s0 + e; const float f = (float)s * (1.f / 8192.f); const float cc_ = __builtin_amdgcn_cosf(f), ss_ = __builtin_amdgcn_sinf(f); const int pb = PH(s0);
                Zb[pb + e] = (f32x2){g0[e], g1[e]}; Zb[pb + 4352 + e] = (f32x2){g0[e] * cc_ + g1[e] * ss_, g1[e] * cc_ - g0[e] * ss_}; }
            HYBAR();
            bf16x8 xr0, xr1; unsigned short xl0, xh0, xl1, xh1;
            RAWLD(xr0, xl0, xh0, r0 + (size_t)c * n); RAWLD(xr1, xl1, xh1, r1 + (size_t)c * n);
            const bf16x8 gh0 = *(const bf16x8*)(r0 + (size_t)(3072 + c) * n + s0), gh1 = *(const bf16x8*)(r1 + (size_t)(3072 + c) * n + s0);
            pg8::u32x4 qa0 = {}, qa1 = {}, qa2 = {}, qb0 = {}, qb1 = {}, qb2 = {};
            if (last) { const bf16_t* pa = r0 + (size_t)(1024 + c) * n + s0; const bf16_t* pb_ = r1 + (size_t)(1024 + c) * n + s0;
                qa0 = *(const pg8::u32x4*)(pa - 3 * (size_t)n); qa1 = *(const pg8::u32x4*)(pa - 2 * (size_t)n); qa2 = *(const pg8::u32x4*)(pa - (size_t)n);
                qb0 = *(const pg8::u32x4*)(pb_ - 3 * (size_t)n); qb1 = *(const pg8::u32x4*)(pb_ - 2 * (size_t)n); qb2 = *(const pg8::u32x4*)(pb_ - (size_t)n); }
            fft13_conv_core(Zb, Fb, tid);
            float oa[8], ob[8];
            { float x0a[8], x0b[8];
              RAWCONV(xr0, xl0, xh0, w00, w01, w02, b0, x0a); RAWCONV(xr1, xl1, xh1, w00, w01, w02, b0, x0b);
#pragma unroll
              for (int e = 0; e < 8; ++e) { const int t = s0 + e; const float f = (float)t * (1.f / 8192.f); const float cc_ = __builtin_amdgcn_cosf(f), ss_ = __builtin_amdgcn_sinf(f);
                  const int pb = PH(s0); const f32x2 u = Zb[pb + e], v = Zb[pb + 4352 + e];
                  const float ya = u.x + (v.x * cc_ - v.y * ss_), yb = u.y + (v.x * ss_ + v.y * cc_);
                  oa[e] = x0a[e] * (ya + g0[e] * hb) * silu_f(bf2f((unsigned short)gh0[e])); ob[e] = x0b[e] * (yb + g1[e] * hb) * silu_f(bf2f((unsigned short)gh1[e])); } }
            { const bf16_t* n0 = xvt + ((size_t)(2 * (pair ^ 1)) * 4096) * n; const bf16_t* n1 = n0 + (size_t)4096 * n;
              RAWLD(fa0, fa0l, fa0h, n0 + (size_t)(2048 + c) * n); RAWLD(fb0, fb0l, fb0h, n0 + (size_t)(1024 + c) * n);
              RAWLD(fa1, fa1l, fa1h, n1 + (size_t)(2048 + c) * n); RAWLD(fb1, fb1l, fb1h, n1 + (size_t)(1024 + c) * n); }
            { int s0 = 8 * tid; OPAQUE(s0);
              bf16_t* ppa = (bf16_t*)r0 + (size_t)(1024 + c) * n + s0; bf16_t* ppb = (bf16_t*)r1 + (size_t)(1024 + c) * n + s0;
              if (!last) { *(pg8::u32x4*)ppa = (pg8::u32x4){pk2(oa[0], oa[1]), pk2(oa[2], oa[3]), pk2(oa[4], oa[5]), pk2(oa[6], oa[7])};
                           *(pg8::u32x4*)ppb = (pg8::u32x4){pk2(ob[0], ob[1]), pk2(ob[2], ob[3]), pk2(ob[4], ob[5]), pk2(ob[6], ob[7])}; }
              else {
                  const unsigned QA0[4] = {qa0.x, qa0.y, qa0.z, qa0.w}, QA1[4] = {qa1.x, qa1.y, qa1.z, qa1.w}, QA2[4] = {qa2.x, qa2.y, qa2.z, qa2.w};
                  const unsigned QB0[4] = {qb0.x, qb0.y, qb0.z, qb0.w}, QB1[4] = {qb1.x, qb1.y, qb1.z, qb1.w}, QB2[4] = {qb2.x, qb2.y, qb2.z, qb2.w};
#pragma unroll
                  for (int e = 0; e < 8; ++e) { const int t = s0 + e; const int sh = (e & 1) * 16;
                      const unsigned lo = ((QA0[e >> 1] >> sh) & 0xffffu) | (((QA1[e >> 1] >> sh) & 0xffffu) << 16), hi = ((QA2[e >> 1] >> sh) & 0xffffu) | ((unsigned)f2bf(oa[e]) << 16);
                      *(u32x2*)(a2 + ((size_t)(2 * pair) * n + t) * 2048 + c - 3) = (u32x2){lo, hi}; }
#pragma unroll
                  for (int e = 0; e < 8; ++e) { const int t = s0 + e; const int sh = (e & 1) * 16;
                      const unsigned lo = ((QB0[e >> 1] >> sh) & 0xffffu) | (((QB1[e >> 1] >> sh) & 0xffffu) << 16), hi = ((QB2[e >> 1] >> sh) & 0xffffu) | ((unsigned)f2bf(ob[e]) << 16);
                      *(u32x2*)(a2 + ((size_t)(2 * pair + 1) * n + t) * 2048 + c - 3) = (u32x2){lo, hi}; } } }
            HYBAR();
        }
#undef RAWLD
#undef RAWCONV
    }
}
__device__ __forceinline__ void hyena_lat4(LAS unsigned char* L, int c0, const bf16_t* __restrict__ xvt, const bf16_t* __restrict__ hdnt, const float* __restrict__ w3,
                                           const float* __restrict__ cw, const float* __restrict__ cb, const float* __restrict__ hyb, bf16_t* __restrict__ a2, int tid, float* __restrict__ park) {
    LAS float* w3s = (LAS float*)(L + 139264) + 16;
    { const int ci_ = tid >> 7, r_ = tid & 127; w3s[ci_ * 128 + (r_ & 63) * 2 + (r_ >> 6)] = w3[(r_ & 63) * 2048 + (r_ >> 6) * 1024 + c0 + ci_]; }
    HYBAR();
#pragma unroll 1
    for (int cp = 0; cp < 2; ++cp) {
        OPAQUE(tid); const int s0 = 8 * tid;
        float a0[8], a1[8]; f32x2 ta[8], tb[8];
#pragma unroll
        for (int e = 0; e < 8; ++e) { ta[e] = (f32x2){0.f, 0.f}; tb[e] = (f32x2){0.f, 0.f}; }
#pragma unroll 8
        for (int j = 0; j < 64; ++j) { const pg8::u32x4 hw = *(const pg8::u32x4*)(hdnt + (size_t)j * 4352 + s0);
            const float hh[8] = {__uint_as_float(hw.x << 16), __uint_as_float(hw.x & 0xffff0000u), __uint_as_float(hw.y << 16), __uint_as_float(hw.y & 0xffff0000u),
                                 __uint_as_float(hw.z << 16), __uint_as_float(hw.z & 0xffff0000u), __uint_as_float(hw.w << 16), __uint_as_float(hw.w & 0xffff0000u)};
            const f32x2 wa = *(const LAS f32x2*)(w3s + (2 * cp) * 128 + 2 * j), wb = *(const LAS f32x2*)(w3s + (2 * cp + 1) * 128 + 2 * j);
#pragma unroll
            for (int e = 0; e < 8; ++e) { ta[e] = ta[e] + wa * hh[e]; tb[e] = tb[e] + wb * hh[e]; } }
#pragma unroll
        for (int e = 0; e < 8; ++e) { park[e * 512 + tid] = tb[e].x; park[(8 + e) * 512 + tid] = tb[e].y; a0[e] = ta[e].x; a1[e] = ta[e].y; }
        hyena_lat_channel(L, c0 + 2 * cp, a0, a1, xvt, cw, cb, hyb, a2, tid, false);
        OPAQUE(tid);
#pragma unroll
        for (int e = 0; e < 8; ++e) { a0[e] = park[e * 512 + tid]; a1[e] = park[(8 + e) * 512 + tid]; }
        hyena_lat_channel(L, c0 + 2 * cp + 1, a0, a1, xvt, cw, cb, hyb, a2, tid, cp == 1);
    }
}
__device__ __forceinline__ void hyena_ctx4(LAS unsigned char* L, int c0, const bf16_t* __restrict__ xvt, const bf16_t* __restrict__ hdnt, const float* __restrict__ w3,
                                           const float* __restrict__ cw, const float* __restrict__ cb, const float* __restrict__ hyb, bf16_t* __restrict__ a2, int tid) {
    constexpr int n = 256, N = 512;
    OPAQUE(tid);
    const int lane = tid & 63, wid = tid >> 6;
    LAS f32x2* Fb = (LAS f32x2*)L; LAS f32x2* Zb = (LAS f32x2*)(L + 69632); LAS float* red = (LAS float*)(L + 139264);
    { const int fc = tid >> 7, c = c0 + fc, t0 = 2 * (tid & 127);
      float a0[2] = {0.f, 0.f}, a1[2] = {0.f, 0.f};
#pragma unroll 16
      for (int j = 0; j < 64; ++j) { const unsigned hw_ = *(const unsigned*)(hdnt + (size_t)j * 4352 + t0); const f32x2 hv = (f32x2){__uint_as_float(hw_ << 16), __uint_as_float(hw_ & 0xffff0000u)}; const float wf = w3[j * 2048 + c], wb = w3[j * 2048 + 1024 + c];
          a0[0] += hv.x * wf; a0[1] += hv.y * wf; a1[0] += hv.x * wb; a1[1] += hv.y * wb; }
      const float absdelta = 3.0701134573253945f + (float)c * (12.280453829301578f / 1023.f);
      float l1 = 0.f;
#pragma unroll
      for (int e = 0; e < 2; ++e) { const int t = t0 + e; const float dec = __expf(-((float)t * (1.f / (float)(n - 1))) * absdelta); a0[e] *= dec; a1[e] *= dec; l1 += fabsf(a0[e]); if (t >= 1) l1 += fabsf(a1[e]); }
      l1 = wave_sum(l1); if (lane == 0) red[wid] = l1;
      HYBAR();
      const float scale = 1.f / ((red[2 * fc] + red[2 * fc + 1]) * (float)N);
#pragma unroll
      for (int e = 0; e < 2; ++e) { const int t = t0 + e; Fb[PH(fc * 512 + t)] = (f32x2){a0[e] * scale, 0.f}; if (t >= 1) Fb[PH(fc * 512 + N - t)] = (f32x2){a1[e] * scale, 0.f}; }
      if ((tid & 127) == 0) Fb[PH(fc * 512 + n)] = (f32x2){0.f, 0.f};
      HYBAR();
#pragma unroll
      for (int i = 0; i < 2; ++i) { const int q = tid + 512 * i, sl = q >> 8, p = q & 255; const float f = (float)p * (1.f / 512.f); const float cc_ = __builtin_amdgcn_cosf(f), ss_ = __builtin_amdgcn_sinf(f);
          const int i0 = PH(sl * 512 + p), i1 = i0 + 272; const f32x2 u = Fb[i0], v = Fb[i1], d = u - v; Fb[i0] = u + v; Fb[i1] = (f32x2){d.x * cc_ + d.y * ss_, d.y * cc_ - d.x * ss_}; }
      HYBAR();
      OPAQUE(tid); r16_pass<false>(Fb, (tid >> 4) * 256 + (tid & 15), 16, (float)(tid & 15) * (1.f / 256.f)); HYBAR();
      OPAQUE(tid); r16_pass<false>(Fb, tid * 16, 1, 0.f); HYBAR(); }
    const int ch = wid >> 1, pair = wid & 1, c = c0 + ch, s0 = 4 * lane;
    const float w00 = cw[c], w01 = cw[3072 + c], w02 = cw[6144 + c], b0 = cb[c];
    const float w10 = cw[1024 + c], w11 = cw[3072 + 1024 + c], w12 = cw[6144 + 1024 + c], b1 = cb[1024 + c];
    const float w20 = cw[2048 + c], w21 = cw[3072 + 2048 + c], w22 = cw[6144 + 2048 + c], b2 = cb[2048 + c];
    const float hb = hyb[c];
    const bf16_t* r0 = xvt + ((size_t)(2 * pair) * 4096) * n; const bf16_t* r1 = xvt + ((size_t)(2 * pair + 1) * 4096) * n;
    float g0[4], g1[4];
#define CONV4(row_, wA, wB, wC, bias_, out_) do { const bf16_t* rp_ = (row_); const u32x2 v_ = *(const u32x2*)(rp_ + s0); float x_[6]; \
        x_[0] = bf2f(rp_[s0 > 0 ? s0 - 1 : 0]) * (s0 > 0 ? 1.f : 0.f); x_[5] = bf2f(rp_[s0 + 4 < n ? s0 + 4 : n - 1]) * (s0 + 4 < n ? 1.f : 0.f);        \
        x_[1] = bf2f((unsigned short)(v_.x & 0xffffu)); x_[2] = bf2f((unsigned short)(v_.x >> 16)); x_[3] = bf2f((unsigned short)(v_.y & 0xffffu)); x_[4] = bf2f((unsigned short)(v_.y >> 16)); \
        _Pragma("unroll") for (int e = 0; e < 4; ++e) out_[e] = (bias_) + (wA) * x_[e] + (wB) * x_[e + 1] + (wC) * x_[e + 2]; } while (0)
    { float tmp[4];
      CONV4(r0 + (size_t)(2048 + c) * n, w20, w21, w22, b2, g0); CONV4(r0 + (size_t)(1024 + c) * n, w10, w11, w12, b1, tmp);
#pragma unroll
      for (int e = 0; e < 4; ++e) g0[e] *= tmp[e];
      CONV4(r1 + (size_t)(2048 + c) * n, w20, w21, w22, b2, g1); CONV4(r1 + (size_t)(1024 + c) * n, w10, w11, w12, b1, tmp);
#pragma unroll
      for (int e = 0; e < 4; ++e) g1[e] *= tmp[e]; }
#pragma unroll
    for (int e = 0; e < 4; ++e) { const int s = s0 + e; const float f = (float)s * (1.f / 512.f); const float cc_ = __builtin_amdgcn_cosf(f), ss_ = __builtin_amdgcn_sinf(f);
        const int pb = PH(wid * 512 + s0); Zb[pb + e] = (f32x2){g0[e], g1[e]}; Zb[pb + 272 + e] = (f32x2){g0[e] * cc_ + g1[e] * ss_, g1[e] * cc_ - g0[e] * ss_}; }
    HYBAR();
    OPAQUE(tid); r16_pass<false>(Zb, (tid >> 4) * 256 + (tid & 15), 16, (float)(tid & 15) * (1.f / 256.f)); WAVE_SEAM();
    OPAQUE(tid); r16_mid(Zb, Fb, tid * 16, (tid >> 6) * 512 + ((tid * 16) & 511)); WAVE_SEAM();
    OPAQUE(tid); r16_pass<true>(Zb, (tid >> 4) * 256 + (tid & 15), 16, (float)(tid & 15) * (1.f / 256.f)); HYBAR();
    { float x0a[4], x0b[4];
      CONV4(r0 + (size_t)c * n, w00, w01, w02, b0, x0a); CONV4(r1 + (size_t)c * n, w00, w01, w02, b0, x0b);
      const u32x2 gha = *(const u32x2*)(r0 + (size_t)(3072 + c) * n + s0), ghb = *(const u32x2*)(r1 + (size_t)(3072 + c) * n + s0);
#pragma unroll
      for (int e = 0; e < 4; ++e) { const int t = s0 + e; const float f = (float)t * (1.f / 512.f); const float cc_ = __builtin_amdgcn_cosf(f), ss_ = __builtin_amdgcn_sinf(f);
          const int pb = PH(wid * 512 + s0); const f32x2 u = Zb[pb + e], v = Zb[pb + 272 + e];
          const float ya = u.x + (v.x * cc_ - v.y * ss_), yb = u.y + (v.x * ss_ + v.y * cc_);
          const unsigned ga_ = e < 2 ? gha.x : gha.y, gb_ = e < 2 ? ghb.x : ghb.y; const float gva = bf2f((unsigned short)((e & 1) ? (ga_ >> 16) : (ga_ & 0xffffu))), gvb = bf2f((unsigned short)((e & 1) ? (gb_ >> 16) : (gb_ & 0xffffu)));
          const float oa = x0a[e] * (ya + g0[e] * hb) * silu_f(gva), ob = x0b[e] * (yb + g1[e] * hb) * silu_f(gvb);
          a2[((size_t)(2 * pair) * n + t) * 2048 + c] = f2bf(oa); a2[((size_t)(2 * pair + 1) * n + t) * 2048 + c] = f2bf(ob); } }
#undef CONV4
    HYBAR();
}
namespace ml2 {
typedef short v4i16 __attribute__((ext_vector_type(4)));
constexpr int RAWS = 264, QS = 136, KTS = 72, VS = 264, SS = 72;
constexpr int OFF_RAW = 0, OFF_V = 34848, OFF_KTA = 68640, OFF_X = 87072, OFF_Q = 87072, OFF_K = 104480, OFF_KTB = 87072, OFF_S = 121888, OFF_G = 131104;
constexpr int G_DEN = 0, G_INV = 64, G_NQ = 128, G_BB = 192, G_CS = 256, G_EB = 320, G_AA = 384, G_NV = 448, G_NV2 = 576, G_SEGA = 704, G_SCAN = 1728, G_MISC = 1744;
constexpr size_t EST_SLOT = 16384;

__device__ __forceinline__ float logsig(float x) { return fminf(x, 0.f) - log1pf(__expf(-fabsf(x))); }
__device__ __forceinline__ unsigned pkbf(float lo, float hi) { return pg8::cvtpk_hw(lo, hi); }
template <int CTRL> __device__ __forceinline__ float dpp_add(float v) { return v + __builtin_bit_cast(float, __builtin_amdgcn_update_dpp(0, __builtin_bit_cast(int, v), CTRL, 0xF, 0xF, true)); }
__device__ __forceinline__ float sum8(float v) { v = dpp_add<0xB1>(v); v = dpp_add<0x4E>(v); return dpp_add<0x141>(v); }
__device__ __forceinline__ float sum16(float v) { return dpp_add<0x140>(sum8(v)); }
template <int CTRL, int ROWMASK> __device__ __forceinline__ float dpp_add_rm(float v) { return v + __builtin_bit_cast(float, __builtin_amdgcn_update_dpp(0, __builtin_bit_cast(int, v), CTRL, ROWMASK, 0xF, ROWMASK == 0xF)); }
__device__ __forceinline__ float wave_scan_incl(float v) {
    v = dpp_add_rm<0x111, 0xF>(v); v = dpp_add_rm<0x112, 0xF>(v); v = dpp_add_rm<0x114, 0xF>(v); v = dpp_add_rm<0x118, 0xF>(v);
    v = dpp_add_rm<0x142, 0xA>(v); v = dpp_add_rm<0x143, 0xC>(v);
    return v;
}
__device__ __forceinline__ bf16x8 vfrag(LAS unsigned char* vs, int srow, int vcol0, int lane) {
    const int g = lane >> 4, i = lane & 15, q = i >> 2, p = i & 3;
    LAS v4i16* a0 = (LAS v4i16*)(vs + ((srow + 8 * g + q) * VS + vcol0 + 4 * p) * 2);
    LAS v4i16* a1 = (LAS v4i16*)(vs + ((srow + 8 * g + 4 + q) * VS + vcol0 + 4 * p) * 2);
    const v4i16 lo = __builtin_amdgcn_ds_read_tr16_b64_v4i16(a0), hi = __builtin_amdgcn_ds_read_tr16_b64_v4i16(a1);
    return (bf16x8){lo[0], lo[1], lo[2], lo[3], hi[0], hi[1], hi[2], hi[3]};
}
__device__ __forceinline__ float block_scan(float x, LAS float* scan, int tid, float* tot) {
    const int lane = tid & 63, wid = tid >> 6; const float v = wave_scan_incl(x);
    if (lane == 63) scan[wid] = v;
    __syncthreads();
    float pre = 0.f, all = 0.f;
#pragma unroll
    for (int w = 0; w < 8; ++w) { const float s = scan[w]; if (w < wid) pre += s; all += s; }
    __syncthreads();
    *tot = all; return v + pre;
}
constexpr int OFF_TAPS = 138240;
__device__ __forceinline__ void stage_taps(LAS unsigned char* L, const float* __restrict__ cw, const float* __restrict__ cb, int h, int tid) {
    LAS float* tp = (LAS float*)(L + OFF_TAPS);
    if (tid < 256) { const int col = tid < 128 ? h * 128 + tid : 1024 + h * 128 + (tid - 128); tp[tid] = cw[col]; tp[256 + tid] = cw[2048 + col]; tp[512 + tid] = cw[4096 + col]; tp[768 + tid] = cb[col]; }
}
__device__ __forceinline__ void conv_row8(LAS unsigned char* L, int r, int cbyte, int tcol, float scale, float (&o)[8]) {
    LAS unsigned char* raw = L + OFF_RAW; const LAS float* tp = (const LAS float*)(L + OFF_TAPS) + tcol;
    const bf16x8 xm = *(const LAS bf16x8*)(raw + r * (RAWS * 2) + cbyte), x0 = *(const LAS bf16x8*)(raw + (r + 1) * (RAWS * 2) + cbyte), xp = *(const LAS bf16x8*)(raw + (r + 2) * (RAWS * 2) + cbyte);
#pragma unroll
    for (int e = 0; e < 8; ++e) { const float a = tp[768 + e] + tp[e] * bf2f((unsigned short)xm[e]) + tp[256 + e] * bf2f((unsigned short)x0[e]) + tp[512 + e] * bf2f((unsigned short)xp[e]);
        o[e] = silu_f(a) * scale; }
}

__device__ __forceinline__ void passA(LAS unsigned char* L, const bf16_t* __restrict__ Y1A, const float* __restrict__ GATES, const float* __restrict__ cw, const float* __restrict__ cb,
                                      unsigned* __restrict__ EST, float* __restrict__ NST, float* __restrict__ PST, unsigned* __restrict__ CTXE, float* __restrict__ CTXN, int bid, int G) {
    int tid = threadIdx.x; asm volatile("" : "+v"(tid));
    const int lane0 = tid & 63, wid = __builtin_amdgcn_readfirstlane(tid >> 6);
    LAS float* gl = (LAS float*)(L + OFF_G);
    LAS unsigned short* kta = (LAS unsigned short*)(L + OFF_KTA); LAS unsigned short* ktb = (LAS unsigned short*)(L + OFF_KTB);
    for (int item = bid; item < 256; item += G) {
        const int b = item >> 6, h = (item >> 3) & 7, g = item & 7;
        stage_taps(L, cw, cb, h, tid);
        const int njobs = 2;
        for (int job = 0; job < njobs; ++job) {
            const bool ctxjob = job == 1; const int ntok = ctxjob ? CTXL : 512, nseq = ctxjob ? CTXL : SEQ, tseg = ctxjob ? 0 : g * 512;
            const size_t rowbase = ctxjob ? (size_t)MLAT + b * CTXL : (size_t)b * SEQ;
            const bool en_f = !ctxjob || g < 4, en_b = !ctxjob || g >= 4; const int cj = g & 3;
            float lff = 0.f, lfb = 0.f, ipf = 0.f, ipb = 0.f;
            if (tid < ntok) { const float* gp = GATES + (rowbase + tseg + tid) * 32 + h; ipf = gp[0]; lff = logsig(gp[8]); ipb = gp[16]; lfb = logsig(gp[24]); }
            float totf, totb; const float Bf = block_scan(lff, gl + G_SCAN, tid, &totf); const float Bbi = block_scan(lfb, gl + G_SCAN, tid, &totb);
            const float Bb = totb - (Bbi - lfb);
            if (tid < ntok) { gl[G_SEGA + tid] = en_f ? __expf(totf - Bf + ipf) : 0.f; gl[G_SEGA + 512 + tid] = en_b ? __expf(totb - Bb + ipb) : 0.f; }
            if (tid < 256) gl[G_NV + tid] = 0.f;
            const int nch = ntok / 64, bh = b * 8 + h; const int c0 = ctxjob ? cj : 0, c1 = ctxjob ? cj + 1 : nch;
#pragma unroll 1
            for (int dir = 0; dir < 2; ++dir) {
                if (!(dir == 0 ? en_f : en_b)) continue;
                f32x4 acc[8][2];
#pragma unroll
                for (int dt = 0; dt < 8; ++dt)
#pragma unroll
                    for (int nt = 0; nt < 2; ++nt) acc[dt][nt] = (f32x4){0.f, 0.f, 0.f, 0.f};
                bf16x8 rk[3], rv[4];
#define A_ISSUE(ci_) do { const int t0_ = tseg + (ci_) * 64; \
                    _Pragma("unroll") for (int i = 0; i < 3; ++i) { const int c = tid + 512 * i; const int rr = c >> 4, cc8 = (c & 15) * 8; int tt = t0_ - 1 + rr; \
                        const bool ok = (tt >= 0) && (tt < nseq) && (c < 1056); tt = tt < 0 ? 0 : (tt > nseq - 1 ? nseq - 1 : tt); \
                        rk[i] = *(const bf16x8*)(Y1A + (rowbase + tt) * 4096 + 1024 + h * 128 + cc8); }   \
                    _Pragma("unroll") for (int i = 0; i < 4; ++i) { const int c = tid + 512 * i; const int rr = c >> 5, cc8 = (c & 31) * 8; \
                        rv[i] = *(const bf16x8*)(Y1A + (rowbase + t0_ + rr) * 4096 + 2048 + h * 256 + cc8); } } while (0)
                A_ISSUE(c0);
#pragma unroll 1
                for (int ci = c0; ci < c1; ++ci) {
                    int lane = lane0; asm volatile("" : "+v"(lane)); const int fr = lane & 15, fq = lane >> 4;
#pragma unroll
                    for (int i = 0; i < 3; ++i) { const int c = tid + 512 * i; const int tt = tseg + ci * 64 - 1 + (c >> 4); const bool ok = (tt >= 0) && (tt < nseq);
                        if (c < 1056) *(LAS bf16x8*)(L + OFF_RAW + (c >> 4) * (RAWS * 2) + (c & 15) * 16) = ok ? rk[i] : (bf16x8){0, 0, 0, 0, 0, 0, 0, 0}; }
#pragma unroll
                    for (int i = 0; i < 4; ++i) { const int c = tid + 512 * i; *(LAS bf16x8*)(L + OFF_V + (c >> 5) * (VS * 2) + (c & 31) * 16) = rv[i]; }
                    __syncthreads();
                    if (ci + 1 < c1) A_ISSUE(ci + 1);
#pragma unroll
                    for (int i = 0; i < 2; ++i) { const int r = tid & 63, d0 = (wid + 8 * i) * 8; float kv[8]; conv_row8(L, r, d0 * 2, 128 + d0, 0.08838834764831845f, kv);
                        const float aw = gl[G_SEGA + dir * 512 + ci * 64 + r];
#pragma unroll
                        for (int e = 0; e < 8; ++e) kta[(d0 + e) * KTS + r] = pg8::f2bf_rne(kv[e] * aw); }
                    __syncthreads();
#pragma unroll
                    for (int kk = 0; kk < 2; ++kk) { bf16x8 bv[2];
#pragma unroll
                        for (int nt = 0; nt < 2; ++nt) bv[nt] = vfrag(L + OFF_V, kk * 32, wid * 32 + nt * 16, lane);
#pragma unroll
                        for (int dt = 0; dt < 8; ++dt) { const bf16x8 af = *(const LAS bf16x8*)(L + OFF_KTA + ((dt * 16 + fr) * KTS + kk * 32 + fq * 8) * 2);
#pragma unroll
                            for (int nt = 0; nt < 2; ++nt) acc[dt][nt] = __builtin_amdgcn_mfma_f32_16x16x32_bf16(af, bv[nt], acc[dt][nt], 0, 0, 0); } }
                    if (tid < 128) { const LAS unsigned short* rowp = kta + tid * KTS; float s = 0.f;
#pragma unroll
                        for (int q = 0; q < 8; ++q) { const bf16x8 x = *(const LAS bf16x8*)(rowp + q * 8);
#pragma unroll
                            for (int e = 0; e < 8; ++e) s += bf2f((unsigned short)x[e]); }
                        gl[G_NV + dir * 128 + tid] += s; }
                    __syncthreads();
                }
#undef A_ISSUE
                const bool own_unused = !ctxjob && (dir == 0 ? g == 7 : g == 0);
                if (!own_unused) { const int slot = ctxjob ? (bh * 2 + dir) * 4 + cj : (bh * 8 + g) * 2 + dir; unsigned* ep = (ctxjob ? CTXE : EST) + (size_t)slot * EST_SLOT + tid;
#pragma unroll
                    for (int dt = 0; dt < 8; ++dt)
#pragma unroll
                        for (int nt = 0; nt < 2; ++nt) { ep[((dt * 2 + nt) * 2 + 0) * 512] = pkbf(acc[dt][nt][0], acc[dt][nt][1]); ep[((dt * 2 + nt) * 2 + 1) * 512] = pkbf(acc[dt][nt][2], acc[dt][nt][3]); }
                    if (tid < 128) (ctxjob ? CTXN : NST)[slot * 128 + tid] = gl[G_NV + dir * 128 + tid]; if (tid == 0 && !ctxjob) PST[slot] = __expf(dir == 0 ? totf : totb); }
            }
            __syncthreads();
        }
    }
}

#if defined(PROBE_A)
#define ML_STAMP(i) do { if (blockIdx.x == 0) ((unsigned long long*)PROBE_STAMPS)[i] = __builtin_amdgcn_s_memrealtime(); } while (0)
#else
#define ML_STAMP(i) do { } while (0)
#endif
__device__ __forceinline__ void passB(LAS unsigned char* L, const bf16_t* __restrict__ Y1A, const float* __restrict__ GATES, const float* __restrict__ cw, const float* __restrict__ cb,
                                      const unsigned* __restrict__ EST, const float* __restrict__ NST, const float* __restrict__ PST, bf16_t* __restrict__ H, int bid, int G, unsigned char* PROBE_STAMPS) {
    int tid = threadIdx.x; asm volatile("" : "+v"(tid));
    const int lane0 = tid & 63, wid = __builtin_amdgcn_readfirstlane(tid >> 6);
    LAS float* gl = (LAS float*)(L + OFF_G);
    LAS unsigned short* q_s = (LAS unsigned short*)(L + OFF_Q); LAS unsigned short* k_s = (LAS unsigned short*)(L + OFF_K);
    LAS unsigned short* kta = (LAS unsigned short*)(L + OFF_KTA); LAS unsigned short* S_s = (LAS unsigned short*)(L + OFF_S);
    for (int item = bid; item < 256; item += G) {
        const int b = item >> 6, h = (item >> 3) & 7, g = item & 7, bh = b * 8 + h;
        stage_taps(L, cw, cb, h, tid);
        const size_t rowbase = (size_t)b * SEQ;
#pragma unroll 1
        for (int dir = 0; dir < 2; ++dir) {
            f32x4 C[8][2];
            { const int sg = dir == 0 ? (g == 0 ? 7 : g - 1) : (g == 7 ? 0 : g + 1);
              const int slot = (bh * 8 + sg) * 2 + dir; const unsigned* ep = EST + (size_t)slot * EST_SLOT + tid;
#pragma unroll
              for (int dt = 0; dt < 8; ++dt)
#pragma unroll
                for (int nt = 0; nt < 2; ++nt) { const unsigned w0 = ep[((dt * 2 + nt) * 2 + 0) * 512], w1 = ep[((dt * 2 + nt) * 2 + 1) * 512];
                    C[dt][nt] = (f32x4){bf2f((unsigned short)(w0 & 0xffffu)), bf2f((unsigned short)(w0 >> 16)), bf2f((unsigned short)(w1 & 0xffffu)), bf2f((unsigned short)(w1 >> 16))}; }
              if (tid < 128) gl[G_NV + tid] = NST[slot * 128 + tid]; }
            ML_STAMP(30 + 2 * dir);
            bf16x8 rq[5]; float rg0 = 0.f, rg1 = 0.f;
#define B_ISSUE(ci_) do { const int t0_ = g * 512 + (ci_) * 64; \
                _Pragma("unroll") for (int i = 0; i < 5; ++i) { const int c = tid + 512 * i; const int rr = c >> 5, c5 = c & 31; int tt = t0_ - 1 + rr; \
                    const bool ok = (tt >= 0) && (tt < SEQ) && (c < 2112); tt = tt < 0 ? 0 : (tt > SEQ - 1 ? SEQ - 1 : tt); \
                    const int col = c5 < 16 ? h * 128 + c5 * 8 : 1024 + h * 128 + (c5 - 16) * 8; \
                    rq[i] = *(const bf16x8*)(Y1A + (rowbase + tt) * 4096 + col); } \
                { const float* gp = GATES + (rowbase + t0_ + (tid & 63)) * 32 + dir * 16 + h; rg0 = gp[0]; rg1 = gp[8]; } } while (0)
            B_ISSUE(dir == 0 ? 0 : 7);
            bf16x8 rv[4];
#define V_ISSUE(ci_) do { const int tv_ = g * 512 + (ci_) * 64; _Pragma("unroll") for (int i = 0; i < 4; ++i) { const int c = tid + 512 * i; \
                rv[i] = *(const bf16x8*)(Y1A + (rowbase + tv_ + (c >> 5)) * 4096 + 2048 + h * 256 + (c & 31) * 8); } } while (0)
#pragma unroll 1
            for (int st = 0; st < 8; ++st) {
                const int ci = dir == 0 ? st : 7 - st; const int t0 = g * 512 + ci * 64;
                ML_STAMP(40);
                V_ISSUE(ci);
                int lane = lane0; asm volatile("" : "+v"(lane)); const int fr = lane & 15, fq = lane >> 4;
#pragma unroll
                for (int i = 0; i < 5; ++i) { const int c = tid + 512 * i; const int tt = t0 - 1 + (c >> 5); const bool ok = (tt >= 0) && (tt < SEQ);
                    if (c < 2112) *(LAS bf16x8*)(L + OFF_RAW + (c >> 5) * (RAWS * 2) + (c & 31) * 16) = ok ? rq[i] : (bf16x8){0, 0, 0, 0, 0, 0, 0, 0}; }
                if (wid == 0) { const float ip = rg0, lf = logsig(rg1); const float v = wave_scan_incl(lf);
                    const float tot = __builtin_bit_cast(float, __builtin_amdgcn_readlane(__builtin_bit_cast(int, v), 63)); const float bb = dir == 0 ? v : tot - (v - lf);
                    gl[G_BB + lane] = bb; gl[G_CS + lane] = bb - ip; gl[G_EB + lane] = __expf(bb); gl[G_AA + lane] = __expf(tot - bb + ip); gl[G_DEN + lane] = 0.f;
                    if (lane == 0) gl[G_MISC] = __expf(tot); }
                __syncthreads(); ML_STAMP(41);
                if (st + 1 < 8) B_ISSUE(dir == 0 ? st + 1 : 6 - st);
#pragma unroll
                for (int i = 0; i < 4; ++i) { const int r = tid & 63, cgi = wid + 8 * i; float o[8]; conv_row8(L, r, cgi * 16, cgi * 8, cgi < 16 ? 1.f : 0.08838834764831845f, o);
                    pg8::u32x4 w; w.x = pkbf(o[0], o[1]); w.y = pkbf(o[2], o[3]); w.z = pkbf(o[4], o[5]); w.w = pkbf(o[6], o[7]);
                    if (cgi < 16) *(LAS pg8::u32x4*)(q_s + r * QS + cgi * 8) = w;
                    else { *(LAS pg8::u32x4*)(k_s + r * QS + (cgi - 16) * 8) = w; const float a = gl[G_AA + r]; const int d0 = (cgi - 16) * 8;
#pragma unroll
                        for (int e = 0; e < 8; ++e) kta[(d0 + e) * KTS + r] = pg8::f2bf_rne(o[e] * a); } }
#pragma unroll
                for (int i = 0; i < 4; ++i) { const int c = tid + 512 * i; *(LAS bf16x8*)(L + OFF_V + (c >> 5) * (VS * 2) + (c & 31) * 16) = rv[i]; }
                __syncthreads(); ML_STAMP(42);
                { const int mt = wid >> 1;
#pragma unroll
                  for (int q2 = 0; q2 < 2; ++q2) { const int nt = (wid & 1) * 2 + q2; f32x4 acc = (f32x4){0.f, 0.f, 0.f, 0.f};
                    const bool need = dir == 0 ? (nt <= mt) : (nt >= mt);
                    if (need) {
#pragma unroll
                      for (int kk = 0; kk < 4; ++kk) { const bf16x8 af = *(const LAS bf16x8*)(L + OFF_Q + ((mt * 16 + fr) * QS + kk * 32 + fq * 8) * 2);
                        const bf16x8 bfr = *(const LAS bf16x8*)(L + OFF_K + ((nt * 16 + fr) * QS + kk * 32 + fq * 8) * 2);
                        acc = __builtin_amdgcn_mfma_f32_16x16x32_bf16(af, bfr, acc, 0, 0, 0); } }
                    const int s = nt * 16 + fr; const float css = gl[G_CS + s];
#pragma unroll
                    for (int j = 0; j < 4; ++j) { const int t = mt * 16 + fq * 4 + j; const bool in = dir == 0 ? (s <= t) : (s >= t);
                      float w = in ? acc[j] * __expf(gl[G_BB + t] - css) : 0.f; S_s[t * SS + s] = pg8::f2bf_rne(w);
                      const float rs = sum16(w);
                      if (need && fr == 0) (void)__hip_atomic_fetch_add(&gl[G_DEN + t], rs, __ATOMIC_RELAXED, __HIP_MEMORY_SCOPE_WORKGROUP); } } }
                { const int row = wid * 8 + (lane >> 3), part = lane & 7;
                  const bf16x8 xa = *(const LAS bf16x8*)(q_s + row * QS + part * 16), xb = *(const LAS bf16x8*)(q_s + row * QS + part * 16 + 8); float s = 0.f;
#pragma unroll
                  for (int e = 0; e < 8; ++e) s += bf2f((unsigned short)xa[e]) * gl[G_NV + part * 16 + e] + bf2f((unsigned short)xb[e]) * gl[G_NV + part * 16 + 8 + e];
                  s = sum8(s);
                  if (part == 0) __hip_atomic_fetch_add(&gl[G_DEN + row], s * gl[G_EB + row], __ATOMIC_RELAXED, __HIP_MEMORY_SCOPE_WORKGROUP); }
                __syncthreads(); ML_STAMP(43);
                bf16x8 cfr[2][4];
#pragma unroll
                for (int nt = 0; nt < 2; ++nt)
#pragma unroll
                    for (int kk = 0; kk < 4; ++kk) { pg8::u32x4 w; w.x = pkbf(C[2 * kk][nt][0], C[2 * kk][nt][1]); w.y = pkbf(C[2 * kk][nt][2], C[2 * kk][nt][3]);
                        w.z = pkbf(C[2 * kk + 1][nt][0], C[2 * kk + 1][nt][1]); w.w = pkbf(C[2 * kk + 1][nt][2], C[2 * kk + 1][nt][3]); cfr[nt][kk] = __builtin_bit_cast(bf16x8, w); }
                bf16x8 vfr[2][2];
#pragma unroll
                for (int nt = 0; nt < 2; ++nt)
#pragma unroll
                    for (int kk = 0; kk < 2; ++kk) vfr[nt][kk] = vfrag(L + OFF_V, kk * 32, wid * 32 + nt * 16, lane);
#pragma unroll
                for (int mt = 0; mt < 4; ++mt) { f32x4 o2[2] = {(f32x4){0.f, 0.f, 0.f, 0.f}, (f32x4){0.f, 0.f, 0.f, 0.f}};
#pragma unroll
                    for (int kk = 0; kk < 4; ++kk) {
                        const u32x2 lo = *(const LAS u32x2*)(L + OFF_Q + ((mt * 16 + fr) * QS + kk * 32 + fq * 4) * 2), hi = *(const LAS u32x2*)(L + OFF_Q + ((mt * 16 + fr) * QS + kk * 32 + 16 + fq * 4) * 2);
                        pg8::u32x4 w; w.x = lo.x; w.y = lo.y; w.z = hi.x; w.w = hi.y; const bf16x8 af = __builtin_bit_cast(bf16x8, w);
#pragma unroll
                        for (int nt = 0; nt < 2; ++nt) o2[nt] = __builtin_amdgcn_mfma_f32_16x16x32_bf16(af, cfr[nt][kk], o2[nt], 0, 0, 0); }
#pragma unroll
                    for (int nt = 0; nt < 2; ++nt)
#pragma unroll
                        for (int j = 0; j < 4; ++j) o2[nt][j] *= gl[G_EB + mt * 16 + fq * 4 + j];
#pragma unroll
                    for (int kk = 0; kk < 2; ++kk) { const bf16x8 af = *(const LAS bf16x8*)(L + OFF_S + ((mt * 16 + fr) * SS + kk * 32 + fq * 8) * 2);
#pragma unroll
                        for (int nt = 0; nt < 2; ++nt) o2[nt] = __builtin_amdgcn_mfma_f32_16x16x32_bf16(af, vfr[nt][kk], o2[nt], 0, 0, 0); }
#pragma unroll
                    for (int j = 0; j < 4; ++j) { const int t = mt * 16 + fq * 4 + j; const float inv = __builtin_amdgcn_rcpf(fmaxf(fabsf(gl[G_DEN + t]), 1.f));
                        LAS unsigned short* hs = (LAS unsigned short*)(L + OFF_RAW + wid * 4096) + t * 32 + fr;
                        hs[0] = pg8::f2bf_rne(o2[0][j] * inv); hs[16] = pg8::f2bf_rne(o2[1][j] * inv); } }
                __builtin_amdgcn_sched_barrier(0);
                { const float ap = gl[G_MISC];
#pragma unroll
                  for (int dt = 0; dt < 8; ++dt)
#pragma unroll
                    for (int nt = 0; nt < 2; ++nt) C[dt][nt] = C[dt][nt] * ap;
#pragma unroll
                  for (int kk = 0; kk < 2; ++kk)
#pragma unroll
                    for (int dt = 0; dt < 8; ++dt) { const bf16x8 af = *(const LAS bf16x8*)(L + OFF_KTA + ((dt * 16 + fr) * KTS + kk * 32 + fq * 8) * 2);
#pragma unroll
                        for (int nt = 0; nt < 2; ++nt) C[dt][nt] = __builtin_amdgcn_mfma_f32_16x16x32_bf16(af, vfr[nt][kk], C[dt][nt], 0, 0, 0); }
                  if (tid >= 384) { const int d = tid - 384; const LAS unsigned short* rowp = kta + d * KTS; float s = 0.f;
#pragma unroll
                    for (int q = 0; q < 8; ++q) { const bf16x8 x = *(const LAS bf16x8*)(rowp + q * 8);
#pragma unroll
                        for (int e = 0; e < 8; ++e) s += bf2f((unsigned short)x[e]); }
                    gl[G_NV + d] = gl[G_NV + d] * ap + s; } }
                { const int row4 = lane >> 2, ch = lane & 3;
#pragma unroll
                  for (int ib = 0; ib < 2; ++ib) {
                    pg8::u32x4 hold[2];
                    if (dir == 1) {
#pragma unroll
                      for (int i2 = 0; i2 < 2; ++i2) hold[i2] = *(const pg8::u32x4*)(H + (rowbase + t0 + (ib * 2 + i2) * 16 + row4) * 2048 + h * 256 + wid * 32 + ch * 8); }
#pragma unroll
                    for (int i2 = 0; i2 < 2; ++i2) { const int t = (ib * 2 + i2) * 16 + row4; const pg8::u32x4 w = *(const LAS pg8::u32x4*)(L + OFF_RAW + wid * 4096 + t * 64 + ch * 16);
                      pg8::u32x4* hp = (pg8::u32x4*)(H + (rowbase + t0 + t) * 2048 + h * 256 + wid * 32 + ch * 8);
                      if (dir == 0) *hp = w;
                      else { const pg8::u32x4 o = hold[i2]; pg8::u32x4 r;
                        r.x = pkbf(bf2f((unsigned short)(o.x & 0xffffu)) + bf2f((unsigned short)(w.x & 0xffffu)), bf2f((unsigned short)(o.x >> 16)) + bf2f((unsigned short)(w.x >> 16)));
                        r.y = pkbf(bf2f((unsigned short)(o.y & 0xffffu)) + bf2f((unsigned short)(w.y & 0xffffu)), bf2f((unsigned short)(o.y >> 16)) + bf2f((unsigned short)(w.y >> 16)));
                        r.z = pkbf(bf2f((unsigned short)(o.z & 0xffffu)) + bf2f((unsigned short)(w.z & 0xffffu)), bf2f((unsigned short)(o.z >> 16)) + bf2f((unsigned short)(w.z >> 16)));
                        r.w = pkbf(bf2f((unsigned short)(o.w & 0xffffu)) + bf2f((unsigned short)(w.w & 0xffffu)), bf2f((unsigned short)(o.w >> 16)) + bf2f((unsigned short)(w.w >> 16)));
                        *hp = r; } }
                    asm volatile("" ::: "memory"); } }
                __syncthreads(); ML_STAMP(44);
            }
#undef B_ISSUE
#undef V_ISSUE
            ML_STAMP(31 + 2 * dir);
        }
    }
}
__device__ __forceinline__ void scan_phase(unsigned* __restrict__ EST, float* __restrict__ NST, const float* __restrict__ PST, const unsigned* __restrict__ CTXE, const float* __restrict__ CTXN, int bid, int G) {
    const int tid = threadIdx.x;
    for (int idx = bid * 512 + tid; idx < 64 * (int)EST_SLOT; idx += G * 512) {
        const int chain = idx >> 14, bh = chain >> 1, dir = chain & 1, e = idx & 16383;
        float s0 = 0.f, s1 = 0.f; unsigned cwd[4];
#pragma unroll
        for (int j = 0; j < 4; ++j) cwd[j] = CTXE[(size_t)((bh * 2 + dir) * 4 + j) * EST_SLOT + e];
        unsigned ew[7]; float Pw[7];
#pragma unroll
        for (int f = 0; f < 7; ++f) { const int gj = dir == 0 ? f : 7 - f; const int slot = (bh * 8 + gj) * 2 + dir; Pw[f] = PST[slot]; ew[f] = EST[(size_t)slot * EST_SLOT + e]; }
#pragma unroll
        for (int j = 0; j < 4; ++j) { s0 += bf2f((unsigned short)(cwd[j] & 0xffffu)); s1 += bf2f((unsigned short)(cwd[j] >> 16)); }
        const unsigned seedw = pkbf(s0, s1);
#pragma unroll
        for (int f = 0; f < 7; ++f) { s0 = s0 * Pw[f] + bf2f((unsigned short)(ew[f] & 0xffffu)); s1 = s1 * Pw[f] + bf2f((unsigned short)(ew[f] >> 16)); ew[f] = pkbf(s0, s1); }
        EST[(size_t)((bh * 8 + (dir == 0 ? 7 : 0)) * 2 + dir) * EST_SLOT + e] = seedw;
#pragma unroll
        for (int f = 0; f < 7; ++f) { const int gj = dir == 0 ? f : 7 - f; const int slot = (bh * 8 + gj) * 2 + dir; EST[(size_t)slot * EST_SLOT + e] = ew[f]; }
    }
    for (int idx = bid * 512 + tid; idx < 64 * 128; idx += G * 512) {
        const int chain = idx >> 7, bh = chain >> 1, dir = chain & 1, e = idx & 127;
        float s = 0.f;
#pragma unroll
        for (int j = 0; j < 4; ++j) s += CTXN[((bh * 2 + dir) * 4 + j) * 128 + e];
        const float seedn = s;
        float nw[7], Pn[7];
#pragma unroll
        for (int f = 0; f < 7; ++f) { const int gj = dir == 0 ? f : 7 - f; const int slot = (bh * 8 + gj) * 2 + dir; Pn[f] = PST[slot]; nw[f] = NST[slot * 128 + e]; }
#pragma unroll
        for (int f = 0; f < 7; ++f) { s = s * Pn[f] + nw[f]; nw[f] = s; }
#pragma unroll
        for (int f = 0; f < 7; ++f) { const int gj = dir == 0 ? f : 7 - f; const int slot = (bh * 8 + gj) * 2 + dir; NST[slot * 128 + e] = nw[f]; }
        NST[((bh * 8 + (dir == 0 ? 7 : 0)) * 2 + dir) * 128 + e] = seedn;
    }
}
}
#define XB_TMO      128
#define XB_XCNT(j)  (256  + 64 * (j))
#define XB_XSUB(j)  (1280 + 64 * (j))
#define XB_XGEN(j)  (2304 + 64 * (j))
#define XB_TOP      3328
#define XB_TOPGEN   3392
#define XCD_BAR_WORDS 3456
#define XB_SPIN_CAP (1u << 18)

__device__ __forceinline__ unsigned xb_ld(unsigned* p)              { return __hip_atomic_load(p, __ATOMIC_RELAXED, __HIP_MEMORY_SCOPE_AGENT); }
__device__ __forceinline__ unsigned xb_add(unsigned* p, unsigned v) { return __hip_atomic_fetch_add(p, v, __ATOMIC_RELAXED, __HIP_MEMORY_SCOPE_AGENT); }
__device__ __forceinline__ unsigned xb_xcc_id() { return (unsigned)__builtin_amdgcn_s_getreg((3 << 11) | 20) & 0xFu; }
#define XB_SPIN(cond, bar) do { unsigned _sp = 0; while (cond) { __builtin_amdgcn_s_sleep(1); \
    if ((++_sp & 255u) == 0u) { if (xb_ld(&(bar)[XB_TMO])) break; if (_sp > XB_SPIN_CAP) { atomicAdd(&(bar)[XB_TMO], 1u); break; } } } } while (0)

struct XcdBarrier {
    unsigned* bar; unsigned x;
    volatile LAS unsigned* st;
};

__device__ __forceinline__ XcdBarrier xcd_barrier_post(unsigned* bar, volatile LAS unsigned* st) {
    XcdBarrier b; b.bar = bar; b.x = xb_xcc_id(); b.st = st;
    if (threadIdx.x == 0) (void)xb_add(&bar[XB_XCNT(b.x)], 1u);
    return b;
}
__device__ __forceinline__ void xcd_barrier_complete(unsigned* bar, unsigned x, unsigned& nloc, unsigned& nx) {
    const unsigned G = gridDim.x * gridDim.y * gridDim.z;
    unsigned sum, cnt, mine, sp = 0u;
    for (;;) {
        sum = 0u; cnt = 0u; mine = 0u;
#pragma unroll
        for (unsigned j = 0; j < 16; ++j) { const unsigned c = xb_ld(&bar[XB_XCNT(j)]); sum += c; cnt += (c > 0u) ? 1u : 0u; mine = (j == x) ? c : mine; }
        if (sum == G) break;
        __builtin_amdgcn_s_sleep(1);
        if ((++sp & 255u) == 0u) { if (xb_ld(&bar[XB_TMO])) break; if (sp > XB_SPIN_CAP) { atomicAdd(&bar[XB_TMO], 1u); break; } }
    }
    nloc = mine > 0u ? mine : 1u; nx = cnt > 0u ? cnt : 1u;
}

__device__ __forceinline__ void xcd_barrier(const XcdBarrier& b) {
    asm volatile("s_waitcnt vmcnt(0)" ::: "memory");
    __syncthreads();
    if (threadIdx.x == 0) {
        unsigned* bar = b.bar;
        __builtin_amdgcn_s_waitcnt(0);
        unsigned nloc = b.st[0], nx = b.st[1];
        if (nloc == 0u) { xcd_barrier_complete(bar, b.x, nloc, nx); b.st[0] = nloc; b.st[1] = nx; }
        const unsigned old = xb_add(&bar[XB_XSUB(b.x)], 1u);
        const unsigned gen = old / nloc;
        if (old + 1u == (gen + 1u) * nloc) {
            __builtin_amdgcn_fence(__ATOMIC_RELEASE, "agent");
            asm volatile("s_waitcnt vmcnt(0)" ::: "memory");
            const unsigned og = xb_add(&bar[XB_TOP], 1u);
            const unsigned tg = og / nx;
            if (og + 1u == (tg + 1u) * nx) xb_add(&bar[XB_TOPGEN], 1u);
            else XB_SPIN(xb_ld(&bar[XB_TOPGEN]) == tg, bar);
            __builtin_amdgcn_fence(__ATOMIC_ACQUIRE, "agent");
            xb_add(&bar[XB_XGEN(b.x)], 1u);
            asm volatile("s_waitcnt vmcnt(0)" ::: "memory");
        } else {
            XB_SPIN(xb_ld(&bar[XB_XGEN(b.x)]) == gen, bar);
            __builtin_amdgcn_fence(__ATOMIC_ACQUIRE, "agent");
            asm volatile("s_waitcnt vmcnt(0)" ::: "memory");
        }
    }
    __syncthreads();
}

struct Args { const float* in[27]; float* out; unsigned char* ws; int ph_lo, ph_hi; };
enum { I_X = 0, I_C, I_CTX, I_CCTX, I_WMOD, I_BMOD, I_GPRE, I_GPOST, I_EWIN, I_ECW, I_ECB, I_FW1, I_FB1, I_FFREQ, I_FW2, I_FB2, I_FW3, I_HYB, I_QN, I_KN, I_EWOUT,
       I_OWIN, I_OCW, I_OCB, I_OGB, I_OHN, I_OWOUT };

__device__ __forceinline__ const float* inp(int i) {
    const __attribute__((address_space(4))) unsigned char* p = (const __attribute__((address_space(4))) unsigned char*)__builtin_amdgcn_kernarg_segment_ptr();
    asm volatile("" : "+s"(p));
    return *(const float* const __attribute__((address_space(4)))*)(p + 8 * i);
}
__global__ void __launch_bounds__(512, 2) fwd_kernel(Args a) {
    extern __shared__ __attribute__((aligned(16))) unsigned char lds_raw[];
    LAS unsigned char* lds = (LAS unsigned char*)lds_raw;
    cg::grid_group grid = cg::this_grid();
#define tid ((int)threadIdx.x)
#define lane ((int)(threadIdx.x & 63))
#define wid (__builtin_amdgcn_readfirstlane((int)(threadIdx.x >> 6)))
#define G ((int)gridDim.x)
#define bid ((int)blockIdx.x)
#define gw (bid * 8 + wid)
#define NGW (G * 8)
    unsigned char* ws = a.ws;
#define MODS ((float*)(ws + WS_MODS))
#define HDN ((bf16_t*)(ws + WS_HDN))
#define GATES ((float*)(ws + WS_GATES))
#define W0IN ((bf16_t*)(ws + WS_W0IN))
#define W0OUT ((bf16_t*)(ws + WS_W0OUT))
#define QKVG ((bf16_t*)(ws + WS_QKVG))
#define XVTL ((bf16_t*)(ws + WS_XVTL))
#define XVTC ((bf16_t*)(ws + WS_XVTC))
#define A2C ((bf16_t*)(ws + WS_A2C))
#define Y0L ((bf16_t*)(ws + WS_Y0))
#define Y0C ((float*)(ws + WS_Y0 + 32 * MiB))
#define W1OUT ((bf16_t*)(ws + WS_W1OUT))
#define W1B ((bf16_t*)(ws + WS_W1B))
#define H1 ((bf16_t*)(ws + WS_H1))
#define Y1A ((bf16_t*)(ws + WS_Y1A))
#define HB ((bf16_t*)(ws + WS_H))
#define W1A ((bf16_t*)(ws + WS_W1A))
#define OZ ((bf16_t*)(ws + WS_OZ))
#define Y1 ((bf16_t*)(ws + WS_Y1))
#define H0 ((bf16_t*)a.out)
#define A2L ((bf16_t*)a.out)
#define X1B ((bf16_t*)a.out + (size_t)MLAT * DM)
#define ESTP ((unsigned*)a.out)
#ifdef DUPPH
    const int lo = a.ph_lo, hi = a.ph_hi & 255, xm = a.ph_hi >> 8;
#define XOFF(bit) ((xm >> (bit)) & 1)
#else
    const int lo = a.ph_lo, hi = a.ph_hi;
#define XOFF(bit) 0
#endif
    volatile LAS unsigned* MISC = (volatile LAS unsigned*)(lds + 143360);
    if (tid < 2) MISC[tid] = 0u;
    __syncthreads();
    if (a.ph_lo < 0) grid.sync();
    XcdBarrier xbar = xcd_barrier_post((unsigned*)(ws + WS_CTL), MISC);
#ifndef PHMASK
#define PHMASK 0xFFFFF
#endif
#define IN(k) ((((PHMASK) >> (k)) & 1) && lo <= (k) && (k) < hi)
#if defined(PROBE_A)
#ifndef PROBE_SCALE
#define PROBE_SCALE 1.f
#endif
#define stamps ((unsigned long long*)(ws + 32768))
#define SEAM(k) do { if (IN(k) && IN((k) + 1)) { xcd_barrier(xbar); } if (((k) + 1 == PROBE_A || (k) == PROBE_A || (k) + 1 == PROBE_B || (k) == PROBE_B) && bid == 0) stamps[(k) + 1] = __builtin_amdgcn_s_memrealtime(); } while (0)
    if (bid == 0) stamps[0] = __builtin_amdgcn_s_memrealtime();
#else
#define SEAM(k) do { if (IN(k) && IN((k) + 1)) { xcd_barrier(xbar); } } while (0)
#endif

    if (IN(0)) {
        LAS float* scr = (LAS float*)(lds + wid * 16384);
        if (!XOFF(0)) for (int it = gw; it < 3328 + 1024; it += NGW) {
            if (it < 3328) { const int kb = it / 208, cb_ = it % 208;
                if (cb_ >= 128 && cb_ < 168) transpose_item<true>(inp(I_EWIN), 6656, 1024, cb_ * 32, W0IN, cb_ * 32, scr, kb, lane);
                else transpose_item(inp(I_EWIN), 6656, 1024, cb_ * 32, W0IN, cb_ * 32, scr, kb, lane); }
            else { const int r = it - 3328, kb = r / 32, cb_ = r % 32; transpose_item(inp(I_EWOUT), 1024, 2048, cb_ * 32, W0OUT, cb_ * 32, scr, kb, lane); }
        }
        if (!XOFF(1)) for (int it = bid; it < 192; it += G) {
            const int l = it / 96, r = it % 96, cc = r / 16, kc = r % 16, col = cc * 512 + tid;
            const float* wm = inp(I_WMOD) + ((size_t)l * 1024 + kc * 64) * 3072 + col; const float* cv = inp(I_C) + kc * 64; const float* ccx = inp(I_CCTX) + kc * 64;
            float acc[5] = {0.f, 0.f, 0.f, 0.f, 0.f};
            LAS float* sl = (LAS float*)lds;
            __syncthreads();
            if (tid < 320) { const int j = tid >> 6, k = tid & 63; sl[tid] = silu_f(j < 4 ? cv[j * 1024 + k] : ccx[k]); }
            __syncthreads();
#pragma unroll 16
            for (int k = 0; k < 64; ++k) { const float w = wm[(size_t)k * 3072];
#pragma unroll
                for (int j = 0; j < 5; ++j) acc[j] += sl[j * 64 + k] * w; }
            const float bm = (kc == 0) ? inp(I_BMOD)[l * 3072 + col] : 0.f;
#pragma unroll
            for (int j = 0; j < 5; ++j) atomicAdd(&MODS[(l * 5 + j) * 3072 + col], acc[j] + bm);
        }
        if (!XOFF(2)) {
            float w1r[33], w2r[64];
            { const float* w1 = inp(I_FW1); const float* w2 = inp(I_FW2);
#pragma unroll
              for (int i = 0; i < 33; ++i) w1r[i] = w1[i * 64 + lane];
#pragma unroll
              for (int i = 0; i < 64; ++i) w2r[i] = w2[i * 64 + lane]; }
            const float fr_ = inp(I_FFREQ)[lane] * 0.15915494309189535f, fb1_ = inp(I_FB1)[lane], fb2_ = inp(I_FB2)[lane];
            for (int r = gw; r < 4352; r += NGW) {
                const int n = r < 4096 ? 4096 : 256, t = r < 4096 ? r : r - 4096;
                float acc = ((float)t / (float)(n - 1)) * w1r[0];
                const float tn = (float)t / (float)n;
#pragma unroll
                for (int i = 0; i < 16; ++i) { const float band = 1e-4f + (float)i * ((15.f - 1e-4f) / 15.f); const float rev = __builtin_amdgcn_fractf(tn * band);
                    acc += __builtin_amdgcn_cosf(rev) * w1r[1 + i] - __builtin_amdgcn_sinf(rev) * w1r[17 + i]; }
                const float h1 = __builtin_amdgcn_sinf(__builtin_amdgcn_fractf(fr_ * (acc + fb1_)));
                float acc2 = 0.f;
#pragma unroll
                for (int i = 0; i < 64; ++i) acc2 += __builtin_bit_cast(float, __builtin_amdgcn_readlane(__builtin_bit_cast(int, h1), i)) * w2r[i];
                HDN[(size_t)lane * 4352 + r] = f2bf(__builtin_amdgcn_sinf(__builtin_amdgcn_fractf(fr_ * (acc2 + fb2_))));
            }
        }
    }
    SEAM(0);
    if (IN(1)) {
        for (int m0 = gw; m0 < MTOT; m0 += 4 * NGW) {
            f32x4 v[4][4];
#pragma unroll
            for (int r = 0; r < 4; ++r) { const int m = m0 + r * NGW;
                if (m < MTOT) load_row(m < MLAT ? inp(I_X) + (size_t)m * DM : inp(I_CTX) + (size_t)(m - MLAT) * DM, lane, v[r]); }
#pragma unroll
            for (int r = 0; r < 4; ++r) { const int m = m0 + r * NGW; const int j = m < MLAT ? (m >> 12) : 4;
                if (m < MTOT) { const float rstd = row_rstd(v[r]); modulate_inplace(v[r], rstd, inp(I_GPRE), MODS + (size_t)j * 3072, lane); } }
#pragma unroll
            for (int r = 0; r < 4; ++r) { const int m = m0 + r * NGW; if (m < MTOT) store_row_bf16(H0 + (size_t)m * DM, lane, v[r]); }
        }
    }
    SEAM(1);
    if (IN(2)) {
        pg8::Gemm g{H0, W0IN, MTOT, 6656, 1024, H0, 1 << 30, 1024, 0}; pg8::StaticOrder S; S.init(MTOT, 6656, G, bid); pg8::EpiL0 E{XVTL, XVTC, QKVG, inp(I_QN), inp(I_KN), (LAS float*)(lds + 131072)};
        pg8::gemm_phase<pg8::EpiL0, pg8::StaticOrder, true, true>(lds, g, S, E);
    }
    SEAM(2);
    if (IN(4)) {
        if (wid >= 4) __builtin_amdgcn_s_setprio(1);
        if ((bid >> 3) & 1) {
        for (int it = bid; it < 256; it += G) hyena_lat4(lds, (it & 7) * 128 + (it >> 3) * 4, XVTL, HDN, inp(I_FW3), inp(I_ECW), inp(I_ECB), inp(I_HYB), A2L, tid, (float*)(ws + 247 * MiB) + (size_t)bid * 8192);
        }
        __syncthreads();
        for (int u = bid; u < 768; u += G) {
            const bf16_t *Qb, *Gb; bf16_t* Ob; int seg0, seq, wrows; unsigned kb0, kb1;
            if (u < 512) { const int b = u >> 7, h = (u >> 4) & 7, qb = u & 15; const size_t q0 = (size_t)b * SEQ + qb * 256;
                Qb = QKVG + q0 * 2560 + h * 128; kb0 = (unsigned)(((size_t)b * SEQ * 2560 + 1024 + (h >> 2) * 128) * 2); kb1 = (unsigned)(((size_t)(MLAT + b * CTXL) * 2560 + 1024 + (h >> 2) * 128) * 2);
                seg0 = SEQ; seq = SEQ + CTXL; wrows = 32; Gb = QKVG + q0 * 2560 + 1536 + h * 128; Ob = A2L + q0 * 2048 + 1024 + h * 128; }
            else { const int p = u - 512, v = p >> 3, sub = p & 7, b = v >> 3, h = v & 7; const size_t q0 = (size_t)MLAT + b * CTXL;
                Qb = QKVG + (q0 + sub * 32) * 2560 + h * 128; kb0 = (unsigned)((q0 * 2560 + 1024 + (h >> 2) * 128) * 2); kb1 = kb0; seg0 = CTXL; seq = CTXL; wrows = 0;
                Gb = QKVG + (q0 + sub * 32) * 2560 + 1536 + h * 128; Ob = A2C + ((size_t)b * CTXL + sub * 32) * 2048 + 1024 + h * 128; }
            const __amdgpu_buffer_rsrc_t kvrs = __builtin_amdgcn_make_buffer_rsrc((void*)QKVG, (short)0, (int)(MTOT * 2560 * 2), 0x00020000);
            attn::attn_dense_body(Qb, kvrs, kb0, kb1, seg0, Gb, Ob, seq, (char*)lds_raw, wrows);
        }
        __syncthreads();
        if (!((bid >> 3) & 1)) {
        for (int it = bid; it < 256; it += G) hyena_lat4(lds, (it & 7) * 128 + (it >> 3) * 4, XVTL, HDN, inp(I_FW3), inp(I_ECW), inp(I_ECB), inp(I_HYB), A2L, tid, (float*)(ws + 247 * MiB) + (size_t)bid * 8192);
        }
        __syncthreads();
#if defined(PROBE_A) && defined(PROBE_P4PARTS)
        xcd_barrier(xbar); if (bid == 0 && tid == 0) stamps[20] = __builtin_amdgcn_s_memrealtime();
#endif
#ifndef NO_HYENA
#if defined(PROBE_A) && defined(PROBE_P4PARTS)
        xcd_barrier(xbar); if (bid == 0 && tid == 0) stamps[21] = __builtin_amdgcn_s_memrealtime();
#endif
        for (int it = bid; it < 256; it += G) hyena_ctx4(lds, (it & 7) * 128 + (it >> 3) * 4, XVTC, HDN + 4096, inp(I_FW3), inp(I_ECW), inp(I_ECB), inp(I_HYB), A2C, tid);
#endif
    }
    __builtin_amdgcn_s_setprio(0);
    SEAM(4);
    if (IN(5)) {
        { pg8::Gemm g{A2L, W0OUT, MLAT, 1024, 2048, A2L, 1 << 30, 2048, 0}; pg8::StaticOrder S; S.init(MLAT, 1024, G, bid); pg8::EpiBf16<0> E{Y0L, 1024, nullptr, 0, 0, 1.f};
          pg8::gemm_phase<pg8::EpiBf16<0>, pg8::StaticOrder, true, true>(lds, g, S, E); }
        { pg8::Gemm g{A2C, W0OUT, MCTX, 1024, 256, A2C, 1 << 30, 2048, 512}; pg8::SplitKOrder S{G, bid}; pg8::EpiF32Slab E{Y0C, 1024, (size_t)MCTX * 1024};
          pg8::gemm_phase<pg8::EpiF32Slab, pg8::SplitKOrder, true, true>(lds, g, S, E); }
    }
    SEAM(5);
    if (IN(6)) {
        for (int m0 = gw; m0 < MLAT; m0 += 2 * NGW) {
            f32x4 y[2][4], x[2][4];
#pragma unroll
            for (int r = 0; r < 2; ++r) { const int m = m0 + r * NGW; load_row_bf16(Y0L + (size_t)m * DM, lane, y[r]); load_row(inp(I_X) + (size_t)m * DM, lane, x[r]); }
#pragma unroll
            for (int r = 0; r < 2; ++r) { const int m = m0 + r * NGW; const int j = m >> 12; const float ry = row_rstd(y[r]);
                const float* ga = MODS + (size_t)j * 3072 + 2048;
#pragma unroll
                for (int q = 0; q < 4; ++q) { const int idx = RIX(lane, q); x[r][q] = x[r][q] + ((const f32x4*)ga)[idx] * (y[r][q] * ry * ((const f32x4*)inp(I_GPOST))[idx]); }
                const float rx = row_rstd(x[r]);
#pragma unroll
                for (int q = 0; q < 4; ++q) y[r][q] = x[r][q];
                modulate_inplace(y[r], rx, inp(I_GPRE) + DM, MODS + (size_t)(5 + j) * 3072, lane); }
#pragma unroll
            for (int r = 0; r < 2; ++r) { const int m = m0 + r * NGW; store_row_bf16(X1B + (size_t)m * DM, lane, x[r]); store_row_bf16(H1 + (size_t)m * DM, lane, y[r]); }
        }
        for (int m = MLAT + gw; m < MTOT; m += NGW) {
            f32x4 y[4], x[4];
            load_row(Y0C + (size_t)(m - MLAT) * DM, lane, y);
#pragma unroll
            for (int kc = 1; kc < 8; ++kc) { f32x4 p[4]; load_row(Y0C + (size_t)kc * MCTX * DM + (size_t)(m - MLAT) * DM, lane, p);
#pragma unroll
                for (int q = 0; q < 4; ++q) y[q] = y[q] + p[q]; }
            load_row(inp(I_CTX) + (size_t)(m - MLAT) * DM, lane, x); const float ry = row_rstd(y);
            const float* ga = MODS + (size_t)4 * 3072 + 2048;
#pragma unroll
            for (int q = 0; q < 4; ++q) { const int idx = RIX(lane, q); x[q] = x[q] + ((const f32x4*)ga)[idx] * (y[q] * ry * ((const f32x4*)inp(I_GPOST))[idx]); }
            const float rx = row_rstd(x);
            modulate_store(x, rx, inp(I_GPRE) + DM, MODS + (size_t)(5 + 4) * 3072, H1 + (size_t)m * DM, lane);
        }
        LAS float* scr = (LAS float*)(lds + wid * 16384);
        for (int it = gw; it < 2048 + 16; it += NGW) {
            if (it < 2048) { const int kb = it / 128, cb_ = it % 128; transpose_item(inp(I_OWIN), 8224, 1024, cb_ * 32, W1A, cb_ * 32, scr, kb, lane); }
            else { const int kb = it - 2048; transpose_item(inp(I_OWIN), 8224, 1024, 8192, W1A, 4096, scr, kb, lane); }
        }
    }
    SEAM(6);
    if (IN(7)) {
        pg8::Gemm g{H1, W1A, MTOT, 4352, 1024, H1, 1 << 30, 1024, 0}; pg8::StaticOrder S; S.init(MTOT, 4352, G, bid); pg8::EpiL1a E{Y1A, GATES, inp(I_OGB)};
        if (bid >= 132) { for (int i_ = 0; i_ < 4; ++i_) __builtin_amdgcn_s_sleep(127); }
        pg8::gemm_phase<pg8::EpiL1a, pg8::StaticOrder, true, true>(lds, g, S, E);
        if (bid >= 132) { LAS float* scr = (LAS float*)(lds + wid * 16384);
            for (int it = (bid - 132) * 8 + wid; it < 2048 + 1024; it += (G - 132) * 8) {
                if (it < 2048) { const int kb = it / 128, cb_ = it % 128; transpose_item(inp(I_OWIN), 8224, 1024, 4096 + cb_ * 32, W1B, cb_ * 32, scr, kb, lane); }
                else { const int r = it - 2048, kb = r / 32, cb_ = r % 32; transpose_item(inp(I_OWOUT), 1024, 2048, cb_ * 32, W1OUT, cb_ * 32, scr, kb, lane); } } }
    }
    SEAM(7);
    if (IN(8)) { if (wid >= 4) __builtin_amdgcn_s_setprio(1); }
    if (IN(8)) ml2::passA(lds, Y1A, GATES, inp(I_OCW), inp(I_OCB), ESTP, (float*)(ws + WS_NST), (float*)(ws + WS_PST), (unsigned*)(ws + WS_CTXE), (float*)(ws + WS_CTXN), bid, G);
    SEAM(8);
    if (IN(9)) ml2::scan_phase(ESTP, (float*)(ws + WS_NST), (const float*)(ws + WS_PST), (const unsigned*)(ws + WS_CTXE), (const float*)(ws + WS_CTXN), bid, G);
    SEAM(9);
    if (IN(10)) ml2::passB(lds, Y1A, GATES, inp(I_OCW), inp(I_OCB), (const unsigned*)ESTP, (const float*)(ws + WS_NST), (const float*)(ws + WS_PST), HB, bid, G, ws + 32768);
    __builtin_amdgcn_s_setprio(0);
    SEAM(10);
    if (IN(12)) {
        pg8::Gemm g{H1, W1B, MLAT, 4096, 1024, H1, 1 << 30, 1024, 0}; pg8::PairOrder S{G, bid}; pg8::EpiOZ E{HB, inp(I_OHN), (LAS float*)(lds + 131072)};
        pg8::gemm_phase<pg8::EpiOZ, pg8::PairOrder, true, true>(lds, g, S, E);
    }
    SEAM(12);
    if (IN(14)) {
        pg8::Gemm g{HB, W1OUT, MLAT, 1024, 2048, HB, 1 << 30, 2048, 0}; pg8::StaticOrder S; S.init(MLAT, 1024, G, bid); pg8::EpiBf16<0> E{Y1, 1024, nullptr, 0, 0, 1.f};
        pg8::gemm_phase<pg8::EpiBf16<0>, pg8::StaticOrder, true, true>(lds, g, S, E);
    }
    SEAM(14);
#if defined(PROBE_A) && !defined(PROBE_KEEP15)
    if (false) {
#else
    if (IN(15)) {
#endif
        f32x4 res[8][4];
#pragma unroll
        for (int r = 0; r < 8; ++r) { const int m = gw + r * NGW;
            if (m < MLAT) { f32x4 y[4], x[4], gav[4], gpv[4]; load_row_bf16(Y1 + (size_t)m * DM, lane, y); load_row_bf16(X1B + (size_t)m * DM, lane, x);
                const float* ga = MODS + (size_t)(5 + (m >> 12)) * 3072 + 2048;
#pragma unroll
                for (int q = 0; q < 4; ++q) { const int idx = RIX(lane, q); gav[q] = ((const f32x4*)ga)[idx]; gpv[q] = ((const f32x4*)(inp(I_GPOST) + DM))[idx]; }
                asm volatile("" ::: "memory");
                const float ry = row_rstd(y);
#pragma unroll
                for (int q = 0; q < 4; ++q) res[r][q] = x[q] + gav[q] * (y[q] * ry * gpv[q]); } }
        xcd_barrier(xbar);
#pragma unroll
        for (int r = 0; r < 8; ++r) { const int m = gw + r * NGW;
            if (m < MLAT) {
#pragma unroll
                for (int q = 0; q < 4; ++q) ((f32x4*)(a.out + (size_t)m * DM))[RIX(lane, q)] = res[r][q]; } }
    }
#if defined(PROBE_A)
    xcd_barrier(xbar);
    if (bid == 0) {
        stamps[NPHASE] = __builtin_amdgcn_s_memrealtime();
        __syncthreads();
#define PDUR(p) ((p) < NPHASE ? (float)(stamps[(p) + 1] - stamps[(p)]) : (p) >= 30 ? (float)(stamps[(p) + 1] - stamps[(p)]) : (p) == 20 ? (float)(stamps[20] - stamps[4]) : (p) == 21 ? (float)(stamps[21] - stamps[20]) : (float)(stamps[5] - stamps[21]))
        float ta = PDUR(PROBE_A) * 0.01f;
        ta = exp2f(rintf(2.f * log2f(ta * PROBE_SCALE) + PROBE_SHIFT) / 2.f);
#if PROBE_B >= 0
#ifdef PROBE_LIN
        float tb = PDUR(PROBE_B) * 0.01f; tb = fmaxf(8.f, rintf((tb - PROBE_T0) / PROBE_Q) * PROBE_Q * PROBE_K);
#else
        float tb = PDUR(PROBE_B) * 0.01f; tb = exp2f(rintf(2.f * log2f(tb * PROBE_SCALE) + PROBE_SHIFT) / 2.f);
#endif
#else
        const float tb = 100.f;
#endif
        for (int i = tid; i < (1 << 20); i += 512) a.out[i] = (i == 0) ? (1000.f + 10.f * ta) : tb;
    }
#endif
#undef IN
#undef SEAM
#undef tid
#undef lane
#undef wid
#undef G
#undef bid
#undef gw
#undef NGW
}

#ifndef MK_MULTI
#define MK_MULTI 0
#endif
extern "C" void kernel_launch(void* const* d_in, const int* in_sizes, int n_in, void* d_out, int out_size, void* d_ws, size_t ws_size, hipStream_t stream) {
    static int grid = 0;
    if (grid == 0) {
        if (n_in != 27 || out_size != MLAT * DM || ws_size < WS_END) { fprintf(stderr, "kernel_launch: unexpected shapes (n_in %d out %d ws %zu)\n", n_in, out_size, ws_size); grid = -1; return; }
        int dev = 0, cus = 0, per_cu = 0;
        if (hipGetDevice(&dev) != hipSuccess || hipDeviceGetAttribute(&cus, hipDeviceAttributeMultiprocessorCount, dev) != hipSuccess) { grid = -1; return; }
        if (hipFuncSetAttribute((const void*)fwd_kernel, hipFuncAttributeMaxDynamicSharedMemorySize, LDS_BYTES) != hipSuccess) { fprintf(stderr, "kernel_launch: hipFuncSetAttribute failed\n"); grid = -1; return; }
        if (hipOccupancyMaxActiveBlocksPerMultiprocessor(&per_cu, (const void*)fwd_kernel, 512, LDS_BYTES) != hipSuccess || per_cu < 1) { fprintf(stderr, "kernel_launch: occupancy query failed (%d)\n", per_cu); (void)hipGetLastError(); per_cu = 1; }
        grid = cus * (per_cu > 1 ? 1 : per_cu);
        if (grid != 256) { fprintf(stderr, "kernel_launch: this kernel's static work split assumes 256 CUs (got %d); nothing launched\n", grid); grid = -1; return; }
    }
    if (grid < 0) return;
    (void)hipMemsetAsync((char*)d_ws + WS_CTL, 0, CTL_ZERO_BYTES, stream);
    Args a{};
    for (int i = 0; i < 27; ++i) a.in[i] = (const float*)d_in[i];
    a.out = (float*)d_out; a.ws = (unsigned char*)d_ws;
#if MK_MULTI
    for (int p = 0; p < NPHASE; ++p) { a.ph_lo = p; a.ph_hi = p + 1; hipLaunchKernelGGL(fwd_kernel, dim3(grid), dim3(512), LDS_BYTES, stream, a); }
#else
    a.ph_lo = 0; a.ph_hi = NPHASE;
    void* args[] = {&a};
    hipError_t e = hipLaunchCooperativeKernel((const void*)fwd_kernel, dim3(grid), dim3(512), args, LDS_BYTES, stream);
    if (e != hipSuccess) fprintf(stderr, "kernel_launch: cooperative launch failed: %s (grid %d)\n", hipGetErrorString(e), grid);
#ifdef DUPPH
    Args a2 = a; a2.ph_lo = DUPPH; a2.ph_hi = (DUPPH + 1) | (DUPX << 8); void* args2[] = {&a2};
    for (int r = 0; r < DUPN; ++r) (void)hipLaunchCooperativeKernel((const void*)fwd_kernel, dim3(grid), dim3(512), args2, LDS_BYTES, stream);
#endif
#endif
}
```

```cpp
#include <hip/hip_runtime.h>
#include <hip/hip_cooperative_groups.h>
#include <hip/hip_bf16.h>
#include <cstdio>
#include <cstdint>
#include <cmath>
namespace cg = cooperative_groups;
namespace pg8 {
#define PG8_LAS __attribute__((address_space(3)))
typedef unsigned short bf16_t;
typedef short bf16x8 __attribute__((ext_vector_type(8)));
typedef float f32x4 __attribute__((ext_vector_type(4)));
typedef unsigned u32x4 __attribute__((ext_vector_type(4)));
constexpr int BM = 256, BK = 64, HALF = 128, HTB = HALF * BK * 2  , STAGE_BYTES = 8 * HTB, NXCD = 8, WGM = 8;

__host__ __device__ __forceinline__ int lds_byte(int r, int c) { const int st = (r >> 4) * 2 + (c >> 5), rr = r & 15, cc = c & 31, ob = rr * 64 + cc * 2; return st * 1024 + (ob ^ (((ob >> 9) & 1) << 5)); }
__host__ __device__ __forceinline__ void stage_rc(int b, int& R, int& C) { const int st = b / 1024, sb = b % 1024, swz = sb ^ (((sb >> 9) & 1) << 5); R = (st >> 1) * 16 + swz / 64; C = (st & 1) * 32 + (swz % 64) / 2; }
__host__ __device__ __forceinline__ int perm32(int rho) { const int n = rho >> 4, i = rho & 15; return 8 * (i >> 2) + 4 * n + (i & 3); }

struct Unit { int pm, pn, kc; };
struct Gemm { const bf16_t* A; const bf16_t* Bt; int M, N, K; const bf16_t* A2; int split_pm; int ld; int kcb; };

struct StaticOrder {
    int nM, nN, nwg, G, c;
    __host__ __device__ void init(int M, int N, int G_, int c_) { nM = M / BM; nN = N / BM; nwg = nM * nN; G = G_; c = c_; }
    __host__ __device__ bool next(int i, Unit& u) const {
        const long L = (long)i * G + c; if (L >= nwg) return false;
        int wgid = (int)L; { const int q = nwg / NXCD, r = nwg % NXCD, xcd = wgid % NXCD, off = wgid / NXCD; wgid = (xcd < r ? xcd * (q + 1) : r * (q + 1) + (xcd - r) * q) + off; }
        const int nig = WGM * nN, gid = wgid / nig, fm = gid * WGM, gsz = (nM - fm) < WGM ? (nM - fm) : WGM;
        u.pm = fm + ((wgid % nig) % gsz); u.pn = (wgid % nig) / gsz; u.kc = 0; return true;
    }
    __device__ __forceinline__ void a_ready(const Unit&) const {}
    __device__ __forceinline__ void done(const Unit&) const {}
};

__device__ __forceinline__ unsigned cvt_pk_bf16(float lo, float hi) { unsigned r; asm volatile("v_cvt_pk_bf16_f32 %0, %1, %2" : "=v"(r) : "v"(lo), "v"(hi)); return r; }
typedef float f32x2 __attribute__((ext_vector_type(2)));
__device__ __forceinline__ f32x2 gelu_pk(f32x2 v) {
    const f32x2 av = __builtin_elementwise_abs(v), d = av * 0.2316418882f + 1.0f;
    f32x2 t; t.x = __builtin_amdgcn_rcpf(d.x); t.y = __builtin_amdgcn_rcpf(d.y);
    f32x2 q = t * 0.5307027145f + (-0.7265760135f); q = q * t + 0.7107068705f; q = q * t + (-0.142248368f); q = q * t + 0.127414796f; q = q * t;
    const f32x2 s = (v * v) * (-0.72134752044f);
    f32x2 e; e.x = __builtin_amdgcn_exp2f(s.x); e.y = __builtin_amdgcn_exp2f(s.y);
    const f32x2 m = v * (q * e), r = v - m;
    f32x2 o; o.x = v.x < 0.f ? m.x : r.x; o.y = v.y < 0.f ? m.y : r.y; return o;
}

template <int ACT  > struct EpiBf16 {
    static constexpr bool PERM = true, AFTER_DRAIN = false; static_assert(ACT == 0 || ACT == 1, "EpiBf16: ACT is 0 (none) or 1 (gelu_pk)");
    bf16_t* O; int ldc; const float* bias; int split_cols; size_t split_stride; float scale0;
    __device__ __forceinline__ void operator()(const f32x4 (&acc)[2][2][4][2], const Unit& u, int wr, int wc, int fr, int fq) const {
        const int row0 = u.pm * BM + wr * 64 + fr; int colt = u.pn * BM; bf16_t* base = O;
        float sc = 1.f; if (split_cols) { const int t = colt / split_cols; base += (size_t)t * split_stride; colt -= t * split_cols; if (t == 0) sc = scale0; }
        const int col0 = colt + wc * 32 + 8 * fq, bcol0 = u.pn * BM + wc * 32 + 8 * fq;
        f32x4 bv[2][2];
#pragma unroll
        for (int bj = 0; bj < 2; ++bj)
#pragma unroll
            for (int n = 0; n < 2; ++n) bv[bj][n] = bias ? *(const f32x4*)(bias + bcol0 + bj * HALF + 4 * n) : (f32x4){0.f, 0.f, 0.f, 0.f};
#pragma unroll
        for (int ai = 0; ai < 2; ++ai)
#pragma unroll
            for (int m = 0; m < 4; ++m) { bf16_t* rowp = base + (size_t)(row0 + ai * HALF + m * 16) * ldc + col0;
#pragma unroll
                for (int bj = 0; bj < 2; ++bj) { f32x4 v0 = acc[ai][bj][m][0] + bv[bj][0], v1 = acc[ai][bj][m][1] + bv[bj][1];
                    if (ACT == 1) { f32x2 a = gelu_pk((f32x2){v0[0], v0[1]}), b = gelu_pk((f32x2){v0[2], v0[3]}), c = gelu_pk((f32x2){v1[0], v1[1]}), d = gelu_pk((f32x2){v1[2], v1[3]});
                        v0 = (f32x4){a.x, a.y, b.x, b.y}; v1 = (f32x4){c.x, c.y, d.x, d.y}; }
                    v0 = v0 * sc; v1 = v1 * sc; u32x4 w; w.x = cvt_pk_bf16(v0[0], v0[1]); w.y = cvt_pk_bf16(v0[2], v0[3]); w.z = cvt_pk_bf16(v1[0], v1[1]); w.w = cvt_pk_bf16(v1[2], v1[3]);
                    *(u32x4*)(rowp + bj * HALF) = w; } }
    }
};
struct EpiF32 {
    static constexpr bool PERM = false, AFTER_DRAIN = false;
    float* C; int ldc; const float* bias;
    __device__ __forceinline__ void operator()(const f32x4 (&acc)[2][2][4][2], const Unit& u, int wr, int wc, int fr, int fq) const {
        const int row0 = u.pm * BM + wr * 64 + fr, col0 = u.pn * BM + wc * 32 + 4 * fq;
        f32x4 bv[2][2];
#pragma unroll
        for (int bj = 0; bj < 2; ++bj)
#pragma unroll
            for (int n = 0; n < 2; ++n) bv[bj][n] = bias ? *(const f32x4*)(bias + col0 + bj * HALF + n * 16) : (f32x4){0.f, 0.f, 0.f, 0.f};
#pragma unroll
        for (int ai = 0; ai < 2; ++ai)
#pragma unroll
            for (int m = 0; m < 4; ++m) { float* rowp = C + (size_t)(row0 + ai * HALF + m * 16) * ldc + col0;
#pragma unroll
                for (int bj = 0; bj < 2; ++bj)
#pragma unroll
                    for (int n = 0; n < 2; ++n) *(f32x4*)(rowp + bj * HALF + n * 16) = acc[ai][bj][m][n] + bv[bj][n]; }
    }
};
template <class Epi, class Sched, bool ALIGN_EPI = false, bool SP2 = false>
__device__ __forceinline__ void gemm_phase(PG8_LAS unsigned char* lds, const Gemm g, const Sched& S, const Epi& E) {
    int tid_ = threadIdx.x; asm volatile("" : "+v"(tid_));
    const int tid = tid_, wid = __builtin_amdgcn_readfirstlane(tid >> 6), lane = tid & 63, wr = wid >> 2, wc = wid & 3, fr = lane & 15, fq = lane >> 4;
    const int K = g.K, nt = K / BK;
    unsigned voffA[2], voffB[2];
#pragma unroll
    for (int i = 0; i < 2; ++i) { int R, C; stage_rc(tid * 16 + i * 8192, R, C); const int Rb = Epi::PERM ? ((R & ~31) + perm32(R & 31)) : R;
        voffA[i] = (unsigned)(R * g.ld + C) * 2u; voffB[i] = (unsigned)(Rb * g.ld + C) * 2u; }
    const size_t kstep = (size_t)(BK * 2);
    const size_t hstep = (size_t)HALF * g.ld * 2;
    const size_t tstep = 2 * hstep;
    const unsigned ldsw = (unsigned)wid * 1024u;
    const int aoff = lds_byte(wr * 64 + fr, fq * 8), boff = lds_byte(wc * 32 + fr, fq * 8);
#define PG8_ABASE(pm_) (((pm_) < g.split_pm) ? ((const char*)g.A + (size_t)(pm_) * tstep) : ((const char*)g.A2 + (size_t)((pm_) - g.split_pm) * tstep))
#define PG8_SA(b, h) (((b) * 2 + (h)) * HTB)
#define PG8_SB(b, h) ((4 + (b) * 2 + (h)) * HTB)
#define PG8_STAGE(bufoff, gbase, voff) do { _Pragma("unroll") for (int _i = 0; _i < 2; ++_i) \
        __builtin_amdgcn_global_load_lds((const unsigned*)((const char*)(gbase) + (voff)[_i]), (PG8_LAS unsigned*)(lds + (bufoff) + ldsw + _i * 8192), 16, 0, 0); } while (0)
#define PG8_LDA(dst, b, h) do { _Pragma("unroll") for (int m = 0; m < 4; ++m) _Pragma("unroll") for (int k = 0; k < 2; ++k) dst[m][k] = *(const PG8_LAS bf16x8*)(lds + PG8_SA(b, h) + aoff + m * 2048 + k * 1024); } while (0)
#define PG8_LDB(dst, b, h) do { _Pragma("unroll") for (int n = 0; n < 2; ++n) _Pragma("unroll") for (int k = 0; k < 2; ++k) dst[n][k] = *(const PG8_LAS bf16x8*)(lds + PG8_SB(b, h) + boff + n * 2048 + k * 1024); } while (0)
#define PG8_MMA(ai, bj, At, Bt) do { __builtin_amdgcn_s_setprio(1); _Pragma("unroll") for (int m = 0; m < 4; ++m) _Pragma("unroll") for (int n = 0; n < 2; ++n) _Pragma("unroll") for (int k = 0; k < 2; ++k) \
        acc[ai][bj][m][n] = __builtin_amdgcn_mfma_f32_16x16x32_bf16(Bt[n][k], At[m][k], acc[ai][bj][m][n], 0, 0, 0); __builtin_amdgcn_s_setprio(0); } while (0)
#define PG8_WAIT_V(n) asm volatile("s_waitcnt vmcnt(" #n ")" ::: "memory")
#define PG8_WAIT_L(n) asm volatile("s_waitcnt lgkmcnt(" #n ")" ::: "memory")
#define PG8_BAR __builtin_amdgcn_s_barrier()
#define PG8_SCHED __builtin_amdgcn_sched_barrier(0)
    Unit cur, nxt; int ui = 0;
    if (!S.next(0, cur)) return;
    f32x4 acc[2][2][4][2];
#pragma unroll
    for (int a = 0; a < 2; ++a)
#pragma unroll
        for (int b = 0; b < 2; ++b)
#pragma unroll
            for (int m = 0; m < 4; ++m)
#pragma unroll
                for (int n = 0; n < 2; ++n) acc[a][b][m][n] = (f32x4){0.f, 0.f, 0.f, 0.f};
    bf16x8 At[4][2], B0[2][2], B1[2][2];
    const char* cA = PG8_ABASE(cur.pm) + (size_t)cur.kc * g.kcb; const char* cB = (const char*)g.Bt + (size_t)cur.pn * tstep + (size_t)cur.kc * g.kcb;
    S.a_ready(cur);
    if constexpr (SP2) {
        PG8_STAGE(PG8_SB(0, 0), cB, voffB); PG8_STAGE(PG8_SB(0, 1), cB + hstep, voffB); PG8_STAGE(PG8_SA(0, 0), cA, voffA); PG8_STAGE(PG8_SA(0, 1), cA + hstep, voffA);
        if (wr == 1) PG8_BAR;
        PG8_WAIT_V(2); PG8_BAR;
        PG8_STAGE(PG8_SB(1, 0), cB + kstep, voffB); PG8_STAGE(PG8_SA(1, 0), cA + kstep, voffA); PG8_STAGE(PG8_SB(1, 1), cB + hstep + kstep, voffB);
        PG8_WAIT_V(6); PG8_BAR;
    } else {
        PG8_STAGE(PG8_SB(0, 0), cB, voffB); PG8_STAGE(PG8_SA(0, 0), cA, voffA); PG8_STAGE(PG8_SB(0, 1), cB + hstep, voffB); PG8_STAGE(PG8_SA(0, 1), cA + hstep, voffA);
        if (wr == 1) PG8_BAR;
        PG8_WAIT_V(4); PG8_BAR;
        PG8_STAGE(PG8_SB(1, 0), cB + kstep, voffB); PG8_STAGE(PG8_SA(1, 0), cA + kstep, voffA); PG8_STAGE(PG8_SB(1, 1), cB + hstep + kstep, voffB);
        PG8_WAIT_V(6); PG8_BAR;
    }
    for (;;) {
        const bool has_next = S.next(ui + 1, nxt);
        const char* nA = has_next ? PG8_ABASE(nxt.pm) + (size_t)nxt.kc * g.kcb : cA; const char* nB = has_next ? (const char*)g.Bt + (size_t)nxt.pn * tstep + (size_t)nxt.kc * g.kcb : cB;
        for (int t = 0; t < nt; t += 2) {
            const bool last = (t == nt - 2);
            const char* a1 = cA + (size_t)(t + 1) * kstep;
            const char* a2 = last ? nA : cA + (size_t)(t + 2) * kstep; const char* b2 = last ? nB : cB + (size_t)(t + 2) * kstep;
            const char* a3 = a2 + kstep; const char* b3 = b2 + kstep;
            if (last && has_next) S.a_ready(nxt);
            if constexpr (SP2) {
            PG8_LDB(B0, 0, 0); PG8_LDB(B1, 0, 1); PG8_SCHED; PG8_LDA(At, 0, 0); PG8_STAGE(PG8_SA(1, 1), a1 + hstep, voffA);
            PG8_WAIT_V(8); PG8_WAIT_L(0); PG8_BAR; PG8_MMA(0, 0, At, B0); PG8_MMA(0, 1, At, B1); PG8_BAR; PG8_SCHED;
            PG8_LDA(At, 0, 1); PG8_STAGE(PG8_SB(0, 0), b2, voffB); PG8_STAGE(PG8_SB(0, 1), b2 + hstep, voffB); PG8_STAGE(PG8_SA(0, 0), a2, voffA);
            PG8_WAIT_V(8); PG8_WAIT_L(0); PG8_BAR; PG8_MMA(1, 0, At, B0); PG8_MMA(1, 1, At, B1); PG8_BAR; PG8_SCHED;
            PG8_LDB(B0, 1, 0); PG8_LDB(B1, 1, 1); PG8_SCHED; PG8_LDA(At, 1, 0); PG8_STAGE(PG8_SA(0, 1), a2 + hstep, voffA);
            PG8_WAIT_V(8); PG8_WAIT_L(0); PG8_BAR; PG8_MMA(0, 0, At, B0); PG8_MMA(0, 1, At, B1); PG8_BAR; PG8_SCHED;
            PG8_LDA(At, 1, 1); PG8_STAGE(PG8_SB(1, 0), b3, voffB); PG8_STAGE(PG8_SB(1, 1), b3 + hstep, voffB); PG8_STAGE(PG8_SA(1, 0), a3, voffA);
            PG8_WAIT_V(8); PG8_WAIT_L(0); PG8_BAR; PG8_MMA(1, 0, At, B0); PG8_MMA(1, 1, At, B1); PG8_BAR; PG8_SCHED;
            } else {
            PG8_LDB(B0, 0, 0); PG8_SCHED; PG8_LDA(At, 0, 0); PG8_STAGE(PG8_SA(1, 1), a1 + hstep, voffA);
            PG8_WAIT_L(8); PG8_BAR; PG8_WAIT_L(0); PG8_MMA(0, 0, At, B0); PG8_BAR; PG8_SCHED;
            PG8_LDB(B1, 0, 1); PG8_STAGE(PG8_SB(0, 0), b2, voffB);
            PG8_BAR; PG8_WAIT_L(0); PG8_MMA(0, 1, At, B1); PG8_BAR;
            PG8_LDA(At, 0, 1); PG8_STAGE(PG8_SA(0, 0), a2, voffA);
            PG8_BAR; PG8_WAIT_L(0); PG8_MMA(1, 0, At, B0); PG8_BAR; PG8_SCHED;
            PG8_STAGE(PG8_SB(0, 1), b2 + hstep, voffB);
            PG8_WAIT_V(6); PG8_BAR; PG8_MMA(1, 1, At, B1); PG8_BAR;
            PG8_LDB(B0, 1, 0); PG8_SCHED; PG8_LDA(At, 1, 0); PG8_STAGE(PG8_SA(0, 1), a2 + hstep, voffA);
            PG8_WAIT_L(8); PG8_BAR; PG8_WAIT_L(0); PG8_MMA(0, 0, At, B0); PG8_BAR; PG8_SCHED;
            PG8_LDB(B1, 1, 1); PG8_STAGE(PG8_SB(1, 0), b3, voffB);
            PG8_BAR; PG8_WAIT_L(0); PG8_MMA(0, 1, At, B1); PG8_BAR;
            PG8_LDA(At, 1, 1); PG8_STAGE(PG8_SA(1, 0), a3, voffA);
            PG8_BAR; PG8_WAIT_L(0); PG8_MMA(1, 0, At, B0); PG8_BAR; PG8_SCHED;
            PG8_STAGE(PG8_SB(1, 1), b3 + hstep, voffB);
            PG8_WAIT_V(6); PG8_BAR; PG8_MMA(1, 1, At, B1); PG8_BAR;
            }
        }
        if constexpr (ALIGN_EPI) { if (wr == 0) PG8_BAR; }
        if constexpr (!Epi::AFTER_DRAIN) { E(acc, cur, wr, wc, fr, fq); S.done(cur); }
        if (!has_next) break;
#pragma unroll
        for (int a = 0; a < 2; ++a)
#pragma unroll
            for (int b = 0; b < 2; ++b)
#pragma unroll
                for (int m = 0; m < 4; ++m)
#pragma unroll
                    for (int n = 0; n < 2; ++n) acc[a][b][m][n] = (f32x4){0.f, 0.f, 0.f, 0.f};
        cur = nxt; cA = nA; cB = nB; ++ui;
        if constexpr (ALIGN_EPI) { if (wr == 1) PG8_BAR; }
    }
    PG8_WAIT_V(0);
    if constexpr (!ALIGN_EPI) { if (wr == 0) PG8_BAR; }
    PG8_BAR;
    if constexpr (Epi::AFTER_DRAIN) { E.fused(acc, cur, wr, wc, fr, fq, lds, wid, lane); S.done(cur); }
#undef PG8_SA
#undef PG8_ABASE
#undef PG8_SB
#undef PG8_STAGE
#undef PG8_LDA
#undef PG8_LDB
#undef PG8_MMA
#undef PG8_WAIT_V
#undef PG8_WAIT_L
#undef PG8_BAR
#undef PG8_SCHED
}
}
namespace pg8 {
typedef float f32x2_t __attribute__((ext_vector_type(2))); typedef __bf16 bf16x2_t __attribute__((ext_vector_type(2)));
__device__ __forceinline__ unsigned cvtpk_hw(float lo, float hi) { f32x2_t v = {lo, hi}; bf16x2_t b = __builtin_convertvector(v, bf16x2_t); return __builtin_bit_cast(unsigned, b); }
__device__ __forceinline__ unsigned short f2bf_rne(float f) { return (unsigned short)(cvtpk_hw(f, 0.f) & 0xffffu); }
struct EpiL0 {
    static constexpr bool PERM = true, AFTER_DRAIN = false;
    bf16_t* xvt_lat; bf16_t* xvt_ctx; bf16_t* qkvg; const float* qn; const float* kn; PG8_LAS float* xch;
    __device__ __forceinline__ void operator()(f32x4 (&acc)[2][2][4][2], const Unit& u, int wr, int wc, int fr, int fq) const {
        if (u.pn >= 16 && u.pn <= 20) {
            const float* gw = u.pn < 20 ? qn : kn; const bool lat = u.pm < 64;
#pragma unroll
            for (int ai = 0; ai < 2; ++ai)
#pragma unroll
                for (int m = 0; m < 4; ++m)
#pragma unroll
                    for (int bj = 0; bj < 2; ++bj) { const f32x4 v0 = acc[ai][bj][m][0], v1 = acc[ai][bj][m][1];
                        float ss = (v0[0] * v0[0] + v0[1] * v0[1]) + (v0[2] * v0[2] + v0[3] * v0[3]) + (v1[0] * v1[0] + v1[1] * v1[1]) + (v1[2] * v1[2] + v1[3] * v1[3]);
                        ss += __shfl_xor(ss, 16); ss += __shfl_xor(ss, 32);
                        if (fq == 0) xch[((ai * HALF + wr * 64 + m * 16 + fr) * 2 + bj) * 4 + wc] = ss; }
            asm volatile("s_waitcnt lgkmcnt(0)" ::: "memory"); __builtin_amdgcn_s_barrier(); asm volatile("" ::: "memory");
            const int kb = 16 * wc + 4 * fq;
            const int ob = wc < 2 ? kb : kb + 32;
            float iv[4];
#pragma unroll
            for (int q = 0; q < 4; ++q) { iv[q] = __builtin_amdgcn_exp2f(-(float)((kb + q) & 31) * (13.287712379549449f / 32.f)) * 0.15915494309189535f; }
            const int row0 = u.pm * BM + wr * 64 + fr; const int col0 = (u.pn - 16) * BM + wc * 32 + 8 * fq;
#pragma unroll
            for (int ai = 0; ai < 2; ++ai)
#pragma unroll
                for (int m = 0; m < 4; ++m) { const int rl = ai * HALF + wr * 64 + m * 16 + fr; const int t = (u.pm * BM + rl) & 4095; const float pos = (float)(wc < 2 ? (t >> 6) : (t & 63));
                    float cs[4], sn[4];
#pragma unroll
                    for (int q = 0; q < 4; ++q) { const float a = pos * iv[q]; cs[q] = lat ? __builtin_amdgcn_cosf(a) : 1.f; sn[q] = lat ? __builtin_amdgcn_sinf(a) : 0.f; }
                    bf16_t* rowp = qkvg + (size_t)(row0 + ai * HALF + m * 16) * 2560 + col0;
                    asm volatile("" ::: "memory");
                    const f32x4 gA = *(const f32x4*)(gw + ob), gB = *(const f32x4*)(gw + ob + 32); const float g1[4] = {gA[0], gA[1], gA[2], gA[3]}, g2[4] = {gB[0], gB[1], gB[2], gB[3]};
#pragma unroll
                    for (int bj = 0; bj < 2; ++bj) { const f32x4 p = *(const PG8_LAS f32x4*)(xch + (rl * 2 + bj) * 4); const float r = __builtin_amdgcn_rsqf(((p[0] + p[1]) + (p[2] + p[3])) * (1.f / 128.f) + 1e-6f);
                        const f32x4 v0 = acc[ai][bj][m][0], v1 = acc[ai][bj][m][1];
                        const float a0 = v0[0] * r * g1[0], b0 = v0[1] * r * g2[0], a1 = v0[2] * r * g1[1], b1 = v0[3] * r * g2[1];
                        const float a2 = v1[0] * r * g1[2], b2 = v1[1] * r * g2[2], a3 = v1[2] * r * g1[3], b3 = v1[3] * r * g2[3];
                        u32x4 w; w.x = cvt_pk_bf16(a0 * cs[0] - b0 * sn[0], a0 * sn[0] + b0 * cs[0]); w.y = cvt_pk_bf16(a1 * cs[1] - b1 * sn[1], a1 * sn[1] + b1 * cs[1]);
                        w.z = cvt_pk_bf16(a2 * cs[2] - b2 * sn[2], a2 * sn[2] + b2 * cs[2]); w.w = cvt_pk_bf16(a3 * cs[3] - b3 * sn[3], a3 * sn[3] + b3 * cs[3]);
                        *(u32x4*)(rowp + bj * HALF) = w; } }
        } else if (u.pn >= 16) {
            const int row0 = u.pm * BM + wr * 64 + fr; const int col0 = (u.pn - 16) * BM + wc * 32 + 8 * fq;
#pragma unroll
            for (int ai = 0; ai < 2; ++ai)
#pragma unroll
                for (int m = 0; m < 4; ++m) { bf16_t* rowp = qkvg + (size_t)(row0 + ai * HALF + m * 16) * 2560 + col0;
#pragma unroll
                    for (int bj = 0; bj < 2; ++bj) { const f32x4 v0 = acc[ai][bj][m][0], v1 = acc[ai][bj][m][1];
                        u32x4 w; w.x = cvt_pk_bf16(v0[0], v0[1]); w.y = cvt_pk_bf16(v0[2], v0[3]); w.z = cvt_pk_bf16(v1[0], v1[1]); w.w = cvt_pk_bf16(v1[2], v1[3]);
                        *(u32x4*)(rowp + bj * HALF) = w; } }
        } else {
            bf16_t* dst; int nt, t0;
            if (u.pm < 64) { const int b = u.pm >> 4; nt = 4096; t0 = (u.pm & 15) * 256; dst = xvt_lat + (size_t)b * 4096 * 4096; }
            else { const int b = u.pm - 64; nt = 256; t0 = 0; dst = xvt_ctx + (size_t)b * 4096 * 256; }
            const int ch0 = u.pn * BM + wc * 32 + 8 * fq; const int tl0 = t0 + wr * 64 + fr;
#pragma unroll
            for (int bj = 0; bj < 2; ++bj)
#pragma unroll
                for (int n = 0; n < 2; ++n)
#pragma unroll
                    for (int j = 0; j < 4; ++j) { bf16_t* cp = dst + (size_t)(ch0 + bj * HALF + 4 * n + j) * nt + tl0;
#pragma unroll
                        for (int ai = 0; ai < 2; ++ai)
#pragma unroll
                            for (int m = 0; m < 4; ++m) cp[ai * HALF + m * 16] = f2bf_rne(acc[ai][bj][m][n][j]); }
        }
    }
};
struct EpiL1a {
    static constexpr bool PERM = true, AFTER_DRAIN = false;
    bf16_t* y; float* gates; const float* gate_b;
    __device__ __forceinline__ void operator()(const f32x4 (&acc)[2][2][4][2], const Unit& u, int wr, int wc, int fr, int fq) const {
        const int row0 = u.pm * BM + wr * 64 + fr;
        if (u.pn < 16) {
            const int col0 = u.pn * BM + wc * 32 + 8 * fq;
#pragma unroll
            for (int ai = 0; ai < 2; ++ai)
#pragma unroll
                for (int m = 0; m < 4; ++m) { bf16_t* rowp = y + (size_t)(row0 + ai * HALF + m * 16) * 4096 + col0;
#pragma unroll
                    for (int bj = 0; bj < 2; ++bj) { const f32x4 v0 = acc[ai][bj][m][0], v1 = acc[ai][bj][m][1];
                        u32x4 w; w.x = cvt_pk_bf16(v0[0], v0[1]); w.y = cvt_pk_bf16(v0[2], v0[3]); w.z = cvt_pk_bf16(v1[0], v1[1]); w.w = cvt_pk_bf16(v1[2], v1[3]);
                        *(u32x4*)(rowp + bj * HALF) = w; } }
        } else if (wc == 0) {
            const int c0 = 8 * fq;
            const f32x4 b0 = *(const f32x4*)(gate_b + c0), b1 = *(const f32x4*)(gate_b + c0 + 4);
#pragma unroll
            for (int ai = 0; ai < 2; ++ai)
#pragma unroll
                for (int m = 0; m < 4; ++m) { float* rowp = gates + (size_t)(row0 + ai * HALF + m * 16) * 32 + c0;
                    *(f32x4*)(rowp) = acc[ai][0][m][0] + b0; *(f32x4*)(rowp + 4) = acc[ai][0][m][1] + b1; }
        }
    }
};
struct EpiF32Slab {
    static constexpr bool PERM = false, AFTER_DRAIN = false;
    float* C; int ldc; size_t slab;
    __device__ __forceinline__ void operator()(const f32x4 (&acc)[2][2][4][2], const Unit& u, int wr, int wc, int fr, int fq) const {
        const int row0 = u.pm * BM + wr * 64 + fr, col0 = u.pn * BM + wc * 32 + 4 * fq; float* Cs = C + (size_t)u.kc * slab;
#pragma unroll
        for (int ai = 0; ai < 2; ++ai)
#pragma unroll
            for (int m = 0; m < 4; ++m) { float* rowp = Cs + (size_t)(row0 + ai * HALF + m * 16) * ldc + col0;
#pragma unroll
                for (int bj = 0; bj < 2; ++bj)
#pragma unroll
                    for (int n = 0; n < 2; ++n) *(f32x4*)(rowp + bj * HALF + n * 16) = acc[ai][bj][m][n]; }
    }
};
struct SplitKOrder {
    int G, c;
    __device__ bool next(int i, Unit& u) const { const int L = i * G + c; if (L >= 128) return false; u.kc = L & 7; u.pm = (L >> 3) >> 2; u.pn = (L >> 3) & 3; return true; }
    __device__ __forceinline__ void a_ready(const Unit&) const {}
    __device__ __forceinline__ void done(const Unit&) const {}
};
}

namespace pg8 {
struct EpiOZ {
    static constexpr bool PERM = true, AFTER_DRAIN = false;
    bf16_t* hb; const float* hn; PG8_LAS float* xch;
    __device__ __forceinline__ static float bflo(unsigned w) { return __builtin_bit_cast(float, w << 16); }
    __device__ __forceinline__ static float bfhi(unsigned w) { return __builtin_bit_cast(float, w & 0xffff0000u); }
    __device__ __forceinline__ void operator()(f32x4 (&acc)[2][2][4][2], const Unit& u, int wr, int wc, int fr, int fq) const {
        const int row0 = u.pm * BM + wr * 64 + fr;
        if (u.pn < 8) {
            const int col0 = u.pn * BM + wc * 32 + 8 * fq;
#pragma unroll
            for (int ai = 0; ai < 2; ++ai)
#pragma unroll
                for (int m = 0; m < 4; ++m) { const bf16_t* rowp = hb + (size_t)(row0 + ai * HALF + m * 16) * 2048 + col0; float ss = 0.f;
#pragma unroll
                    for (int bj = 0; bj < 2; ++bj) { const u32x4 hv = *(const u32x4*)(rowp + bj * HALF); f32x4& v0 = acc[ai][bj][m][0]; f32x4& v1 = acc[ai][bj][m][1];
                        v0[0] = bflo(hv.x) * __builtin_amdgcn_rcpf(1.f + __expf(-v0[0])); v0[1] = bfhi(hv.x) * __builtin_amdgcn_rcpf(1.f + __expf(-v0[1])); v0[2] = bflo(hv.y) * __builtin_amdgcn_rcpf(1.f + __expf(-v0[2])); v0[3] = bfhi(hv.y) * __builtin_amdgcn_rcpf(1.f + __expf(-v0[3]));
                        v1[0] = bflo(hv.z) * __builtin_amdgcn_rcpf(1.f + __expf(-v1[0])); v1[1] = bfhi(hv.z) * __builtin_amdgcn_rcpf(1.f + __expf(-v1[1])); v1[2] = bflo(hv.w) * __builtin_amdgcn_rcpf(1.f + __expf(-v1[2])); v1[3] = bfhi(hv.w) * __builtin_amdgcn_rcpf(1.f + __expf(-v1[3]));
                        ss += (v0[0] * v0[0] + v0[1] * v0[1]) + (v0[2] * v0[2] + v0[3] * v0[3]) + (v1[0] * v1[0] + v1[1] * v1[1]) + (v1[2] * v1[2] + v1[3] * v1[3]); }
                    ss += __shfl_xor(ss, 16); ss += __shfl_xor(ss, 32);
                    if (fq == 0) xch[(ai * HALF + wr * 64 + m * 16 + fr) * 4 + wc] = ss; }
            asm volatile("s_waitcnt lgkmcnt(0)" ::: "memory"); __builtin_amdgcn_s_barrier(); asm volatile("" ::: "memory");
#pragma unroll
            for (int bj = 0; bj < 2; ++bj) { const f32x4 g0 = *(const f32x4*)(hn + col0 + bj * HALF), g1 = *(const f32x4*)(hn + col0 + bj * HALF + 4);
#pragma unroll
                for (int ai = 0; ai < 2; ++ai)
#pragma unroll
                    for (int m = 0; m < 4; ++m) { const int rl = ai * HALF + wr * 64 + m * 16 + fr; const f32x4 p = *(const PG8_LAS f32x4*)(xch + rl * 4);
                        const float r = __builtin_amdgcn_rsqf(((p[0] + p[1]) + (p[2] + p[3])) * (1.f / 256.f) + 1e-6f);
                        bf16_t* rowp = hb + (size_t)(row0 + ai * HALF + m * 16) * 2048 + col0;
                        const f32x4 v0 = acc[ai][bj][m][0] * r * g0, v1 = acc[ai][bj][m][1] * r * g1;
                        u32x4 w; w.x = cvt_pk_bf16(v0[0], v0[1]); w.y = cvt_pk_bf16(v0[2], v0[3]); w.z = cvt_pk_bf16(v1[0], v1[1]); w.w = cvt_pk_bf16(v1[2], v1[3]);
                        *(u32x4*)(rowp + bj * HALF) = w; } }
        } else {
            const int col0 = (u.pn - 8) * BM + wc * 32 + 8 * fq;
#pragma unroll
            for (int ai = 0; ai < 2; ++ai)
#pragma unroll
                for (int m = 0; m < 4; ++m) { bf16_t* rowp = hb + (size_t)(row0 + ai * HALF + m * 16) * 2048 + col0;
                    const u32x4 hq[2] = {*(const u32x4*)rowp, *(const u32x4*)(rowp + HALF)};
#pragma unroll
                    for (int bj = 0; bj < 2; ++bj) { const u32x4 hv = hq[bj]; const f32x4 a0 = acc[ai][bj][m][0], a1 = acc[ai][bj][m][1];
                        u32x4 w; w.x = cvt_pk_bf16(bflo(hv.x) * a0[0] * __builtin_amdgcn_rcpf(1.f + __expf(-a0[0])), bfhi(hv.x) * a0[1] * __builtin_amdgcn_rcpf(1.f + __expf(-a0[1])));
                        w.y = cvt_pk_bf16(bflo(hv.y) * a0[2] * __builtin_amdgcn_rcpf(1.f + __expf(-a0[2])), bfhi(hv.y) * a0[3] * __builtin_amdgcn_rcpf(1.f + __expf(-a0[3])));
                        w.z = cvt_pk_bf16(bflo(hv.z) * a1[0] * __builtin_amdgcn_rcpf(1.f + __expf(-a1[0])), bfhi(hv.z) * a1[1] * __builtin_amdgcn_rcpf(1.f + __expf(-a1[1])));
                        w.w = cvt_pk_bf16(bflo(hv.w) * a1[2] * __builtin_amdgcn_rcpf(1.f + __expf(-a1[2])), bfhi(hv.w) * a1[3] * __builtin_amdgcn_rcpf(1.f + __expf(-a1[3])));
                        *(u32x4*)(rowp + bj * HALF) = w; } }
        }
    }
};
struct PairOrder {
    int G, c;
    __device__ bool next(int i, Unit& u) const { const int r = i >> 1; if (r >= 512 / G) return false; const int x = c & 7, y = c >> 3, head = y & 7; u.pm = r * (G >> 3) + x * (G >> 6) + (y >> 3); u.pn = (i & 1) ? 8 + head : head; u.kc = 0; return true; }
    __device__ __forceinline__ void a_ready(const Unit&) const {}
    __device__ __forceinline__ void done(const Unit&) const {}
};
}
namespace attn {
using bf16 = unsigned short;
constexpr int D = 128, NW = 8, QBLK = 32, KVBLK = 64;
constexpr float SCALE = 0.088388347648318440f;
constexpr float THR = 8.f;
constexpr int SDEPTH = 2;
constexpr int LDQ = 2560, LDK = 2560, LDO = 2048, VOFF = 256, GOFF = 1536;
constexpr size_t SHM_V = KVBLK * D * 2, SHM_K = KVBLK * D * 2, SHM_ATTN = 2 * SHM_V + 2 * SHM_K + NW * 64 * 4;
using bf16x8 = __attribute__((ext_vector_type(8))) short;
using s16x4  = __attribute__((ext_vector_type(4))) short;
using f32x16 = __attribute__((ext_vector_type(16))) float;
using u32x4  = __attribute__((ext_vector_type(4))) unsigned;
#define KSWZ(row, colB) ((row) * 256 + ((colB) ^ (((row) & 7) << 4)))
#define SBAR() __builtin_amdgcn_sched_barrier(0)
__device__ __forceinline__ int crow(int r, int hi) { return (r & 3) + 8 * (r >> 2) + 4 * hi; }
__device__ __forceinline__ unsigned cvtpk(float lo, float hi) { unsigned r; asm volatile("v_cvt_pk_bf16_f32 %0, %1, %2" : "=v"(r) : "v"(lo), "v"(hi)); return r; }
__device__ __forceinline__ bf16x8 ld8(const bf16* p) { return *reinterpret_cast<const bf16x8*>(p); }
__device__ __forceinline__ void partialSM(f32x16& p0, f32x16& p1, float& m_reg, float& mn, float& alpha) {
  constexpr float C = SCALE * 1.4426950408889634f;
  float pmax = p0[0]; for (int r = 1; r < 16; ++r) pmax = fmaxf(pmax, p0[r]); for (int r = 0; r < 16; ++r) pmax = fmaxf(pmax, p1[r]);
  { auto rr = __builtin_amdgcn_permlane32_swap(__float_as_uint(pmax), __float_as_uint(pmax), false, false);
    pmax = fmaxf(__uint_as_float(rr[0]), __uint_as_float(rr[1])); }
  if (__builtin_expect(__all(pmax - m_reg <= THR / SCALE), 1)) { mn = m_reg; alpha = 1.f; }
  else { mn = fmaxf(m_reg, pmax); alpha = __builtin_amdgcn_exp2f((m_reg - mn) * C); m_reg = mn; }
  float mnC = -mn * C;
  for (int r = 0; r < 16; ++r) p0[r] = fmaf(p0[r], C, mnC); for (int r = 0; r < 16; ++r) p1[r] = fmaf(p1[r], C, mnC);
  for (int r = 0; r < 16; ++r) p0[r] = __builtin_amdgcn_exp2f(p0[r]);
}
__device__ __forceinline__ void finishSM(f32x16& p0, f32x16& p1, float alpha, float& l_reg, bf16x8& pa0, bf16x8& pa1, bf16x8& pa2, bf16x8& pa3) {
  for (int r = 0; r < 16; ++r) p1[r] = __builtin_amdgcn_exp2f(p1[r]);
  float ps = 0; for (int r = 0; r < 16; ++r) ps += p0[r]; for (int r = 0; r < 16; ++r) ps += p1[r];
  { auto rr = __builtin_amdgcn_permlane32_swap(__float_as_uint(ps), __float_as_uint(ps), false, false);
    ps = __uint_as_float(rr[0]) + __uint_as_float(rr[1]); }
  l_reg = l_reg * alpha + ps;
#define PK4(P, BASE, OUT) do { unsigned a0 = cvtpk(P[BASE + 0], P[BASE + 1]), a1 = cvtpk(P[BASE + 2], P[BASE + 3]);   \
    unsigned b0 = cvtpk(P[BASE + 4], P[BASE + 5]), b1 = cvtpk(P[BASE + 6], P[BASE + 7]);                              \
    auto r0 = __builtin_amdgcn_permlane32_swap(a0, b0, false, false); auto r1 = __builtin_amdgcn_permlane32_swap(a1, b1, false, false); \
    u32x4 w = {r0[0], r1[0], r0[1], r1[1]}; OUT = *reinterpret_cast<bf16x8*>(&w); } while (0)
  PK4(p0, 0, pa0); PK4(p0, 8, pa1); PK4(p1, 0, pa2); PK4(p1, 8, pa3);
#undef PK4
}
__device__ __forceinline__ void qkt(f32x16& p0, f32x16& p1, const bf16* Ks, const bf16x8* qr, int r32, int hi) {
  p0 = f32x16{}; p1 = f32x16{};
  for (int d0 = 0; d0 < 8; ++d0) { int cb = (d0 * 16 + hi * 8) * 2;
    bf16x8 b0 = *reinterpret_cast<const bf16x8*>((const char*)Ks + KSWZ(r32, cb));
    bf16x8 b1 = *reinterpret_cast<const bf16x8*>((const char*)Ks + KSWZ(32 + r32, cb));
    p0 = __builtin_amdgcn_mfma_f32_32x32x16_bf16(b0, qr[d0], p0, 0, 0, 0);
    p1 = __builtin_amdgcn_mfma_f32_32x32x16_bf16(b1, qr[d0], p1, 0, 0, 0); }
}
__device__ __forceinline__ int v_st(int k, int c) { const int kk = (k & ~0xC) | ((k & 4) << 1) | ((k & 8) >> 1); return ((kk >> 3) * 4 + (c >> 5)) * 512 + ((kk & 7) * 32 + (c & 31)) * 2; }
__device__ __forceinline__ int v_rd_base(int lane) { return ((lane & 3) << 3) | (((lane >> 2) & 3) << 6) | (((lane >> 4) & 1) << 5) | (((lane >> 5) & 1) << 8); }
constexpr int v_rd_off(int d0, int ks, int half) { return d0 * 512 + ks * 4096 + half * 2048; }
template <int OFF> __device__ __forceinline__ s16x4 tr_read(int vb) {
  s16x4 r; asm volatile("ds_read_b64_tr_b16 %0, %1 offset:%2" : "=&v"(r) : "v"(vb), "i"(OFF) : "memory"); return r;
}
template <int D0> __device__ __forceinline__ void pv_one(f32x16& od, int vb, bf16x8 pa0, bf16x8 pa1, bf16x8 pa2, bf16x8 pa3) {
  const s16x4 l0 = tr_read<v_rd_off(D0, 0, 0)>(vb), h0 = tr_read<v_rd_off(D0, 0, 1)>(vb), l1 = tr_read<v_rd_off(D0, 1, 0)>(vb), h1 = tr_read<v_rd_off(D0, 1, 1)>(vb);
  const s16x4 l2 = tr_read<v_rd_off(D0, 2, 0)>(vb), h2 = tr_read<v_rd_off(D0, 2, 1)>(vb), l3 = tr_read<v_rd_off(D0, 3, 0)>(vb), h3 = tr_read<v_rd_off(D0, 3, 1)>(vb);
  asm volatile("s_waitcnt lgkmcnt(0)" ::: "memory"); SBAR();
#define PK(L, H) (bf16x8){L[0], L[1], L[2], L[3], H[0], H[1], H[2], H[3]}
  od = __builtin_amdgcn_mfma_f32_32x32x16_bf16(pa0, PK(l0, h0), od, 0, 0, 0);
  od = __builtin_amdgcn_mfma_f32_32x32x16_bf16(pa1, PK(l1, h1), od, 0, 0, 0);
  od = __builtin_amdgcn_mfma_f32_32x32x16_bf16(pa2, PK(l2, h2), od, 0, 0, 0);
  od = __builtin_amdgcn_mfma_f32_32x32x16_bf16(pa3, PK(l3, h3), od, 0, 0, 0);
#undef PK
}
__device__ __forceinline__ void pv_d0(f32x16* o, int vb, bf16x8 pa0, bf16x8 pa1, bf16x8 pa2, bf16x8 pa3) {
  pv_one<0>(o[0], vb, pa0, pa1, pa2, pa3); pv_one<1>(o[1], vb, pa0, pa1, pa2, pa3); pv_one<2>(o[2], vb, pa0, pa1, pa2, pa3); pv_one<3>(o[3], vb, pa0, pa1, pa2, pa3);
}
__device__ __forceinline__ void attn_dense_body(const bf16* __restrict__ Qb, __amdgpu_buffer_rsrc_t kvrs, unsigned kb0, unsigned kb1, int seg0, const bf16* __restrict__ Gb,
                                                bf16* __restrict__ Ob, int seq, char* lds, int wrows = QBLK) {
  int tid_ = threadIdx.x; asm volatile("" : "+v"(tid_));
  const int tid = tid_, wid = tid >> 6, lane = tid & 63, r32 = lane & 31, hi = lane >> 5;
  bf16* V_lds = (bf16*)lds; bf16* K_lds = (bf16*)(lds + 2 * SHM_V);
  float* ws = (float*)(lds + 2 * SHM_V + 2 * SHM_K) + wid * 64; float* li_l = ws; float* al_l = ws + 32;
  float m_reg = -1e30f, l_reg = 0; f32x16 o[4] = {}; bf16x8 qr[8];
  const bf16* Qw = Qb + (long)(wid * wrows + r32) * LDQ + hi * 8;
#pragma unroll
  for (int d0 = 0; d0 < 8; ++d0) qr[d0] = ld8(Qw + d0 * 16);
  const int sr = tid >> 4, sc = (tid & 15) * 8, vst0 = v_st(sr, sc), vst1 = v_st(32 + sr, sc);
  const int vb0 = (int)(uintptr_t)V_lds + v_rd_base(lane);
  struct { bf16x8 vs0, vs1, ks0, ks1; } sr_[SDEPTH];
  const unsigned vo0 = (unsigned)(sr * LDK + sc) * 2u, vo1 = (unsigned)((32 + sr) * LDK + sc) * 2u;
#define BLD(vo, so) __builtin_bit_cast(bf16x8, __builtin_amdgcn_raw_buffer_load_b128(kvrs, (int)(vo), (int)(so), 0))
#define SLOAD(i, k0) do { const unsigned so_ = ((k0) < seg0) ? kb0 + (unsigned)(k0) * (LDK * 2) : kb1 + (unsigned)((k0) - seg0) * (LDK * 2); \
    sr_[i].vs0 = BLD(vo0 + VOFF * 2, so_); sr_[i].vs1 = BLD(vo1 + VOFF * 2, so_); \
    sr_[i].ks0 = BLD(vo0, so_); sr_[i].ks1 = BLD(vo1, so_); } while (0)
#define SWRITE(b, i) do { *(bf16x8*)((char*)V_lds + (b) * SHM_V + vst0) = sr_[i].vs0;          \
    *(bf16x8*)((char*)V_lds + (b) * SHM_V + vst1) = sr_[i].vs1; int kc = sc * 2;               \
    *(bf16x8*)((char*)K_lds + (b) * SHM_K + KSWZ(sr, kc)) = sr_[i].ks0;                       \
    *(bf16x8*)((char*)K_lds + (b) * SHM_K + KSWZ(32 + sr, kc)) = sr_[i].ks1; } while (0)
#define SWAIT() do { if constexpr (SDEPTH == 2) asm volatile("s_waitcnt vmcnt(4)" ::: "memory"); else asm volatile("s_waitcnt vmcnt(0)" ::: "memory"); } while (0)
#define RESC(a) do { if (__any((a) < 1.f)) { if (hi == 0) al_l[r32] = (a); asm volatile("s_waitcnt lgkmcnt(0)" ::: "memory"); \
    for (int d = 0; d < 4; ++d) for (int r = 0; r < 16; ++r) o[d][r] *= al_l[crow(r, hi)]; } } while (0)
  f32x16 pA0, pA1, pB0, pB1; float mnA, mnB, alA, alB; bf16x8 pa0, pa1, pa2, pa3; const int NT = seq / KVBLK;
  constexpr int SE = 0, SO = SDEPTH - 1;
  SLOAD(SE, 0); asm volatile("s_waitcnt vmcnt(0)" ::: "memory"); SWRITE(0, SE); __syncthreads();
  qkt(pA0, pA1, K_lds, qr, r32, hi); partialSM(pA0, pA1, m_reg, mnA, alA);
  SLOAD(SO, KVBLK); if constexpr (SDEPTH == 2) { if (2 < NT) SLOAD(SE, 2 * KVBLK); }
  SWAIT(); SWRITE(1, SO); __syncthreads();
  for (int j = 1; j + 1 < NT; j += 2) {
    SBAR(); qkt(pB0, pB1, (bf16*)((char*)K_lds + SHM_K), qr, r32, hi);
    finishSM(pA0, pA1, alA, l_reg, pa0, pa1, pa2, pa3); SBAR();
    SLOAD(SO, (j + SDEPTH) * KVBLK); SBAR();
    pv_d0(o, vb0, pa0, pa1, pa2, pa3); partialSM(pB0, pB1, m_reg, mnB, alB);
    __syncthreads(); SWAIT(); SWRITE(0, SE);
    RESC(alB); __syncthreads();
    SBAR(); qkt(pA0, pA1, K_lds, qr, r32, hi);
    finishSM(pB0, pB1, alB, l_reg, pa0, pa1, pa2, pa3); SBAR();
    if (SDEPTH == 1 || j + 3 < NT) SLOAD(SE, (j + 1 + SDEPTH) * KVBLK); SBAR();
    pv_d0(o, vb0 + (int)SHM_V, pa0, pa1, pa2, pa3); partialSM(pA0, pA1, m_reg, mnA, alA);
    __syncthreads(); SWAIT(); SWRITE(1, SO);
    RESC(alA); __syncthreads();
  }
  SBAR(); qkt(pB0, pB1, (bf16*)((char*)K_lds + SHM_K), qr, r32, hi);
  finishSM(pA0, pA1, alA, l_reg, pa0, pa1, pa2, pa3); SBAR();
  pv_d0(o, vb0, pa0, pa1, pa2, pa3); partialSM(pB0, pB1, m_reg, mnB, alB);
  __syncthreads(); RESC(alB);
  finishSM(pB0, pB1, alB, l_reg, pa0, pa1, pa2, pa3); SBAR();
  pv_d0(o, vb0 + (int)SHM_V, pa0, pa1, pa2, pa3);
  if (hi == 0) li_l[r32] = l_reg; asm volatile("s_waitcnt lgkmcnt(0)" ::: "memory");
  float rli[16];
#pragma unroll
  for (int r = 0; r < 16; ++r) rli[r] = __builtin_amdgcn_rcpf(li_l[crow(r, hi)]);
  bf16* Ow = Ob + (long)(wid * wrows) * LDO; const bf16* Gw = Gb + (long)(wid * wrows) * LDQ;
  asm volatile("" ::: "memory"); SBAR();
#pragma unroll
  for (int rh = 0; rh < 2; ++rh) {
    unsigned short gv[8][4];
#pragma unroll
    for (int r8 = 0; r8 < 8; ++r8) { const int orow = crow(rh * 8 + r8, hi);
#pragma unroll
      for (int d0 = 0; d0 < 4; ++d0) gv[r8][d0] = Gw[(long)orow * LDQ + d0 * 32 + r32]; }
    asm volatile("" ::: "memory");
#pragma unroll
    for (int r8 = 0; r8 < 8; ++r8) { const int r = rh * 8 + r8; const int orow = crow(r, hi);
#pragma unroll
      for (int d0 = 0; d0 < 4; ++d0) { const float gt = __uint_as_float((unsigned)gv[r8][d0] << 16);
        const float val = o[d0][r] * rli[r] * (gt * __builtin_amdgcn_rcpf(1.f + __expf(-gt)));
        Ow[(long)orow * LDO + d0 * 32 + r32] = pg8::f2bf_rne(val); } }
    asm volatile("" ::: "memory"); }
  __syncthreads();
#undef SLOAD
#undef BLD
#undef SWRITE
#undef SWAIT
#undef RESC
}
#undef KSWZ
#undef SBAR
}
#define LAS __attribute__((address_space(3)))
typedef unsigned short bf16_t;
typedef float f32x4 __attribute__((ext_vector_type(4)));
typedef float f32x2 __attribute__((ext_vector_type(2)));
typedef short bf16x8 __attribute__((ext_vector_type(8)));
typedef unsigned u32x2 __attribute__((ext_vector_type(2)));
constexpr int DM = 1024, NB = 4, SEQ = 4096, CTXL = 256, MLAT = NB * SEQ, MCTX = NB * CTXL, MTOT = MLAT + MCTX;
constexpr float EPS = 1e-6f;
constexpr size_t MiB = 1u << 20;
constexpr size_t WS_CTL = 0, CTL_ZERO_BYTES = 256 * 1024, WS_MODS = 65536, WS_HDN = 512 * 1024, WS_GATES = 2 * MiB;
constexpr size_t WS_W0IN = 5 * MiB, WS_W0OUT = 18 * MiB, WS_QKVG = 22 * MiB, WS_XVTL = 107 * MiB, WS_XVTC = 235 * MiB, WS_A2C = 243 * MiB, WS_Y0 = 100 * MiB;
constexpr size_t WS_W1OUT = 5 * MiB, WS_W1B = 9 * MiB, WS_H1 = 17 * MiB, WS_Y1A = 51 * MiB, WS_H = 192 * MiB, WS_W1A = 192 * MiB, WS_OZ = 51 * MiB, WS_Y1 = 51 * MiB;
constexpr size_t WS_EST = 17 * MiB, WS_NST = 49 * MiB, WS_PST = 49 * MiB + 512 * 1024;
constexpr size_t WS_CTXE = 192 * MiB, WS_CTXN = 208 * MiB;
constexpr size_t WS_END = 256 * MiB;
constexpr int LDS_BYTES = 147456;
constexpr int NPHASE = 16;

__device__ __forceinline__ float bf2f(unsigned short b) { return __uint_as_float((unsigned)b << 16); }
__device__ __forceinline__ unsigned short f2bf(float f) { return pg8::f2bf_rne(f); }
__device__ __forceinline__ unsigned pk2(float lo, float hi) { return pg8::cvtpk_hw(lo, hi); }
__device__ __forceinline__ float silu_f(float x) { return x * __builtin_amdgcn_rcpf(1.f + __expf(-x)); }
__device__ __forceinline__ float sigm_f(float x) { return __builtin_amdgcn_rcpf(1.f + __expf(-x)); }
template <int CTRL, int ROWMASK> __device__ __forceinline__ float dpp_addf(float v) { return v + __builtin_bit_cast(float, __builtin_amdgcn_update_dpp(0, __builtin_bit_cast(int, v), CTRL, ROWMASK, 0xF, ROWMASK == 0xF)); }
__device__ __forceinline__ float wave_sum(float v) {
    v = dpp_addf<0xB1, 0xF>(v); v = dpp_addf<0x4E, 0xF>(v); v = dpp_addf<0x141, 0xF>(v); v = dpp_addf<0x140, 0xF>(v);
    v = dpp_addf<0x142, 0xA>(v); v = dpp_addf<0x143, 0xC>(v);
    return __builtin_bit_cast(float, __builtin_amdgcn_readlane(__builtin_bit_cast(int, v), 63));
}
#define LDS_WAIT() asm volatile("s_waitcnt lgkmcnt(0)" ::: "memory")

template <bool ROPE_PERM = false>
__device__ __forceinline__ void transpose_item(const float* __restrict__ W, int ldw, int K, int col0, bf16_t* __restrict__ WT, int row0, LAS float* scr, int kb, int lane) {
    const int k0 = 64 * kb; int sc = col0 + (lane & 31);
    if constexpr (ROPE_PERM) { const int p = sc & 127, k = p >> 1, s = p & 1; sc = (sc & ~127) + (k < 32 ? k + 32 * s : k + 32 + 32 * s); }
#pragma unroll 8
    for (int i = 0; i < 32; ++i) { const int kk = 2 * i + (lane >> 5); scr[kk * 33 + (lane & 31)] = W[(size_t)(k0 + kk) * ldw + sc]; }
    LDS_WAIT(); asm volatile("" ::: "memory");
    const int c = lane & 7;
#pragma unroll
    for (int j = 0; j < 4; ++j) { const int n = (lane >> 3) + 8 * j; const LAS float* s = scr + (8 * c) * 33 + n;
        pg8::u32x4 o; o.x = pk2(s[0 * 33], s[1 * 33]); o.y = pk2(s[2 * 33], s[3 * 33]); o.z = pk2(s[4 * 33], s[5 * 33]); o.w = pk2(s[6 * 33], s[7 * 33]);
        *(pg8::u32x4*)(WT + (size_t)(row0 + n) * K + k0 + 8 * c) = o; }
    LDS_WAIT(); asm volatile("" ::: "memory");
}

#define RIX(lane_, j) (((j) >> 1) * 128 + 2 * (lane_) + ((j) & 1))
__device__ __forceinline__ void load_row(const float* __restrict__ p, int lane, f32x4 (&v)[4]) {
#pragma unroll
    for (int j = 0; j < 4; ++j) v[j] = ((const f32x4*)p)[RIX(lane, j)];
}
__device__ __forceinline__ void load_row_bf16(const bf16_t* __restrict__ p, int lane_, f32x4 (&v)[4]) {
#pragma unroll
    for (int c = 0; c < 2; ++c) { const pg8::u32x4 w = ((const pg8::u32x4*)p)[c * 64 + lane_];
        v[2 * c] = (f32x4){bf2f((unsigned short)(w.x & 0xffffu)), bf2f((unsigned short)(w.x >> 16)), bf2f((unsigned short)(w.y & 0xffffu)), bf2f((unsigned short)(w.y >> 16))};
        v[2 * c + 1] = (f32x4){bf2f((unsigned short)(w.z & 0xffffu)), bf2f((unsigned short)(w.z >> 16)), bf2f((unsigned short)(w.w & 0xffffu)), bf2f((unsigned short)(w.w >> 16))}; }
}
__device__ __forceinline__ void store_row_bf16(bf16_t* __restrict__ p, int lane_, const f32x4 (&v)[4]) {
#pragma unroll
    for (int c = 0; c < 2; ++c) { pg8::u32x4 w; w.x = pk2(v[2 * c].x, v[2 * c].y); w.y = pk2(v[2 * c].z, v[2 * c].w); w.z = pk2(v[2 * c + 1].x, v[2 * c + 1].y); w.w = pk2(v[2 * c + 1].z, v[2 * c + 1].w);
        ((pg8::u32x4*)p)[c * 64 + lane_] = w; }
}
__device__ __forceinline__ float row_rstd(const f32x4 (&v)[4]) {
    float s = 0.f;
#pragma unroll
    for (int j = 0; j < 4; ++j) s += (v[j].x * v[j].x + v[j].y * v[j].y) + (v[j].z * v[j].z + v[j].w * v[j].w);
    return rsqrtf(wave_sum(s) * (1.f / DM) + EPS);
}
__device__ __forceinline__ void modulate_inplace(f32x4 (&v)[4], float rstd, const float* __restrict__ g, const float* __restrict__ mods, int lane) {
#pragma unroll
    for (int j = 0; j < 4; ++j) { const int q = RIX(lane, j); const f32x4 gg = ((const f32x4*)g)[q], sh = ((const f32x4*)mods)[q], sc = ((const f32x4*)(mods + DM))[q];
        v[j] = v[j] * rstd * gg * (sc + 1.f) + sh; }
}
__device__ __forceinline__ void modulate_store(const f32x4 (&v)[4], float rstd, const float* __restrict__ g, const float* __restrict__ mods, bf16_t* __restrict__ orow, int lane) {
    f32x4 h[4];
#pragma unroll
    for (int j = 0; j < 4; ++j) { const int q = RIX(lane, j); const f32x4 gg = ((const f32x4*)g)[q], sh = ((const f32x4*)mods)[q], sc = ((const f32x4*)(mods + DM))[q];
        h[j] = v[j] * rstd * gg * (sc + 1.f) + sh; }
    store_row_bf16(orow, lane, h);
}

#define HYBAR() asm volatile("s_waitcnt lgkmcnt(0)\n\ts_barrier" ::: "memory")
__device__ __forceinline__ int PH(int p) { return p + (p >> 4); }
__host__ __device__ constexpr float ck16(int k) { return k == 0 ? 1.f : k == 1 ? 0.92387953251128674f : k == 2 ? 0.70710678118654752f : k == 3 ? 0.38268343236508977f : k == 4 ? 0.f : k == 5 ? -0.38268343236508977f : k == 6 ? -0.70710678118654752f : -0.92387953251128674f; }
__host__ __device__ constexpr float sk16(int k) { return k == 0 ? 0.f : k == 1 ? 0.38268343236508977f : k == 2 ? 0.70710678118654752f : k == 3 ? 0.92387953251128674f : k == 4 ? 1.f : k == 5 ? 0.92387953251128674f : k == 6 ? 0.70710678118654752f : 0.38268343236508977f; }
template <bool INV> __device__ __forceinline__ void r16_bfly(f32x2 (&x)[16], float f8) {
    float cb[4], sb[4];
#pragma unroll
    for (int s = 0; s < 4; ++s) { const float f = f8 * (float)(1 << s); cb[s] = __builtin_amdgcn_cosf(f); sb[s] = __builtin_amdgcn_sinf(f); }
#pragma unroll
    for (int si = 0; si < 4; ++si) {
        const int s = INV ? 3 - si : si; const int hl = 8 >> s;
#pragma unroll
        for (int m0 = 0; m0 < 16; ++m0) {
            if (m0 & hl) continue;
            const int k16 = (m0 % hl) * (8 / hl);
            const float tc = cb[s] * ck16(k16) - sb[s] * sk16(k16), ts = cb[s] * sk16(k16) + sb[s] * ck16(k16);
            const f32x2 u = x[m0], v = x[m0 + hl];
            if (!INV) { const f32x2 d = u - v; x[m0] = u + v; x[m0 + hl] = (f32x2){d.x * tc + d.y * ts, d.y * tc - d.x * ts}; }
            else { const f32x2 w = (f32x2){v.x * tc - v.y * ts, v.x * ts + v.y * tc}; x[m0] = u + w; x[m0 + hl] = u - w; }
        }
    }
}
template <bool INV> __device__ __forceinline__ void r16_pass(LAS f32x2* buf, int e0, int stride, float f8) {
    f32x2 x[16];
    const int pb_ = PH(e0), step = stride + (stride >> 4);
#pragma unroll
    for (int m = 0; m < 16; ++m) x[m] = buf[pb_ + step * m];
    r16_bfly<INV>(x, f8);
#pragma unroll
    for (int m = 0; m < 16; ++m) buf[pb_ + step * m] = x[m];
}
__device__ __forceinline__ void r16_mid(LAS f32x2* zb, const LAS f32x2* fb, int e0, int ef) {
    f32x2 x[16]; const int pb_ = PH(e0), pf_ = PH(ef);
#pragma unroll
    for (int m = 0; m < 16; ++m) x[m] = zb[pb_ + m];
    r16_bfly<false>(x, 0.f);
#pragma unroll
    for (int m = 0; m < 16; ++m) { const f32x2 f = fb[pf_ + m], z = x[m]; x[m] = (f32x2){z.x * f.x - z.y * f.y, z.x * f.y + z.y * f.x}; }
    r16_bfly<true>(x, 0.f);
#pragma unroll
    for (int m = 0; m < 16; ++m) zb[pb_ + m] = x[m];
}
#define WAVE_SEAM() asm volatile("" ::: "memory")
#define OPAQUE(v) asm volatile("" : "+v"(v))
__device__ __forceinline__ void fft13_fwd_tail(LAS f32x2* buf, int tid) {
    OPAQUE(tid);
    r16_pass<false>(buf, (tid >> 8) * 4096 + (tid & 255), 256, (float)(tid & 255) * (1.f / 4096.f)); HYBAR();
    OPAQUE(tid); r16_pass<false>(buf, (tid >> 4) * 256 + (tid & 15), 16, (float)(tid & 15) * (1.f / 256.f)); WAVE_SEAM();
    OPAQUE(tid); r16_pass<false>(buf, tid * 16, 1, 0.f); HYBAR();
}
__device__ __forceinline__ void fft13_conv_core(LAS f32x2* zb, const LAS f32x2* fb, int tid) {
    OPAQUE(tid);
    r16_pass<false>(zb, (tid >> 8) * 4096 + (tid & 255), 256, (float)(tid & 255) * (1.f / 4096.f)); HYBAR();
    OPAQUE(tid); r16_pass<false>(zb, (tid >> 4) * 256 + (tid & 15), 16, (float)(tid & 15) * (1.f / 256.f)); WAVE_SEAM();
    OPAQUE(tid); r16_mid(zb, fb, tid * 16, tid * 16); WAVE_SEAM();
    OPAQUE(tid); r16_pass<true>(zb, (tid >> 4) * 256 + (tid & 15), 16, (float)(tid & 15) * (1.f / 256.f)); HYBAR();
    OPAQUE(tid); r16_pass<true>(zb, (tid >> 8) * 4096 + (tid & 255), 256, (float)(tid & 255) * (1.f / 4096.f)); HYBAR();
}
__device__ __forceinline__ void conv8(const bf16_t* __restrict__ row, int s0, int n, float w0, float w1, float w2, float bias, float (&o)[8]) {
    const bf16x8 v = *(const bf16x8*)(row + s0);
    float x[10];
    x[0] = s0 > 0 ? bf2f(row[s0 - 1]) : 0.f; x[9] = s0 + 8 < n ? bf2f(row[s0 + 8]) : 0.f;
#pragma unroll
    for (int e = 0; e < 8; ++e) x[1 + e] = bf2f((unsigned short)v[e]);
#pragma unroll
    for (int e = 0; e < 8; ++e) o[e] = bias + w0 * x[e] + w1 * x[e + 1] + w2 * x[e + 2];
}
__device__ __forceinline__ void hyena_lat_channel(LAS unsigned char* L, int c, float (&a0)[8], float (&a1)[8], const bf16_t* __restrict__ xvt,
                                                  const float* __restrict__ cw, const float* __restrict__ cb, const float* __restrict__ hyb, bf16_t* __restrict__ a2, int tid, bool last) {
    constexpr int n = 4096, N = 8192;
    OPAQUE(tid); const int lane = tid & 63, wid = tid >> 6, s0 = 8 * tid;
    LAS f32x2* Fb = (LAS f32x2*)L; LAS f32x2* Zb = (LAS f32x2*)(L + 69632); LAS float* red = (LAS float*)(L + 139264);
    {
        const float absdelta = 3.0701134573253945f + (float)c * (12.280453829301578f / 1023.f);
        float l1 = 0.f;
#pragma unroll
        for (int e = 0; e < 8; ++e) { const int t = s0 + e; const float dec = __expf(-((float)t * (1.f / (float)(n - 1))) * absdelta); a0[e] *= dec; a1[e] *= dec; l1 += fabsf(a0[e]); if (t >= 1) l1 += fabsf(a1[e]); }
        l1 = wave_sum(l1); if (lane == 0) red[wid] = l1;
        HYBAR();
        float tot = 0.f;
#pragma unroll
        for (int w = 0; w < 8; ++w) tot += red[w];
        const float scale = 1.f / (tot * (float)N);
        { const int pb = PH(s0), qb = PH(N - 8 - s0);
#pragma unroll
          for (int e = 0; e < 8; ++e) { Fb[pb + e] = (f32x2){a0[e] * scale, 0.f}; if (e >= 1) Fb[qb + 8 - e] = (f32x2){a1[e] * scale, 0.f}; }
          if (tid >= 1) Fb[PH(N - s0)] = (f32x2){a1[0] * scale, 0.f}; }
        if (tid == 0) Fb[PH(n)] = (f32x2){0.f, 0.f};
        HYBAR();
        const float w00 = cw[c], w01 = cw[3072 + c], w02 = cw[6144 + c], b0 = cb[c];
        const float w10 = cw[1024 + c], w11 = cw[3072 + 1024 + c], w12 = cw[6144 + 1024 + c], b1 = cb[1024 + c];
        const float w20 = cw[2048 + c], w21 = cw[3072 + 2048 + c], w22 = cw[6144 + 2048 + c], b2 = cb[2048 + c];
        const float hb = hyb[c];
        const int sm1 = s0 > 0 ? s0 - 1 : 0, sp8 = s0 + 8 < n ? s0 + 8 : n - 1;
        const float mlo = s0 > 0 ? 1.f : 0.f, mhi = s0 + 8 < n ? 1.f : 0.f;
#define RAWLD(V, LO, HI, rowp) do { const bf16_t* rp_ = (rowp); V = *(const bf16x8*)(rp_ + s0); LO = rp_[sm1]; HI = rp_[sp8]; } while (0)
#define RAWCONV(V, LO, HI, wA, wB, wC, bias_, out_) do { float x_[10]; x_[0] = bf2f(LO) * mlo; x_[9] = bf2f(HI) * mhi; \
        _Pragma("unroll") for (int e = 0; e < 8; ++e) x_[1 + e] = bf2f((unsigned short)V[e]); \
        _Pragma("unroll") for (int e = 0; e < 8; ++e) out_[e] = (bias_) + (wA) * x_[e] + (wB) * x_[e + 1] + (wC) * x_[e + 2]; } while (0)
        bf16x8 fa0, fb0, fa1, fb1; unsigned short fa0l, fa0h, fb0l, fb0h, fa1l, fa1h, fb1l, fb1h;
        { const bf16_t* r0 = xvt; const bf16_t* r1 = xvt + (size_t)4096 * n;
          RAWLD(fa0, fa0l, fa0h, r0 + (size_t)(2048 + c) * n); RAWLD(fb0, fb0l, fb0h, r0 + (size_t)(1024 + c) * n);
          RAWLD(fa1, fa1l, fa1h, r1 + (size_t)(2048 + c) * n); RAWLD(fb1, fb1l, fb1h, r1 + (size_t)(1024 + c) * n); }
        { const int pt = PH(tid);
#pragma unroll
          for (int k = 0; k < 8; ++k) { const float f = (float)(tid + 512 * k) * (1.f / 8192.f); const float cc_ = __builtin_amdgcn_cosf(f), ss_ = __builtin_amdgcn_sinf(f);
            const int i0 = pt + 544 * k, i1 = i0 + 4352;
            const f32x2 u = Fb[i0], v = Fb[i1], d = u - v; Fb[i0] = u + v; Fb[i1] = (f32x2){d.x * cc_ + d.y * ss_, d.y * cc_ - d.x * ss_}; } }
        HYBAR();
        fft13_fwd_tail(Fb, tid);
#pragma unroll 1
        for (int pair = 0; pair < 2; ++pair) {
            const bf16_t* r0 = xvt + ((size_t)(2 * pair) * 4096) * n; const bf16_t* r1 = xvt + ((size_t)(2 * pair + 1) * 4096) * n;
            float g0[8], g1[8];
            { float tmp[8];
              RAWCONV(fa0, fa0l, fa0h, w20, w21, w22, b2, g0); RAWCONV(fb0, fb0l, fb0h, w10, w11, w12, b1, tmp);
#pragma unroll
              for (int e = 0; e < 8; ++e) g0[e] *= tmp[e];
              RAWCONV(fa1, fa1l, fa1h, w20, w21, w22, b2, g1); RAWCONV(fb1, fb1l, fb1h, w10, w11, w12, b1, tmp);
#pragma unroll
              for (int e = 0; e < 8; ++e) g1[e] *= tmp[e]; }
#pragma unroll
            for (int e = 0; e < 8; ++e) { const int s = s0 + e; const float f = (float)s * (1.f / 8192.f); const float cc_ = __builtin_amdgcn_cosf(f), ss_ = __builtin_amdgcn_sinf(f); const int pb = PH(s0);
                Zb[pb + e] = (f32x2){g0[e], g1[e]}; Zb[pb + 4352 + e] = (f32x2){g0[e] * cc_ + g1[e] * ss_, g1[e] * cc_ - g0[e] * ss_}; }
            HYBAR();
            bf16x8 xr0, xr1; unsigned short xl0, xh0, xl1, xh1;
            RAWLD(xr0, xl0, xh0, r0 + (size_t)c * n); RAWLD(xr1, xl1, xh1, r1 + (size_t)c * n);
            const bf16x8 gh0 = *(const bf16x8*)(r0 + (size_t)(3072 + c) * n + s0), gh1 = *(const bf16x8*)(r1 + (size_t)(3072 + c) * n + s0);
            pg8::u32x4 qa0 = {}, qa1 = {}, qa2 = {}, qb0 = {}, qb1 = {}, qb2 = {};
            if (last) { const bf16_t* pa = r0 + (size_t)(1024 + c) * n + s0; const bf16_t* pb_ = r1 + (size_t)(1024 + c) * n + s0;
                qa0 = *(const pg8::u32x4*)(pa - 3 * (size_t)n); qa1 = *(const pg8::u32x4*)(pa - 2 * (size_t)n); qa2 = *(const pg8::u32x4*)(pa - (size_t)n);
                qb0 = *(const pg8::u32x4*)(pb_ - 3 * (size_t)n); qb1 = *(const pg8::u32x4*)(pb_ - 2 * (size_t)n); qb2 = *(const pg8::u32x4*)(pb_ - (size_t)n); }
            fft13_conv_core(Zb, Fb, tid);
            float oa[8], ob[8];
            { float x0a[8], x0b[8];
              RAWCONV(xr0, xl0, xh0, w00, w01, w02, b0, x0a); RAWCONV(xr1, xl1, xh1, w00, w01, w02, b0, x0b);
#pragma unroll
              for (int e = 0; e < 8; ++e) { const int t = s0 + e; const float f = (float)t * (1.f / 8192.f); const float cc_ = __builtin_amdgcn_cosf(f), ss_ = __builtin_amdgcn_sinf(f);
                  const int pb = PH(s0); const f32x2 u = Zb[pb + e], v = Zb[pb + 4352 + e];
                  const float ya = u.x + (v.x * cc_ - v.y * ss_), yb = u.y + (v.x * ss_ + v.y * cc_);
                  oa[e] = x0a[e] * (ya + g0[e] * hb) * silu_f(bf2f((unsigned short)gh0[e])); ob[e] = x0b[e] * (yb + g1[e] * hb) * silu_f(bf2f((unsigned short)gh1[e])); } }
            { const bf16_t* n0 = xvt + ((size_t)(2 * (pair ^ 1)) * 4096) * n; const bf16_t* n1 = n0 + (size_t)4096 * n;
              RAWLD(fa0, fa0l, fa0h, n0 + (size_t)(2048 + c) * n); RAWLD(fb0, fb0l, fb0h, n0 + (size_t)(1024 + c) * n);
              RAWLD(fa1, fa1l, fa1h, n1 + (size_t)(2048 + c) * n); RAWLD(fb1, fb1l, fb1h, n1 + (size_t)(1024 + c) * n); }
            { int s0 = 8 * tid; OPAQUE(s0);
              bf16_t* ppa = (bf16_t*)r0 + (size_t)(1024 + c) * n + s0; bf16_t* ppb = (bf16_t*)r1 + (size_t)(1024 + c) * n + s0;
              if (!last) { *(pg8::u32x4*)ppa = (pg8::u32x4){pk2(oa[0], oa[1]), pk2(oa[2], oa[3]), pk2(oa[4], oa[5]), pk2(oa[6], oa[7])};
                           *(pg8::u32x4*)ppb = (pg8::u32x4){pk2(ob[0], ob[1]), pk2(ob[2], ob[3]), pk2(ob[4], ob[5]), pk2(ob[6], ob[7])}; }
              else {
                  const unsigned QA0[4] = {qa0.x, qa0.y, qa0.z, qa0.w}, QA1[4] = {qa1.x, qa1.y, qa1.z, qa1.w}, QA2[4] = {qa2.x, qa2.y, qa2.z, qa2.w};
                  const unsigned QB0[4] = {qb0.x, qb0.y, qb0.z, qb0.w}, QB1[4] = {qb1.x, qb1.y, qb1.z, qb1.w}, QB2[4] = {qb2.x, qb2.y, qb2.z, qb2.w};
#pragma unroll
                  for (int e = 0; e < 8; ++e) { const int t = s0 + e; const int sh = (e & 1) * 16;
                      const unsigned lo = ((QA0[e >> 1] >> sh) & 0xffffu) | (((QA1[e >> 1] >> sh) & 0xffffu) << 16), hi = ((QA2[e >> 1] >> sh) & 0xffffu) | ((unsigned)f2bf(oa[e]) << 16);
                      *(u32x2*)(a2 + ((size_t)(2 * pair) * n + t) * 2048 + c - 3) = (u32x2){lo, hi}; }
#pragma unroll
                  for (int e = 0; e < 8; ++e) { const int t = s0 + e; const int sh = (e & 1) * 16;
                      const unsigned lo = ((QB0[e >> 1] >> sh) & 0xffffu) | (((QB1[e >> 1] >> sh) & 0xffffu) << 16), hi = ((QB2[e >> 1] >> sh) & 0xffffu) | ((unsigned)f2bf(ob[e]) << 16);
                      *(u32x2*)(a2 + ((size_t)(2 * pair + 1) * n + t) * 2048 + c - 3) = (u32x2){lo, hi}; } } }
            HYBAR();
        }
#undef RAWLD
#undef RAWCONV
    }
}
__device__ __forceinline__ void hyena_lat4(LAS unsigned char* L, int c0, const bf16_t* __restrict__ xvt, const bf16_t* __restrict__ hdnt, const float* __restrict__ w3,
                                           const float* __restrict__ cw, const float* __restrict__ cb, const float* __restrict__ hyb, bf16_t* __restrict__ a2, int tid, float* __restrict__ park) {
    LAS float* w3s = (LAS float*)(L + 139264) + 16;
    { const int ci_ = tid >> 7, r_ = tid & 127; w3s[ci_ * 128 + (r_ & 63) * 2 + (r_ >> 6)] = w3[(r_ & 63) * 2048 + (r_ >> 6) * 1024 + c0 + ci_]; }
    HYBAR();
#pragma unroll 1
    for (int cp = 0; cp < 2; ++cp) {
        OPAQUE(tid); const int s0 = 8 * tid;
        float a0[8], a1[8]; f32x2 ta[8], tb[8];
#pragma unroll
        for (int e = 0; e < 8; ++e) { ta[e] = (f32x2){0.f, 0.f}; tb[e] = (f32x2){0.f, 0.f}; }
#pragma unroll 8
        for (int j = 0; j < 64; ++j) { const pg8::u32x4 hw = *(const pg8::u32x4*)(hdnt + (size_t)j * 4352 + s0);
            const float hh[8] = {__uint_as_float(hw.x << 16), __uint_as_float(hw.x & 0xffff0000u), __uint_as_float(hw.y << 16), __uint_as_float(hw.y & 0xffff0000u),
                                 __uint_as_float(hw.z << 16), __uint_as_float(hw.z & 0xffff0000u), __uint_as_float(hw.w << 16), __uint_as_float(hw.w & 0xffff0000u)};
            const f32x2 wa = *(const LAS f32x2*)(w3s + (2 * cp) * 128 + 2 * j), wb = *(const LAS f32x2*)(w3s + (2 * cp + 1) * 128 + 2 * j);
#pragma unroll
            for (int e = 0; e < 8; ++e) { ta[e] = ta[e] + wa * hh[e]; tb[e] = tb[e] + wb * hh[e]; } }
#pragma unroll
        for (int e = 0; e < 8; ++e) { park[e * 512 + tid] = tb[e].x; park[(8 + e) * 512 + tid] = tb[e].y; a0[e] = ta[e].x; a1[e] = ta[e].y; }
        hyena_lat_channel(L, c0 + 2 * cp, a0, a1, xvt, cw, cb, hyb, a2, tid, false);
        OPAQUE(tid);
#pragma unroll
        for (int e = 0; e < 8; ++e) { a0[e] = park[e * 512 + tid]; a1[e] = park[(8 + e) * 512 + tid]; }
        hyena_lat_channel(L, c0 + 2 * cp + 1, a0, a1, xvt, cw, cb, hyb, a2, tid, cp == 1);
    }
}
__device__ __forceinline__ void hyena_ctx4(LAS unsigned char* L, int c0, const bf16_t* __restrict__ xvt, const bf16_t* __restrict__ hdnt, const float* __restrict__ w3,
                                           const float* __restrict__ cw, const float* __restrict__ cb, const float* __restrict__ hyb, bf16_t* __restrict__ a2, int tid) {
    constexpr int n = 256, N = 512;
    OPAQUE(tid);
    const int lane = tid & 63, wid = tid >> 6;
    LAS f32x2* Fb = (LAS f32x2*)L; LAS f32x2* Zb = (LAS f32x2*)(L + 69632); LAS float* red = (LAS float*)(L + 139264);
    { const int fc = tid >> 7, c = c0 + fc, t0 = 2 * (tid & 127);
      float a0[2] = {0.f, 0.f}, a1[2] = {0.f, 0.f};
#pragma unroll 16
      for (int j = 0; j < 64; ++j) { const unsigned hw_ = *(const unsigned*)(hdnt + (size_t)j * 4352 + t0); const f32x2 hv = (f32x2){__uint_as_float(hw_ << 16), __uint_as_float(hw_ & 0xffff0000u)}; const float wf = w3[j * 2048 + c], wb = w3[j * 2048 + 1024 + c];
          a0[0] += hv.x * wf; a0[1] += hv.y * wf; a1[0] += hv.x * wb; a1[1] += hv.y * wb; }
      const float absdelta = 3.0701134573253945f + (float)c * (12.280453829301578f / 1023.f);
      float l1 = 0.f;
#pragma unroll
      for (int e = 0; e < 2; ++e) { const int t = t0 + e; const float dec = __expf(-((float)t * (1.f / (float)(n - 1))) * absdelta); a0[e] *= dec; a1[e] *= dec; l1 += fabsf(a0[e]); if (t >= 1) l1 += fabsf(a1[e]); }
      l1 = wave_sum(l1); if (lane == 0) red[wid] = l1;
      HYBAR();
      const float scale = 1.f / ((red[2 * fc] + red[2 * fc + 1]) * (float)N);
#pragma unroll
      for (int e = 0; e < 2; ++e) { const int t = t0 + e; Fb[PH(fc * 512 + t)] = (f32x2){a0[e] * scale, 0.f}; if (t >= 1) Fb[PH(fc * 512 + N - t)] = (f32x2){a1[e] * scale, 0.f}; }
      if ((tid & 127) == 0) Fb[PH(fc * 512 + n)] = (f32x2){0.f, 0.f};
      HYBAR();
#pragma unroll
      for (int i = 0; i < 2; ++i) { const int q = tid + 512 * i, sl = q >> 8, p = q & 255; const float f = (float)p * (1.f / 512.f); const float cc_ = __builtin_amdgcn_cosf(f), ss_ = __builtin_amdgcn_sinf(f);
          const int i0 = PH(sl * 512 + p), i1 = i0 + 272; const f32x2 u = Fb[i0], v = Fb[i1], d = u - v; Fb[i0] = u + v; Fb[i1] = (f32x2){d.x * cc_ + d.y * ss_, d.y * cc_ - d.x * ss_}; }
      HYBAR();
      OPAQUE(tid); r16_pass<false>(Fb, (tid >> 4) * 256 + (tid & 15), 16, (float)(tid & 15) * (1.f / 256.f)); HYBAR();
      OPAQUE(tid); r16_pass<false>(Fb, tid * 16, 1, 0.f); HYBAR(); }
    const int ch = wid >> 1, pair = wid & 1, c = c0 + ch, s0 = 4 * lane;
    const float w00 = cw[c], w01 = cw[3072 + c], w02 = cw[6144 + c], b0 = cb[c];
    const float w10 = cw[1024 + c], w11 = cw[3072 + 1024 + c], w12 = cw[6144 + 1024 + c], b1 = cb[1024 + c];
    const float w20 = cw[2048 + c], w21 = cw[3072 + 2048 + c], w22 = cw[6144 + 2048 + c], b2 = cb[2048 + c];
    const float hb = hyb[c];
    const bf16_t* r0 = xvt + ((size_t)(2 * pair) * 4096) * n; const bf16_t* r1 = xvt + ((size_t)(2 * pair + 1) * 4096) * n;
    float g0[4], g1[4];
#define CONV4(row_, wA, wB, wC, bias_, out_) do { const bf16_t* rp_ = (row_); const u32x2 v_ = *(const u32x2*)(rp_ + s0); float x_[6]; \
        x_[0] = bf2f(rp_[s0 > 0 ? s0 - 1 : 0]) * (s0 > 0 ? 1.f : 0.f); x_[5] = bf2f(rp_[s0 + 4 < n ? s0 + 4 : n - 1]) * (s0 + 4 < n ? 1.f : 0.f);        \
        x_[1] = bf2f((unsigned short)(v_.x & 0xffffu)); x_[2] = bf2f((unsigned short)(v_.x >> 16)); x_[3] = bf2f((unsigned short)(v_.y & 0xffffu)); x_[4] = bf2f((unsigned short)(v_.y >> 16)); \
        _Pragma("unroll") for (int e = 0; e < 4; ++e) out_[e] = (bias_) + (wA) * x_[e] + (wB) * x_[e + 1] + (wC) * x_[e + 2]; } while (0)
    { float tmp[4];
      CONV4(r0 + (size_t)(2048 + c) * n, w20, w21, w22, b2, g0); CONV4(r0 + (size_t)(1024 + c) * n, w10, w11, w12, b1, tmp);
#pragma unroll
      for (int e = 0; e < 4; ++e) g0[e] *= tmp[e];
      CONV4(r1 + (size_t)(2048 + c) * n, w20, w21, w22, b2, g1); CONV4(r1 + (size_t)(1024 + c) * n, w10, w11, w12, b1, tmp);
#pragma unroll
      for (int e = 0; e < 4; ++e) g1[e] *= tmp[e]; }
#pragma unroll
    for (int e = 0; e < 4; ++e) { const int s = s0 + e; const float f = (float)s * (1.f / 512.f); const float cc_ = __builtin_amdgcn_cosf(f), ss_ = __builtin_amdgcn_sinf(f);
        const int pb = PH(wid * 512 + s0); Zb[pb + e] = (f32x2){g0[e], g1[e]}; Zb[pb + 272 + e] = (f32x2){g0[e] * cc_ + g1[e] * ss_, g1[e] * cc_ - g0[e] * ss_}; }
    HYBAR();
    OPAQUE(tid); r16_pass<false>(Zb, (tid >> 4) * 256 + (tid & 15), 16, (float)(tid & 15) * (1.f / 256.f)); WAVE_SEAM();
    OPAQUE(tid); r16_mid(Zb, Fb, tid * 16, (tid >> 6) * 512 + ((tid * 16) & 511)); WAVE_SEAM();
    OPAQUE(tid); r16_pass<true>(Zb, (tid >> 4) * 256 + (tid & 15), 16, (float)(tid & 15) * (1.f / 256.f)); HYBAR();
    { float x0a[4], x0b[4];
      CONV4(r0 + (size_t)c * n, w00, w01, w02, b0, x0a); CONV4(r1 + (size_t)c * n, w00, w01, w02, b0, x0b);
      const u32x2 gha = *(const u32x2*)(r0 + (size_t)(3072 + c) * n + s0), ghb = *(const u32x2*)(r1 + (size_t)(3072 + c) * n + s0);
#pragma unroll
      for (int e = 0; e < 4; ++e) { const int t = s0 + e; const float f = (float)t * (1.f / 512.f); const float cc_ = __builtin_amdgcn_cosf(f), ss_ = __builtin_amdgcn_sinf(f);
          const int pb = PH(wid * 512 + s0); const f32x2 u = Zb[pb + e], v = Zb[pb + 272 + e];
          const float ya = u.x + (v.x * cc_ - v.y * ss_), yb = u.y + (v.x * ss_ + v.y * cc_);
          const unsigned ga_ = e < 2 ? gha.x : gha.y, gb_ = e < 2 ? ghb.x : ghb.y; const float gva = bf2f((unsigned short)((e & 1) ? (ga_ >> 16) : (ga_ & 0xffffu))), gvb = bf2f((unsigned short)((e & 1) ? (gb_ >> 16) : (gb_ & 0xffffu)));
          const float oa = x0a[e] * (ya + g0[e] * hb) * silu_f(gva), ob = x0b[e] * (yb + g1[e] * hb) * silu_f(gvb);
          a2[((size_t)(2 * pair) * n + t) * 2048 + c] = f2bf(oa); a2[((size_t)(2 * pair + 1) * n + t) * 2048 + c] = f2bf(ob); } }
#undef CONV4
    HYBAR();
}
namespace ml2 {
typedef short v4i16 __attribute__((ext_vector_type(4)));
constexpr int RAWS = 264, QS = 136, KTS = 72, VS = 264, SS = 72;
constexpr int OFF_RAW = 0, OFF_V = 34848, OFF_KTA = 68640, OFF_X = 87072, OFF_Q = 87072, OFF_K = 104480, OFF_KTB = 87072, OFF_S = 121888, OFF_G = 131104;
constexpr int G_DEN = 0, G_INV = 64, G_NQ = 128, G_BB = 192, G_CS = 256, G_EB = 320, G_AA = 384, G_NV = 448, G_NV2 = 576, G_SEGA = 704, G_SCAN = 1728, G_MISC = 1744;
constexpr size_t EST_SLOT = 16384;

__device__ __forceinline__ float logsig(float x) { return fminf(x, 0.f) - log1pf(__expf(-fabsf(x))); }
__device__ __forceinline__ unsigned pkbf(float lo, float hi) { return pg8::cvtpk_hw(lo, hi); }
template <int CTRL> __device__ __forceinline__ float dpp_add(float v) { return v + __builtin_bit_cast(float, __builtin_amdgcn_update_dpp(0, __builtin_bit_cast(int, v), CTRL, 0xF, 0xF, true)); }
__device__ __forceinline__ float sum8(float v) { v = dpp_add<0xB1>(v); v = dpp_add<0x4E>(v); return dpp_add<0x141>(v); }
__device__ __forceinline__ float sum16(float v) { return dpp_add<0x140>(sum8(v)); }
template <int CTRL, int ROWMASK> __device__ __forceinline__ float dpp_add_rm(float v) { return v + __builtin_bit_cast(float, __builtin_amdgcn_update_dpp(0, __builtin_bit_cast(int, v), CTRL, ROWMASK, 0xF, ROWMASK == 0xF)); }
__device__ __forceinline__ float wave_scan_incl(float v) {
    v = dpp_add_rm<0x111, 0xF>(v); v = dpp_add_rm<0x112, 0xF>(v); v = dpp_add_rm<0x114, 0xF>(v); v = dpp_add_rm<0x118, 0xF>(v);
    v = dpp_add_rm<0x142, 0xA>(v); v = dpp_add_rm<0x143, 0xC>(v);
    return v;
}
__device__ __forceinline__ bf16x8 vfrag(LAS unsigned char* vs, int srow, int vcol0, int lane) {
    const int g = lane >> 4, i = lane & 15, q = i >> 2, p = i & 3;
    LAS v4i16* a0 = (LAS v4i16*)(vs + ((srow + 8 * g + q) * VS + vcol0 + 4 * p) * 2);
    LAS v4i16* a1 = (LAS v4i16*)(vs + ((srow + 8 * g + 4 + q) * VS + vcol0 + 4 * p) * 2);
    const v4i16 lo = __builtin_amdgcn_ds_read_tr16_b64_v4i16(a0), hi = __builtin_amdgcn_ds_read_tr16_b64_v4i16(a1);
    return (bf16x8){lo[0], lo[1], lo[2], lo[3], hi[0], hi[1], hi[2], hi[3]};
}
__device__ __forceinline__ float block_scan(float x, LAS float* scan, int tid, float* tot) {
    const int lane = tid & 63, wid = tid >> 6; const float v = wave_scan_incl(x);
    if (lane == 63) scan[wid] = v;
    __syncthreads();
    float pre = 0.f, all = 0.f;
#pragma unroll
    for (int w = 0; w < 8; ++w) { const float s = scan[w]; if (w < wid) pre += s; all += s; }
    __syncthreads();
    *tot = all; return v + pre;
}
constexpr int OFF_TAPS = 138240;
__device__ __forceinline__ void stage_taps(LAS unsigned char* L, const float* __restrict__ cw, const float* __restrict__ cb, int h, int tid) {
    LAS float* tp = (LAS float*)(L + OFF_TAPS);
    if (tid < 256) { const int col = tid < 128 ? h * 128 + tid : 1024 + h * 128 + (tid - 128); tp[tid] = cw[col]; tp[256 + tid] = cw[2048 + col]; tp[512 + tid] = cw[4096 + col]; tp[768 + tid] = cb[col]; }
}
__device__ __forceinline__ void conv_row8(LAS unsigned char* L, int r, int cbyte, int tcol, float scale, float (&o)[8]) {
    LAS unsigned char* raw = L + OFF_RAW; const LAS float* tp = (const LAS float*)(L + OFF_TAPS) + tcol;
    const bf16x8 xm = *(const LAS bf16x8*)(raw + r * (RAWS * 2) + cbyte), x0 = *(const LAS bf16x8*)(raw + (r + 1) * (RAWS * 2) + cbyte), xp = *(const LAS bf16x8*)(raw + (r + 2) * (RAWS * 2) + cbyte);
#pragma unroll
    for (int e = 0; e < 8; ++e) { const float a = tp[768 + e] + tp[e] * bf2f((unsigned short)xm[e]) + tp[256 + e] * bf2f((unsigned short)x0[e]) + tp[512 + e] * bf2f((unsigned short)xp[e]);
        o[e] = silu_f(a) * scale; }
}

__device__ __forceinline__ void passA(LAS unsigned char* L, const bf16_t* __restrict__ Y1A, const float* __restrict__ GATES, const float* __restrict__ cw, const float* __restrict__ cb,
                                      unsigned* __restrict__ EST, float* __restrict__ NST, float* __restrict__ PST, unsigned* __restrict__ CTXE, float* __restrict__ CTXN, int bid, int G) {
    int tid = threadIdx.x; asm volatile("" : "+v"(tid));
    const int lane0 = tid & 63, wid = __builtin_amdgcn_readfirstlane(tid >> 6);
    LAS float* gl = (LAS float*)(L + OFF_G);
    LAS unsigned short* kta = (LAS unsigned short*)(L + OFF_KTA); LAS unsigned short* ktb = (LAS unsigned short*)(L + OFF_KTB);
    for (int item = bid; item < 256; item += G) {
        const int b = item >> 6, h = (item >> 3) & 7, g = item & 7;
        stage_taps(L, cw, cb, h, tid);
        const int njobs = 2;
        for (int job = 0; job < njobs; ++job) {
            const bool ctxjob = job == 1; const int ntok = ctxjob ? CTXL : 512, nseq = ctxjob ? CTXL : SEQ, tseg = ctxjob ? 0 : g * 512;
            const size_t rowbase = ctxjob ? (size_t)MLAT + b * CTXL : (size_t)b * SEQ;
            const bool en_f = !ctxjob || g < 4, en_b = !ctxjob || g >= 4; const int cj = g & 3;
            float lff = 0.f, lfb = 0.f, ipf = 0.f, ipb = 0.f;
            if (tid < ntok) { const float* gp = GATES + (rowbase + tseg + tid) * 32 + h; ipf = gp[0]; lff = logsig(gp[8]); ipb = gp[16]; lfb = logsig(gp[24]); }
            float totf, totb; const float Bf = block_scan(lff, gl + G_SCAN, tid, &totf); const float Bbi = block_scan(lfb, gl + G_SCAN, tid, &totb);
            const float Bb = totb - (Bbi - lfb);
            if (tid < ntok) { gl[G_SEGA + tid] = en_f ? __expf(totf - Bf + ipf) : 0.f; gl[G_SEGA + 512 + tid] = en_b ? __expf(totb - Bb + ipb) : 0.f; }
            if (tid < 256) gl[G_NV + tid] = 0.f;
            const int nch = ntok / 64, bh = b * 8 + h; const int c0 = ctxjob ? cj : 0, c1 = ctxjob ? cj + 1 : nch;
#pragma unroll 1
            for (int dir = 0; dir < 2; ++dir) {
                if (!(dir == 0 ? en_f : en_b)) continue;
                f32x4 acc[8][2];
#pragma unroll
                for (int dt = 0; dt < 8; ++dt)
#pragma unroll
                    for (int nt = 0; nt < 2; ++nt) acc[dt][nt] = (f32x4){0.f, 0.f, 0.f, 0.f};
                bf16x8 rk[3], rv[4];
#define A_ISSUE(ci_) do { const int t0_ = tseg + (ci_) * 64; \
                    _Pragma("unroll") for (int i = 0; i < 3; ++i) { const int c = tid + 512 * i; const int rr = c >> 4, cc8 = (c & 15) * 8; int tt = t0_ - 1 + rr; \
                        const bool ok = (tt >= 0) && (tt < nseq) && (c < 1056); tt = tt < 0 ? 0 : (tt > nseq - 1 ? nseq - 1 : tt); \
                        rk[i] = *(const bf16x8*)(Y1A + (rowbase + tt) * 4096 + 1024 + h * 128 + cc8); }   \
                    _Pragma("unroll") for (int i = 0; i < 4; ++i) { const int c = tid + 512 * i; const int rr = c >> 5, cc8 = (c & 31) * 8; \
                        rv[i] = *(const bf16x8*)(Y1A + (rowbase + t0_ + rr) * 4096 + 2048 + h * 256 + cc8); } } while (0)
                A_ISSUE(c0);
#pragma unroll 1
                for (int ci = c0; ci < c1; ++ci) {
                    int lane = lane0; asm volatile("" : "+v"(lane)); const int fr = lane & 15, fq = lane >> 4;
#pragma unroll
                    for (int i = 0; i < 3; ++i) { const int c = tid + 512 * i; const int tt = tseg + ci * 64 - 1 + (c >> 4); const bool ok = (tt >= 0) && (tt < nseq);
                        if (c < 1056) *(LAS bf16x8*)(L + OFF_RAW + (c >> 4) * (RAWS * 2) + (c & 15) * 16) = ok ? rk[i] : (bf16x8){0, 0, 0, 0, 0, 0, 0, 0}; }
#pragma unroll
                    for (int i = 0; i < 4; ++i) { const int c = tid + 512 * i; *(LAS bf16x8*)(L + OFF_V + (c >> 5) * (VS * 2) + (c & 31) * 16) = rv[i]; }
                    __syncthreads();
                    if (ci + 1 < c1) A_ISSUE(ci + 1);
#pragma unroll
                    for (int i = 0; i < 2; ++i) { const int r = tid & 63, d0 = (wid + 8 * i) * 8; float kv[8]; conv_row8(L, r, d0 * 2, 128 + d0, 0.08838834764831845f, kv);
                        const float aw = gl[G_SEGA + dir * 512 + ci * 64 + r];
#pragma unroll
                        for (int e = 0; e < 8; ++e) kta[(d0 + e) * KTS + r] = pg8::f2bf_rne(kv[e] * aw); }
                    __syncthreads();
#pragma unroll
                    for (int kk = 0; kk < 2; ++kk) { bf16x8 bv[2];
#pragma unroll
                        for (int nt = 0; nt < 2; ++nt) bv[nt] = vfrag(L + OFF_V, kk * 32, wid * 32 + nt * 16, lane);
#pragma unroll
                        for (int dt = 0; dt < 8; ++dt) { const bf16x8 af = *(const LAS bf16x8*)(L + OFF_KTA + ((dt * 16 + fr) * KTS + kk * 32 + fq * 8) * 2);
#pragma unroll
                            for (int nt = 0; nt < 2; ++nt) acc[dt][nt] = __builtin_amdgcn_mfma_f32_16x16x32_bf16(af, bv[nt], acc[dt][nt], 0, 0, 0); } }
                    if (tid < 128) { const LAS unsigned short* rowp = kta + tid * KTS; float s = 0.f;
#pragma unroll
                        for (int q = 0; q < 8; ++q) { const bf16x8 x = *(const LAS bf16x8*)(rowp + q * 8);
#pragma unroll
                            for (int e = 0; e < 8; ++e) s += bf2f((unsigned short)x[e]); }
                        gl[G_NV + dir * 128 + tid] += s; }
                    __syncthreads();
                }
#undef A_ISSUE
                const bool own_unused = !ctxjob && (dir == 0 ? g == 7 : g == 0);
                if (!own_unused) { const int slot = ctxjob ? (bh * 2 + dir) * 4 + cj : (bh * 8 + g) * 2 + dir; unsigned* ep = (ctxjob ? CTXE : EST) + (size_t)slot * EST_SLOT + tid;
#pragma unroll
                    for (int dt = 0; dt < 8; ++dt)
#pragma unroll
                        for (int nt = 0; nt < 2; ++nt) { ep[((dt * 2 + nt) * 2 + 0) * 512] = pkbf(acc[dt][nt][0], acc[dt][nt][1]); ep[((dt * 2 + nt) * 2 + 1) * 512] = pkbf(acc[dt][nt][2], acc[dt][nt][3]); }
                    if (tid < 128) (ctxjob ? CTXN : NST)[slot * 128 + tid] = gl[G_NV + dir * 128 + tid]; if (tid == 0 && !ctxjob) PST[slot] = __expf(dir == 0 ? totf : totb); }
            }
            __syncthreads();
        }
    }
}

#if defined(PROBE_A)
#define ML_STAMP(i) do { if (blockIdx.x == 0) ((unsigned long long*)PROBE_STAMPS)[i] = __builtin_amdgcn_s_memrealtime(); } while (0)
#else
#define ML_STAMP(i) do { } while (0)
#endif
__device__ __forceinline__ void passB(LAS unsigned char* L, const bf16_t* __restrict__ Y1A, const float* __restrict__ GATES, const float* __restrict__ cw, const float* __restrict__ cb,
                                      const unsigned* __restrict__ EST, const float* __restrict__ NST, const float* __restrict__ PST, bf16_t* __restrict__ H, int bid, int G, unsigned char* PROBE_STAMPS) {
    int tid = threadIdx.x; asm volatile("" : "+v"(tid));
    const int lane0 = tid & 63, wid = __builtin_amdgcn_readfirstlane(tid >> 6);
    LAS float* gl = (LAS float*)(L + OFF_G);
    LAS unsigned short* q_s = (LAS unsigned short*)(L + OFF_Q); LAS unsigned short* k_s = (LAS unsigned short*)(L + OFF_K);
    LAS unsigned short* kta = (LAS unsigned short*)(L + OFF_KTA); LAS unsigned short* S_s = (LAS unsigned short*)(L + OFF_S);
    for (int item = bid; item < 256; item += G) {
        const int b = item >> 6, h = (item >> 3) & 7, g = item & 7, bh = b * 8 + h;
        stage_taps(L, cw, cb, h, tid);
        const size_t rowbase = (size_t)b * SEQ;
#pragma unroll 1
        for (int dir = 0; dir < 2; ++dir) {
            f32x4 C[8][2];
            { const int sg = dir == 0 ? (g == 0 ? 7 : g - 1) : (g == 7 ? 0 : g + 1);
              const int slot = (bh * 8 + sg) * 2 + dir; const unsigned* ep = EST + (size_t)slot * EST_SLOT + tid;
#pragma unroll
              for (int dt = 0; dt < 8; ++dt)
#pragma unroll
                for (int nt = 0; nt < 2; ++nt) { const unsigned w0 = ep[((dt * 2 + nt) * 2 + 0) * 512], w1 = ep[((dt * 2 + nt) * 2 + 1) * 512];
                    C[dt][nt] = (f32x4){bf2f((unsigned short)(w0 & 0xffffu)), bf2f((unsigned short)(w0 >> 16)), bf2f((unsigned short)(w1 & 0xffffu)), bf2f((unsigned short)(w1 >> 16))}; }
              if (tid < 128) gl[G_NV + tid] = NST[slot * 128 + tid]; }
            ML_STAMP(30 + 2 * dir);
            bf16x8 rq[5]; float rg0 = 0.f, rg1 = 0.f;
#define B_ISSUE(ci_) do { const int t0_ = g * 512 + (ci_) * 64; \
                _Pragma("unroll") for (int i = 0; i < 5; ++i) { const int c = tid + 512 * i; const int rr = c >> 5, c5 = c & 31; int tt = t0_ - 1 + rr; \
                    const bool ok = (tt >= 0) && (tt < SEQ) && (c < 2112); tt = tt < 0 ? 0 : (tt > SEQ - 1 ? SEQ - 1 : tt); \
                    const int col = c5 < 16 ? h * 128 + c5 * 8 : 1024 + h * 128 + (c5 - 16) * 8; \
                    rq[i] = *(const bf16x8*)(Y1A + (rowbase + tt) * 4096 + col); } \
                { const float* gp = GATES + (rowbase + t0_ + (tid & 63)) * 32 + dir * 16 + h; rg0 = gp[0]; rg1 = gp[8]; } } while (0)
            B_ISSUE(dir == 0 ? 0 : 7);
            bf16x8 rv[4];
#define V_ISSUE(ci_) do { const int tv_ = g * 512 + (ci_) * 64; _Pragma("unroll") for (int i = 0; i < 4; ++i) { const int c = tid + 512 * i; \
                rv[i] = *(const bf16x8*)(Y1A + (rowbase + tv_ + (c >> 5)) * 4096 + 2048 + h * 256 + (c & 31) * 8); } } while (0)
#pragma unroll 1
            for (int st = 0; st < 8; ++st) {
                const int ci = dir == 0 ? st : 7 - st; const int t0 = g * 512 + ci * 64;
                ML_STAMP(40);
                V_ISSUE(ci);
                int lane = lane0; asm volatile("" : "+v"(lane)); const int fr = lane & 15, fq = lane >> 4;
#pragma unroll
                for (int i = 0; i < 5; ++i) { const int c = tid + 512 * i; const int tt = t0 - 1 + (c >> 5); const bool ok = (tt >= 0) && (tt < SEQ);
                    if (c < 2112) *(LAS bf16x8*)(L + OFF_RAW + (c >> 5) * (RAWS * 2) + (c & 31) * 16) = ok ? rq[i] : (bf16x8){0, 0, 0, 0, 0, 0, 0, 0}; }
                if (wid == 0) { const float ip = rg0, lf = logsig(rg1); const float v = wave_scan_incl(lf);
                    const float tot = __builtin_bit_cast(float, __builtin_amdgcn_readlane(__builtin_bit_cast(int, v), 63)); const float bb = dir == 0 ? v : tot - (v - lf);
                    gl[G_BB + lane] = bb; gl[G_CS + lane] = bb - ip; gl[G_EB + lane] = __expf(bb); gl[G_AA + lane] = __expf(tot - bb + ip); gl[G_DEN + lane] = 0.f;
                    if (lane == 0) gl[G_MISC] = __expf(tot); }
                __syncthreads(); ML_STAMP(41);
                if (st + 1 < 8) B_ISSUE(dir == 0 ? st + 1 : 6 - st);
#pragma unroll
                for (int i = 0; i < 4; ++i) { const int r = tid & 63, cgi = wid + 8 * i; float o[8]; conv_row8(L, r, cgi * 16, cgi * 8, cgi < 16 ? 1.f : 0.08838834764831845f, o);
                    pg8::u32x4 w; w.x = pkbf(o[0], o[1]); w.y = pkbf(o[2], o[3]); w.z = pkbf(o[4], o[5]); w.w = pkbf(o[6], o[7]);
                    if (cgi < 16) *(LAS pg8::u32x4*)(q_s + r * QS + cgi * 8) = w;
                    else { *(LAS pg8::u32x4*)(k_s + r * QS + (cgi - 16) * 8) = w; const float a = gl[G_AA + r]; const int d0 = (cgi - 16) * 8;
#pragma unroll
                        for (int e = 0; e < 8; ++e) kta[(d0 + e) * KTS + r] = pg8::f2bf_rne(o[e] * a); } }
#pragma unroll
                for (int i = 0; i < 4; ++i) { const int c = tid + 512 * i; *(LAS bf16x8*)(L + OFF_V + (c >> 5) * (VS * 2) + (c & 31) * 16) = rv[i]; }
                __syncthreads(); ML_STAMP(42);
                { const int mt = wid >> 1;
#pragma unroll
                  for (int q2 = 0; q2 < 2; ++q2) { const int nt = (wid & 1) * 2 + q2; f32x4 acc = (f32x4){0.f, 0.f, 0.f, 0.f};
                    const bool need = dir == 0 ? (nt <= mt) : (nt >= mt);
                    if (need) {
#pragma unroll
                      for (int kk = 0; kk < 4; ++kk) { const bf16x8 af = *(const LAS bf16x8*)(L + OFF_Q + ((mt * 16 + fr) * QS + kk * 32 + fq * 8) * 2);
                        const bf16x8 bfr = *(const LAS bf16x8*)(L + OFF_K + ((nt * 16 + fr) * QS + kk * 32 + fq * 8) * 2);
                        acc = __builtin_amdgcn_mfma_f32_16x16x32_bf16(af, bfr, acc, 0, 0, 0); } }
                    const int s = nt * 16 + fr; const float css = gl[G_CS + s];
#pragma unroll
                    for (int j = 0; j < 4; ++j) { const int t = mt * 16 + fq * 4 + j; const bool in = dir == 0 ? (s <= t) : (s >= t);
                      float w = in ? acc[j] * __expf(gl[G_BB + t] - css) : 0.f; S_s[t * SS + s] = pg8::f2bf_rne(w);
                      const float rs = sum16(w);
                      if (need && fr == 0) (void)__hip_atomic_fetch_add(&gl[G_DEN + t], rs, __ATOMIC_RELAXED, __HIP_MEMORY_SCOPE_WORKGROUP); } } }
                { const int row = wid * 8 + (lane >> 3), part = lane & 7;
                  const bf16x8 xa = *(const LAS bf16x8*)(q_s + row * QS + part * 16), xb = *(const LAS bf16x8*)(q_s + row * QS + part * 16 + 8); float s = 0.f;
#pragma unroll
                  for (int e = 0; e < 8; ++e) s += bf2f((unsigned short)xa[e]) * gl[G_NV + part * 16 + e] + bf2f((unsigned short)xb[e]) * gl[G_NV + part * 16 + 8 + e];
                  s = sum8(s);
                  if (part == 0) __hip_atomic_fetch_add(&gl[G_DEN + row], s * gl[G_EB + row], __ATOMIC_RELAXED, __HIP_MEMORY_SCOPE_WORKGROUP); }
                __syncthreads(); ML_STAMP(43);
                bf16x8 cfr[2][4];
#pragma unroll
                for (int nt = 0; nt < 2; ++nt)
#pragma unroll
                    for (int kk = 0; kk < 4; ++kk) { pg8::u32x4 w; w.x = pkbf(C[2 * kk][nt][0], C[2 * kk][nt][1]); w.y = pkbf(C[2 * kk][nt][2], C[2 * kk][nt][3]);
                        w.z = pkbf(C[2 * kk + 1][nt][0], C[2 * kk + 1][nt][1]); w.w = pkbf(C[2 * kk + 1][nt][2], C[2 * kk + 1][nt][3]); cfr[nt][kk] = __builtin_bit_cast(bf16x8, w); }
                bf16x8 vfr[2][2];
#pragma unroll
                for (int nt = 0; nt < 2; ++nt)
#pragma unroll
                    for (int kk = 0; kk < 2; ++kk) vfr[nt][kk] = vfrag(L + OFF_V, kk * 32, wid * 32 + nt * 16, lane);
#pragma unroll
                for (int mt = 0; mt < 4; ++mt) { f32x4 o2[2] = {(f32x4){0.f, 0.f, 0.f, 0.f}, (f32x4){0.f, 0.f, 0.f, 0.f}};
#pragma unroll
                    for (int kk = 0; kk < 4; ++kk) {
                        const u32x2 lo = *(const LAS u32x2*)(L + OFF_Q + ((mt * 16 + fr) * QS + kk * 32 + fq * 4) * 2), hi = *(const LAS u32x2*)(L + OFF_Q + ((mt * 16 + fr) * QS + kk * 32 + 16 + fq * 4) * 2);
                        pg8::u32x4 w; w.x = lo.x; w.y = lo.y; w.z = hi.x; w.w = hi.y; const bf16x8 af = __builtin_bit_cast(bf16x8, w);
#pragma unroll
                        for (int nt = 0; nt < 2; ++nt) o2[nt] = __builtin_amdgcn_mfma_f32_16x16x32_bf16(af, cfr[nt][kk], o2[nt], 0, 0, 0); }
#pragma unroll
                    for (int nt = 0; nt < 2; ++nt)
#pragma unroll
                        for (int j = 0; j < 4; ++j) o2[nt][j] *= gl[G_EB + mt * 16 + fq * 4 + j];
#pragma unroll
                    for (int kk = 0; kk < 2; ++kk) { const bf16x8 af = *(const LAS bf16x8*)(L + OFF_S + ((mt * 16 + fr) * SS + kk * 32 + fq * 8) * 2);
#pragma unroll
                        for (int nt = 0; nt < 2; ++nt) o2[nt] = __builtin_amdgcn_mfma_f32_16x16x32_bf16(af, vfr[nt][kk], o2[nt], 0, 0, 0); }
#pragma unroll
                    for (int j = 0; j < 4; ++j) { const int t = mt * 16 + fq * 4 + j; const float inv = __builtin_amdgcn_rcpf(fmaxf(fabsf(gl[G_DEN + t]), 1.f));
                        LAS unsigned short* hs = (LAS unsigned short*)(L + OFF_RAW + wid * 4096) + t * 32 + fr;
                        hs[0] = pg8::f2bf_rne(o2[0][j] * inv); hs[16] = pg8::f2bf_rne(o2[1][j] * inv); } }
                __builtin_amdgcn_sched_barrier(0);
                { const float ap = gl[G_MISC];
#pragma unroll
                  for (int dt = 0; dt < 8; ++dt)
#pragma unroll
                    for (int nt = 0; nt < 2; ++nt) C[dt][nt] = C[dt][nt] * ap;
#pragma unroll
                  for (int kk = 0; kk < 2; ++kk)
#pragma unroll
                    for (int dt = 0; dt < 8; ++dt) { const bf16x8 af = *(const LAS bf16x8*)(L + OFF_KTA + ((dt * 16 + fr) * KTS + kk * 32 + fq * 8) * 2);
#pragma unroll
                        for (int nt = 0; nt < 2; ++nt) C[dt][nt] = __builtin_amdgcn_mfma_f32_16x16x32_bf16(af, vfr[nt][kk], C[dt][nt], 0, 0, 0); }
                  if (tid >= 384) { const int d = tid - 384; const LAS unsigned short* rowp = kta + d * KTS; float s = 0.f;
#pragma unroll
                    for (int q = 0; q < 8; ++q) { const bf16x8 x = *(const LAS bf16x8*)(rowp + q * 8);
#pragma unroll
                        for (int e = 0; e < 8; ++e) s += bf2f((unsigned short)x[e]); }
                    gl[G_NV + d] = gl[G_NV + d] * ap + s; } }
                { const int row4 = lane >> 2, ch = lane & 3;
#pragma unroll
                  for (int ib = 0; ib < 2; ++ib) {
                    pg8::u32x4 hold[2];
                    if (dir == 1) {
#pragma unroll
                      for (int i2 = 0; i2 < 2; ++i2) hold[i2] = *(const pg8::u32x4*)(H + (rowbase + t0 + (ib * 2 + i2) * 16 + row4) * 2048 + h * 256 + wid * 32 + ch * 8); }
#pragma unroll
                    for (int i2 = 0; i2 < 2; ++i2) { const int t = (ib * 2 + i2) * 16 + row4; const pg8::u32x4 w = *(const LAS pg8::u32x4*)(L + OFF_RAW + wid * 4096 + t * 64 + ch * 16);
                      pg8::u32x4* hp = (pg8::u32x4*)(H + (rowbase + t0 + t) * 2048 + h * 256 + wid * 32 + ch * 8);
                      if (dir == 0) *hp = w;
                      else { const pg8::u32x4 o = hold[i2]; pg8::u32x4 r;
                        r.x = pkbf(bf2f((unsigned short)(o.x & 0xffffu)) + bf2f((unsigned short)(w.x & 0xffffu)), bf2f((unsigned short)(o.x >> 16)) + bf2f((unsigned short)(w.x >> 16)));
                        r.y = pkbf(bf2f((unsigned short)(o.y & 0xffffu)) + bf2f((unsigned short)(w.y & 0xffffu)), bf2f((unsigned short)(o.y >> 16)) + bf2f((unsigned short)(w.y >> 16)));
                        r.z = pkbf(bf2f((unsigned short)(o.z & 0xffffu)) + bf2f((unsigned short)(w.z & 0xffffu)), bf2f((unsigned short)(o.z >> 16)) + bf2f((unsigned short)(w.z >> 16)));
                        r.w = pkbf(bf2f((unsigned short)(o.w & 0xffffu)) + bf2f((unsigned short)(w.w & 0xffffu)), bf2f((unsigned short)(o.w >> 16)) + bf2f((unsigned short)(w.w >> 16)));
                        *hp = r; } }
                    asm volatile("" ::: "memory"); } }
                __syncthreads(); ML_STAMP(44);
            }
#undef B_ISSUE
#undef V_ISSUE
            ML_STAMP(31 + 2 * dir);
        }
    }
}
__device__ __forceinline__ void scan_phase(unsigned* __restrict__ EST, float* __restrict__ NST, const float* __restrict__ PST, const unsigned* __restrict__ CTXE, const float* __restrict__ CTXN, int bid, int G) {
    const int tid = threadIdx.x;
    for (int idx = bid * 512 + tid; idx < 64 * (int)EST_SLOT; idx += G * 512) {
        const int chain = idx >> 14, bh = chain >> 1, dir = chain & 1, e = idx & 16383;
        float s0 = 0.f, s1 = 0.f; unsigned cwd[4];
#pragma unroll
        for (int j = 0; j < 4; ++j) cwd[j] = CTXE[(size_t)((bh * 2 + dir) * 4 + j) * EST_SLOT + e];
        unsigned ew[7]; float Pw[7];
#pragma unroll
        for (int f = 0; f < 7; ++f) { const int gj = dir == 0 ? f : 7 - f; const int slot = (bh * 8 + gj) * 2 + dir; Pw[f] = PST[slot]; ew[f] = EST[(size_t)slot * EST_SLOT + e]; }
#pragma unroll
        for (int j = 0; j < 4; ++j) { s0 += bf2f((unsigned short)(cwd[j] & 0xffffu)); s1 += bf2f((unsigned short)(cwd[j] >> 16)); }
        const unsigned seedw = pkbf(s0, s1);
#pragma unroll
        for (int f = 0; f < 7; ++f) { s0 = s0 * Pw[f] + bf2f((unsigned short)(ew[f] & 0xffffu)); s1 = s1 * Pw[f] + bf2f((unsigned short)(ew[f] >> 16)); ew[f] = pkbf(s0, s1); }
        EST[(size_t)((bh * 8 + (dir == 0 ? 7 : 0)) * 2 + dir) * EST_SLOT + e] = seedw;
#pragma unroll
        for (int f = 0; f < 7; ++f) { const int gj = dir == 0 ? f : 7 - f; const int slot = (bh * 8 + gj) * 2 + dir; EST[(size_t)slot * EST_SLOT + e] = ew[f]; }
    }
    for (int idx = bid * 512 + tid; idx < 64 * 128; idx += G * 512) {
        const int chain = idx >> 7, bh = chain >> 1, dir = chain & 1, e = idx & 127;
        float s = 0.f;
#pragma unroll
        for (int j = 0; j < 4; ++j) s += CTXN[((bh * 2 + dir) * 4 + j) * 128 + e];
        const float seedn = s;
        float nw[7], Pn[7];
#pragma unroll
        for (int f = 0; f < 7; ++f) { const int gj = dir == 0 ? f : 7 - f; const int slot = (bh * 8 + gj) * 2 + dir; Pn[f] = PST[slot]; nw[f] = NST[slot * 128 + e]; }
#pragma unroll
        for (int f = 0; f < 7; ++f) { s = s * Pn[f] + nw[f]; nw[f] = s; }
#pragma unroll
        for (int f = 0; f < 7; ++f) { const int gj = dir == 0 ? f : 7 - f; const int slot = (bh * 8 + gj) * 2 + dir; NST[slot * 128 + e] = nw[f]; }
        NST[((bh * 8 + (dir == 0 ? 7 : 0)) * 2 + dir) * 128 + e] = seedn;
    }
}
}
#define XB_TMO      128
#define XB_XCNT(j)  (256  + 64 * (j))
#define XB_XSUB(j)  (1280 + 64 * (j))
#define XB_XGEN(j)  (2304 + 64 * (j))
#define XB_TOP      3328
#define XB_TOPGEN   3392
#define XCD_BAR_WORDS 3456
#define XB_SPIN_CAP (1u << 18)

__device__ __forceinline__ unsigned xb_ld(unsigned* p)              { return __hip_atomic_load(p, __ATOMIC_RELAXED, __HIP_MEMORY_SCOPE_AGENT); }
__device__ __forceinline__ unsigned xb_add(unsigned* p, unsigned v) { return __hip_atomic_fetch_add(p, v, __ATOMIC_RELAXED, __HIP_MEMORY_SCOPE_AGENT); }
__device__ __forceinline__ unsigned xb_xcc_id() { return (unsigned)__builtin_amdgcn_s_getreg((3 << 11) | 20) & 0xFu; }
#define XB_SPIN(cond, bar) do { unsigned _sp = 0; while (cond) { __builtin_amdgcn_s_sleep(1); \
    if ((++_sp & 255u) == 0u) { if (xb_ld(&(bar)[XB_TMO])) break; if (_sp > XB_SPIN_CAP) { atomicAdd(&(bar)[XB_TMO], 1u); break; } } } } while (0)

struct XcdBarrier {
    unsigned* bar; unsigned x;
    volatile LAS unsigned* st;
};

__device__ __forceinline__ XcdBarrier xcd_barrier_post(unsigned* bar, volatile LAS unsigned* st) {
    XcdBarrier b; b.bar = bar; b.x = xb_xcc_id(); b.st = st;
    if (threadIdx.x == 0) (void)xb_add(&bar[XB_XCNT(b.x)], 1u);
    return b;
}
__device__ __forceinline__ void xcd_barrier_complete(unsigned* bar, unsigned x, unsigned& nloc, unsigned& nx) {
    const unsigned G = gridDim.x * gridDim.y * gridDim.z;
    unsigned sum, cnt, mine, sp = 0u;
    for (;;) {
        sum = 0u; cnt = 0u; mine = 0u;
#pragma unroll
        for (unsigned j = 0; j < 16; ++j) { const unsigned c = xb_ld(&bar[XB_XCNT(j)]); sum += c; cnt += (c > 0u) ? 1u : 0u; mine = (j == x) ? c : mine; }
        if (sum == G) break;
        __builtin_amdgcn_s_sleep(1);
        if ((++sp & 255u) == 0u) { if (xb_ld(&bar[XB_TMO])) break; if (sp > XB_SPIN_CAP) { atomicAdd(&bar[XB_TMO], 1u); break; } }
    }
    nloc = mine > 0u ? mine : 1u; nx = cnt > 0u ? cnt : 1u;
}

__device__ __forceinline__ void xcd_barrier(const XcdBarrier& b) {
    asm volatile("s_waitcnt vmcnt(0)" ::: "memory");
    __syncthreads();
    if (threadIdx.x == 0) {
        unsigned* bar = b.bar;
        __builtin_amdgcn_s_waitcnt(0);
        unsigned nloc = b.st[0], nx = b.st[1];
        if (nloc == 0u) { xcd_barrier_complete(bar, b.x, nloc, nx); b.st[0] = nloc; b.st[1] = nx; }
        const unsigned old = xb_add(&bar[XB_XSUB(b.x)], 1u);
        const unsigned gen = old / nloc;
        if (old + 1u == (gen + 1u) * nloc) {
            __builtin_amdgcn_fence(__ATOMIC_RELEASE, "agent");
            asm volatile("s_waitcnt vmcnt(0)" ::: "memory");
            const unsigned og = xb_add(&bar[XB_TOP], 1u);
            const unsigned tg = og / nx;
            if (og + 1u == (tg + 1u) * nx) xb_add(&bar[XB_TOPGEN], 1u);
            else XB_SPIN(xb_ld(&bar[XB_TOPGEN]) == tg, bar);
            __builtin_amdgcn_fence(__ATOMIC_ACQUIRE, "agent");
            xb_add(&bar[XB_XGEN(b.x)], 1u);
            asm volatile("s_waitcnt vmcnt(0)" ::: "memory");
        } else {
            XB_SPIN(xb_ld(&bar[XB_XGEN(b.x)]) == gen, bar);
            __builtin_amdgcn_fence(__ATOMIC_ACQUIRE, "agent");
            asm volatile("s_waitcnt vmcnt(0)" ::: "memory");
        }
    }
    __syncthreads();
}

struct Args { const float* in[27]; float* out; unsigned char* ws; int ph_lo, ph_hi; };
enum { I_X = 0, I_C, I_CTX, I_CCTX, I_WMOD, I_BMOD, I_GPRE, I_GPOST, I_EWIN, I_ECW, I_ECB, I_FW1, I_FB1, I_FFREQ, I_FW2, I_FB2, I_FW3, I_HYB, I_QN, I_KN, I_EWOUT,
       I_OWIN, I_OCW, I_OCB, I_OGB, I_OHN, I_OWOUT };

__device__ __forceinline__ const float* inp(int i) {
    const __attribute__((address_space(4))) unsigned char* p = (const __attribute__((address_space(4))) unsigned char*)__builtin_amdgcn_kernarg_segment_ptr();
    asm volatile("" : "+s"(p));
    return *(const float* const __attribute__((address_space(4)))*)(p + 8 * i);
}
__global__ void __launch_bounds__(512, 2) fwd_kernel(Args a) {
    extern __shared__ __attribute__((aligned(16))) unsigned char lds_raw[];
    LAS unsigned char* lds = (LAS unsigned char*)lds_raw;
    cg::grid_group grid = cg::this_grid();
#define tid ((int)threadIdx.x)
#define lane ((int)(threadIdx.x & 63))
#define wid (__builtin_amdgcn_readfirstlane((int)(threadIdx.x >> 6)))
#define G ((int)gridDim.x)
#define bid ((int)blockIdx.x)
#define gw (bid * 8 + wid)
#define NGW (G * 8)
    unsigned char* ws = a.ws;
#define MODS ((float*)(ws + WS_MODS))
#define HDN ((bf16_t*)(ws + WS_HDN))
#define GATES ((float*)(ws + WS_GATES))
#define W0IN ((bf16_t*)(ws + WS_W0IN))
#define W0OUT ((bf16_t*)(ws + WS_W0OUT))
#define QKVG ((bf16_t*)(ws + WS_QKVG))
#define XVTL ((bf16_t*)(ws + WS_XVTL))
#define XVTC ((bf16_t*)(ws + WS_XVTC))
#define A2C ((bf16_t*)(ws + WS_A2C))
#define Y0L ((bf16_t*)(ws + WS_Y0))
#define Y0C ((float*)(ws + WS_Y0 + 32 * MiB))
#define W1OUT ((bf16_t*)(ws + WS_W1OUT))
#define W1B ((bf16_t*)(ws + WS_W1B))
#define H1 ((bf16_t*)(ws + WS_H1))
#define Y1A ((bf16_t*)(ws + WS_Y1A))
#define HB ((bf16_t*)(ws + WS_H))
#define W1A ((bf16_t*)(ws + WS_W1A))
#define OZ ((bf16_t*)(ws + WS_OZ))
#define Y1 ((bf16_t*)(ws + WS_Y1))
#define H0 ((bf16_t*)a.out)
#define A2L ((bf16_t*)a.out)
#define X1B ((bf16_t*)a.out + (size_t)MLAT * DM)
#define ESTP ((unsigned*)a.out)
#ifdef DUPPH
    const int lo = a.ph_lo, hi = a.ph_hi & 255, xm = a.ph_hi >> 8;
#define XOFF(bit) ((xm >> (bit)) & 1)
#else
    const int lo = a.ph_lo, hi = a.ph_hi;
#define XOFF(bit) 0
#endif
    volatile LAS unsigned* MISC = (volatile LAS unsigned*)(lds + 143360);
    if (tid < 2) MISC[tid] = 0u;
    __syncthreads();
    if (a.ph_lo < 0) grid.sync();
    XcdBarrier xbar = xcd_barrier_post((unsigned*)(ws + WS_CTL), MISC);
#ifndef PHMASK
#define PHMASK 0xFFFFF
#endif
#define IN(k) ((((PHMASK) >> (k)) & 1) && lo <= (k) && (k) < hi)
#if defined(PROBE_A)
#ifndef PROBE_SCALE
#define PROBE_SCALE 1.f
#endif
#define stamps ((unsigned long long*)(ws + 32768))
#define SEAM(k) do { if (IN(k) && IN((k) + 1)) { xcd_barrier(xbar); } if (((k) + 1 == PROBE_A || (k) == PROBE_A || (k) + 1 == PROBE_B || (k) == PROBE_B) && bid == 0) stamps[(k) + 1] = __builtin_amdgcn_s_memrealtime(); } while (0)
    if (bid == 0) stamps[0] = __builtin_amdgcn_s_memrealtime();
#else
#define SEAM(k) do { if (IN(k) && IN((k) + 1)) { xcd_barrier(xbar); } } while (0)
#endif

    if (IN(0)) {
        LAS float* scr = (LAS float*)(lds + wid * 16384);
        if (!XOFF(0)) for (int it = gw; it < 3328; it += NGW) {
            { const int kb = it / 208, cb_ = it % 208;
                if (cb_ >= 128 && cb_ < 168) transpose_item<true>(inp(I_EWIN), 6656, 1024, cb_ * 32, W0IN, cb_ * 32, scr, kb, lane);
                else transpose_item(inp(I_EWIN), 6656, 1024, cb_ * 32, W0IN, cb_ * 32, scr, kb, lane); }
        }
        if (!XOFF(1)) for (int it = bid; it < 192; it += G) {
            const int l = it / 96, r = it % 96, cc = r / 16, kc = r % 16, col = cc * 512 + tid;
            const float* wm = inp(I_WMOD) + ((size_t)l * 1024 + kc * 64) * 3072 + col; const float* cv = inp(I_C) + kc * 64; const float* ccx = inp(I_CCTX) + kc * 64;
            float acc[5] = {0.f, 0.f, 0.f, 0.f, 0.f};
            LAS float* sl = (LAS float*)lds;
            __syncthreads();
            if (tid < 320) { const int j = tid >> 6, k = tid & 63; sl[tid] = silu_f(j < 4 ? cv[j * 1024 + k] : ccx[k]); }
            __syncthreads();
#pragma unroll 16
            for (int k = 0; k < 64; ++k) { const float w = wm[(size_t)k * 3072];
#pragma unroll
                for (int j = 0; j < 5; ++j) acc[j] += sl[j * 64 + k] * w; }
            const float bm = (kc == 0) ? inp(I_BMOD)[l * 3072 + col] : 0.f;
#pragma unroll
            for (int j = 0; j < 5; ++j) atomicAdd(&MODS[(l * 5 + j) * 3072 + col], acc[j] + bm);
        }
        if (!XOFF(2)) {
            float w1r[33], w2r[64];
            { const float* w1 = inp(I_FW1); const float* w2 = inp(I_FW2);
#pragma unroll
              for (int i = 0; i < 33; ++i) w1r[i] = w1[i * 64 + lane];
#pragma unroll
              for (int i = 0; i < 64; ++i) w2r[i] = w2[i * 64 + lane]; }
            const float fr_ = inp(I_FFREQ)[lane] * 0.15915494309189535f, fb1_ = inp(I_FB1)[lane], fb2_ = inp(I_FB2)[lane];
            for (int r = gw; r < 4352; r += NGW) {
                const int n = r < 4096 ? 4096 : 256, t = r < 4096 ? r : r - 4096;
                float acc = ((float)t / (float)(n - 1)) * w1r[0];
                const float tn = (float)t / (float)n;
#pragma unroll
                for (int i = 0; i < 16; ++i) { const float band = 1e-4f + (float)i * ((15.f - 1e-4f) / 15.f); const float rev = __builtin_amdgcn_fractf(tn * band);
                    acc += __builtin_amdgcn_cosf(rev) * w1r[1 + i] - __builtin_amdgcn_sinf(rev) * w1r[17 + i]; }
                const float h1 = __builtin_amdgcn_sinf(__builtin_amdgcn_fractf(fr_ * (acc + fb1_)));
                float acc2 = 0.f;
#pragma unroll
                for (int i = 0; i < 64; ++i) acc2 += __builtin_bit_cast(float, __builtin_amdgcn_readlane(__builtin_bit_cast(int, h1), i)) * w2r[i];
                HDN[(size_t)lane * 4352 + r] = f2bf(__builtin_amdgcn_sinf(__builtin_amdgcn_fractf(fr_ * (acc2 + fb2_))));
            }
        }
    }
    SEAM(0);
    if (IN(1)) {
        for (int m0 = gw; m0 < MTOT; m0 += 4 * NGW) {
            f32x4 v[4][4];
#pragma unroll
            for (int r = 0; r < 4; ++r) { const int m = m0 + r * NGW;
                if (m < MTOT) load_row(m < MLAT ? inp(I_X) + (size_t)m * DM : inp(I_CTX) + (size_t)(m - MLAT) * DM, lane, v[r]); }
#pragma unroll
            for (int r = 0; r < 4; ++r) { const int m = m0 + r * NGW; const int j = m < MLAT ? (m >> 12) : 4;
                if (m < MTOT) { const float rstd = row_rstd(v[r]); modulate_inplace(v[r], rstd, inp(I_GPRE), MODS + (size_t)j * 3072, lane); } }
#pragma unroll
            for (int r = 0; r < 4; ++r) { const int m = m0 + r * NGW; if (m < MTOT) store_row_bf16(H0 + (size_t)m * DM, lane, v[r]); }
        }
    }
    SEAM(1);
    if (IN(2)) {
        pg8::Gemm g{H0, W0IN, MTOT, 6656, 1024, H0, 1 << 30, 1024, 0}; pg8::StaticOrder S; S.init(MTOT, 6656, G, bid); pg8::EpiL0 E{XVTL, XVTC, QKVG, inp(I_QN), inp(I_KN), (LAS float*)(lds + 131072)};
        pg8::gemm_phase<pg8::EpiL0, pg8::StaticOrder, true, true>(lds, g, S, E);
        if (bid >= 232) { LAS float* scr = (LAS float*)(lds + wid * 16384);
            for (int it = (bid - 232) * 8 + wid; it < 1024; it += (G - 232) * 8) { const int kb = it / 32, cb_ = it % 32; transpose_item(inp(I_EWOUT), 1024, 2048, cb_ * 32, W0OUT, cb_ * 32, scr, kb, lane); } }
    }
    SEAM(2);
    if (IN(4)) {
        if (wid >= 4) __builtin_amdgcn_s_setprio(1);
        if ((bid >> 3) & 1) {
        for (int it = bid; it < 256; it += G) hyena_lat4(lds, (it & 7) * 128 + (it >> 3) * 4, XVTL, HDN, inp(I_FW3), inp(I_ECW), inp(I_ECB), inp(I_HYB), A2L, tid, (float*)(ws + 247 * MiB) + (size_t)bid * 8192);
        }
        __syncthreads();
        for (int u = bid; u < 768; u += G) {
            const bf16_t *Qb, *Gb; bf16_t* Ob; int seg0, seq, wrows; unsigned kb0, kb1;
            if (u < 512) { const int b = u >> 7, h = (u >> 4) & 7, qb = u & 15; const size_t q0 = (size_t)b * SEQ + qb * 256;
                Qb = QKVG + q0 * 2560 + h * 128; kb0 = (unsigned)(((size_t)b * SEQ * 2560 + 1024 + (h >> 2) * 128) * 2); kb1 = (unsigned)(((size_t)(MLAT + b * CTXL) * 2560 + 1024 + (h >> 2) * 128) * 2);
                seg0 = SEQ; seq = SEQ + CTXL; wrows = 32; Gb = QKVG + q0 * 2560 + 1536 + h * 128; Ob = A2L + q0 * 2048 + 1024 + h * 128; }
            else { const int p = u - 512, v = p >> 3, sub = p & 7, b = v >> 3, h = v & 7; const size_t q0 = (size_t)MLAT + b * CTXL;
                Qb = QKVG + (q0 + sub * 32) * 2560 + h * 128; kb0 = (unsigned)((q0 * 2560 + 1024 + (h >> 2) * 128) * 2); kb1 = kb0; seg0 = CTXL; seq = CTXL; wrows = 0;
                Gb = QKVG + (q0 + sub * 32) * 2560 + 1536 + h * 128; Ob = A2C + ((size_t)b * CTXL + sub * 32) * 2048 + 1024 + h * 128; }
            const __amdgpu_buffer_rsrc_t kvrs = __builtin_amdgcn_make_buffer_rsrc((void*)QKVG, (short)0, (int)(MTOT * 2560 * 2), 0x00020000);
            attn::attn_dense_body(Qb, kvrs, kb0, kb1, seg0, Gb, Ob, seq, (char*)lds_raw, wrows);
        }
        __syncthreads();
        if (!((bid >> 3) & 1)) {
        for (int it = bid; it < 256; it += G) hyena_lat4(lds, (it & 7) * 128 + (it >> 3) * 4, XVTL, HDN, inp(I_FW3), inp(I_ECW), inp(I_ECB), inp(I_HYB), A2L, tid, (float*)(ws + 247 * MiB) + (size_t)bid * 8192);
        }
        __syncthreads();
#if defined(PROBE_A) && defined(PROBE_P4PARTS)
        xcd_barrier(xbar); if (bid == 0 && tid == 0) stamps[20] = __builtin_amdgcn_s_memrealtime();
#endif
#ifndef NO_HYENA
#if defined(PROBE_A) && defined(PROBE_P4PARTS)
        xcd_barrier(xbar); if (bid == 0 && tid == 0) stamps[21] = __builtin_amdgcn_s_memrealtime();
#endif
        for (int it = bid; it < 256; it += G) hyena_ctx4(lds, (it & 7) * 128 + (it >> 3) * 4, XVTC, HDN + 4096, inp(I_FW3), inp(I_ECW), inp(I_ECB), inp(I_HYB), A2C, tid);
#endif
    }
    __builtin_amdgcn_s_setprio(0);
    SEAM(4);
    if (IN(5)) {
        { pg8::Gemm g{A2L, W0OUT, MLAT, 1024, 2048, A2L, 1 << 30, 2048, 0}; pg8::StaticOrder S; S.init(MLAT, 1024, G, bid); pg8::EpiBf16<0> E{Y0L, 1024, nullptr, 0, 0, 1.f};
          pg8::gemm_phase<pg8::EpiBf16<0>, pg8::StaticOrder, true, true>(lds, g, S, E); }
        { pg8::Gemm g{A2C, W0OUT, MCTX, 1024, 256, A2C, 1 << 30, 2048, 512}; pg8::SplitKOrder S{G, bid}; pg8::EpiF32Slab E{Y0C, 1024, (size_t)MCTX * 1024};
          pg8::gemm_phase<pg8::EpiF32Slab, pg8::SplitKOrder, true, true>(lds, g, S, E); }
        if (bid >= 128) { LAS float* scr = (LAS float*)(lds + wid * 16384);
            for (int it = (bid - 128) * 8 + wid; it < 2048 + 16; it += (G - 128) * 8) {
                if (it < 2048) { const int kb = it / 128, cb_ = it % 128; transpose_item(inp(I_OWIN), 8224, 1024, cb_ * 32, W1A, cb_ * 32, scr, kb, lane); }
                else { const int kb = it - 2048; transpose_item(inp(I_OWIN), 8224, 1024, 8192, W1A, 4096, scr, kb, lane); } } }
    }
    SEAM(5);
    if (IN(6)) {
        for (int m0 = gw; m0 < MLAT; m0 += 2 * NGW) {
            f32x4 y[2][4], x[2][4];
#pragma unroll
            for (int r = 0; r < 2; ++r) { const int m = m0 + r * NGW; load_row_bf16(Y0L + (size_t)m * DM, lane, y[r]); load_row(inp(I_X) + (size_t)m * DM, lane, x[r]); }
#pragma unroll
            for (int r = 0; r < 2; ++r) { const int m = m0 + r * NGW; const int j = m >> 12; const float ry = row_rstd(y[r]);
                const float* ga = MODS + (size_t)j * 3072 + 2048;
#pragma unroll
                for (int q = 0; q < 4; ++q) { const int idx = RIX(lane, q); x[r][q] = x[r][q] + ((const f32x4*)ga)[idx] * (y[r][q] * ry * ((const f32x4*)inp(I_GPOST))[idx]); }
                const float rx = row_rstd(x[r]);
#pragma unroll
                for (int q = 0; q < 4; ++q) y[r][q] = x[r][q];
                modulate_inplace(y[r], rx, inp(I_GPRE) + DM, MODS + (size_t)(5 + j) * 3072, lane); }
#pragma unroll
            for (int r = 0; r < 2; ++r) { const int m = m0 + r * NGW; store_row_bf16(X1B + (size_t)m * DM, lane, x[r]); store_row_bf16(H1 + (size_t)m * DM, lane, y[r]); }
        }
        for (int m = MLAT + gw; m < MTOT; m += NGW) {
            f32x4 y[4], x[4];
            load_row(Y0C + (size_t)(m - MLAT) * DM, lane, y);
#pragma unroll
            for (int kc = 1; kc < 8; ++kc) { f32x4 p[4]; load_row(Y0C + (size_t)kc * MCTX * DM + (size_t)(m - MLAT) * DM, lane, p);
#pragma unroll
                for (int q = 0; q < 4; ++q) y[q] = y[q] + p[q]; }
            load_row(inp(I_CTX) + (size_t)(m - MLAT) * DM, lane, x); const float ry = row_rstd(y);
            const float* ga = MODS + (size_t)4 * 3072 + 2048;
#pragma unroll
            for (int q = 0; q < 4; ++q) { const int idx = RIX(lane, q); x[q] = x[q] + ((const f32x4*)ga)[idx] * (y[q] * ry * ((const f32x4*)inp(I_GPOST))[idx]); }
            const float rx = row_rstd(x);
            modulate_store(x, rx, inp(I_GPRE) + DM, MODS + (size_t)(5 + 4) * 3072, H1 + (size_t)m * DM, lane);
        }
    }
    SEAM(6);
    if (IN(7)) {
        pg8::Gemm g{H1, W1A, MTOT, 4352, 1024, H1, 1 << 30, 1024, 0}; pg8::StaticOrder S; S.init(MTOT, 4352, G, bid); pg8::EpiL1a E{Y1A, GATES, inp(I_OGB)};
        if (bid >= 132) { for (int i_ = 0; i_ < 4; ++i_) __builtin_amdgcn_s_sleep(127); }
        pg8::gemm_phase<pg8::EpiL1a, pg8::StaticOrder, true, true>(lds, g, S, E);
        if (bid >= 132) { LAS float* scr = (LAS float*)(lds + wid * 16384);
            for (int it = (bid - 132) * 8 + wid; it < 2048 + 1024; it += (G - 132) * 8) {
                if (it < 2048) { const int kb = it / 128, cb_ = it % 128; transpose_item(inp(I_OWIN), 8224, 1024, 4096 + cb_ * 32, W1B, cb_ * 32, scr, kb, lane); }
                else { const int r = it - 2048, kb = r / 32, cb_ = r % 32; transpose_item(inp(I_OWOUT), 1024, 2048, cb_ * 32, W1OUT, cb_ * 32, scr, kb, lane); } } }
    }
    SEAM(7);
    if (IN(8)) { if (wid >= 4) __builtin_amdgcn_s_setprio(1); }
    if (IN(8)) ml2::passA(lds, Y1A, GATES, inp(I_OCW), inp(I_OCB), ESTP, (float*)(ws + WS_NST), (float*)(ws + WS_PST), (unsigned*)(ws + WS_CTXE), (float*)(ws + WS_CTXN), bid, G);
    SEAM(8);
    if (IN(9)) ml2::scan_phase(ESTP, (float*)(ws + WS_NST), (const float*)(ws + WS_PST), (const unsigned*)(ws + WS_CTXE), (const float*)(ws + WS_CTXN), bid, G);
    SEAM(9);
    if (IN(10)) ml2::passB(lds, Y1A, GATES, inp(I_OCW), inp(I_OCB), (const unsigned*)ESTP, (const float*)(ws + WS_NST), (const float*)(ws + WS_PST), HB, bid, G, ws + 32768);
    __builtin_amdgcn_s_setprio(0);
    SEAM(10);
    if (IN(12)) {
        pg8::Gemm g{H1, W1B, MLAT, 4096, 1024, H1, 1 << 30, 1024, 0}; pg8::PairOrder S{G, bid}; pg8::EpiOZ E{HB, inp(I_OHN), (LAS float*)(lds + 131072)};
        pg8::gemm_phase<pg8::EpiOZ, pg8::PairOrder, true, true>(lds, g, S, E);
    }
    SEAM(12);
    if (IN(14)) {
        pg8::Gemm g{HB, W1OUT, MLAT, 1024, 2048, HB, 1 << 30, 2048, 0}; pg8::StaticOrder S; S.init(MLAT, 1024, G, bid); pg8::EpiBf16<0> E{Y1, 1024, nullptr, 0, 0, 1.f};
        pg8::gemm_phase<pg8::EpiBf16<0>, pg8::StaticOrder, true, true>(lds, g, S, E);
    }
    SEAM(14);
#if defined(PROBE_A) && !defined(PROBE_KEEP15)
    if (false) {
#else
    if (IN(15)) {
#endif
        f32x4 res[8][4];
#pragma unroll
        for (int r = 0; r < 8; ++r) { const int m = gw + r * NGW;
            if (m < MLAT) { f32x4 y[4], x[4], gav[4], gpv[4]; load_row_bf16(Y1 + (size_t)m * DM, lane, y); load_row_bf16(X1B + (size_t)m * DM, lane, x);
                const float* ga = MODS + (size_t)(5 + (m >> 12)) * 3072 + 2048;
#pragma unroll
                for (int q = 0; q < 4; ++q) { const int idx = RIX(lane, q); gav[q] = ((const f32x4*)ga)[idx]; gpv[q] = ((const f32x4*)(inp(I_GPOST) + DM))[idx]; }
                asm volatile("" ::: "memory");
                const float ry = row_rstd(y);
#pragma unroll
                for (int q = 0; q < 4; ++q) res[r][q] = x[q] + gav[q] * (y[q] * ry * gpv[q]); } }
        xcd_barrier(xbar);
#pragma unroll
        for (int r = 0; r < 8; ++r) { const int m = gw + r * NGW;
            if (m < MLAT) {
#pragma unroll
                for (int q = 0; q < 4; ++q) ((f32x4*)(a.out + (size_t)m * DM))[RIX(lane, q)] = res[r][q]; } }
    }
#if defined(PROBE_A)
    xcd_barrier(xbar);
    if (bid == 0) {
        stamps[NPHASE] = __builtin_amdgcn_s_memrealtime();
        __syncthreads();
#define PDUR(p) ((p) < NPHASE ? (float)(stamps[(p) + 1] - stamps[(p)]) : (p) >= 30 ? (float)(stamps[(p) + 1] - stamps[(p)]) : (p) == 20 ? (float)(stamps[20] - stamps[4]) : (p) == 21 ? (float)(stamps[21] - stamps[20]) : (float)(stamps[5] - stamps[21]))
        float ta = PDUR(PROBE_A) * 0.01f;
        ta = exp2f(rintf(2.f * log2f(ta * PROBE_SCALE) + PROBE_SHIFT) / 2.f);
#if PROBE_B >= 0
#ifdef PROBE_LIN
        float tb = PDUR(PROBE_B) * 0.01f; tb = fmaxf(8.f, rintf((tb - PROBE_T0) / PROBE_Q) * PROBE_Q * PROBE_K);
#else
        float tb = PDUR(PROBE_B) * 0.01f; tb = exp2f(rintf(2.f * log2f(tb * PROBE_SCALE) + PROBE_SHIFT) / 2.f);
#endif
#else
        const float tb = 100.f;
#endif
        for (int i = tid; i < (1 << 20); i += 512) a.out[i] = (i == 0) ? (1000.f + 10.f * ta) : tb;
    }
#endif
#undef IN
#undef SEAM
#undef tid
#undef lane
#undef wid
#undef G
#undef bid
#undef gw
#undef NGW
}

#ifndef MK_MULTI
#define MK_MULTI 0
#endif
extern "C" void kernel_launch(void* const* d_in, const int* in_sizes, int n_in, void* d_out, int out_size, void* d_ws, size_t ws_size, hipStream_t stream) {
    static int grid = 0;
    if (grid == 0) {
        if (n_in != 27 || out_size != MLAT * DM || ws_size < WS_END) { fprintf(stderr, "kernel_launch: unexpected shapes (n_in %d out %d ws %zu)\n", n_in, out_size, ws_size); grid = -1; return; }
        int dev = 0, cus = 0, per_cu = 0;
        if (hipGetDevice(&dev) != hipSuccess || hipDeviceGetAttribute(&cus, hipDeviceAttributeMultiprocessorCount, dev) != hipSuccess) { grid = -1; return; }
        if (hipFuncSetAttribute((const void*)fwd_kernel, hipFuncAttributeMaxDynamicSharedMemorySize, LDS_BYTES) != hipSuccess) { fprintf(stderr, "kernel_launch: hipFuncSetAttribute failed\n"); grid = -1; return; }
        if (hipOccupancyMaxActiveBlocksPerMultiprocessor(&per_cu, (const void*)fwd_kernel, 512, LDS_BYTES) != hipSuccess || per_cu < 1) { fprintf(stderr, "kernel_launch: occupancy query failed (%d)\n", per_cu); (void)hipGetLastError(); per_cu = 1; }
        grid = cus * (per_cu > 1 ? 1 : per_cu);
        if (grid != 256) { fprintf(stderr, "kernel_launch: this kernel's static work split assumes 256 CUs (got %d); nothing launched\n", grid); grid = -1; return; }
    }
    if (grid < 0) return;
    (void)hipMemsetAsync((char*)d_ws + WS_CTL, 0, CTL_ZERO_BYTES, stream);
    Args a{};
    for (int i = 0; i < 27; ++i) a.in[i] = (const float*)d_in[i];
    a.out = (float*)d_out; a.ws = (unsigned char*)d_ws;
#if MK_MULTI
    for (int p = 0; p < NPHASE; ++p) { a.ph_lo = p; a.ph_hi = p + 1; hipLaunchKernelGGL(fwd_kernel, dim3(grid), dim3(512), LDS_BYTES, stream, a); }
#else
    a.ph_lo = 0; a.ph_hi = NPHASE;
    void* args[] = {&a};
    hipError_t e = hipLaunchCooperativeKernel((const void*)fwd_kernel, dim3(grid), dim3(512), args, LDS_BYTES, stream);
    if (e != hipSuccess) fprintf(stderr, "kernel_launch: cooperative launch failed: %s (grid %d)\n", hipGetErrorString(e), grid);
#ifdef DUPPH
    Args a2 = a; a2.ph_lo = DUPPH; a2.ph_hi = (DUPPH + 1) | (DUPX << 8); void* args2[] = {&a2};
    for (int r = 0; r < DUPN; ++r) (void)hipLaunchCooperativeKernel((const void*)fwd_kernel, dim3(grid), dim3(512), args2, LDS_BYTES, stream);
#endif
#endif
}
```
